# Optimizing an MI355X kernel written in HIP

```python
import math
import jax
import jax.numpy as jnp
from jax import lax
import numpy as np

D_MODEL = 1024
BATCH = 8
SEQ = 8192
DEPTH = 2

CTX_LEN = 256
GRID_W = 64
D_MIX = D_MODEL
D_S5 = D_MIX // 2
D_POOL = D_MIX - D_S5
S5_H = 16
S5_G = D_S5 // S5_H
S5_P = 64
N_DIRS = 2
POOL_WINDOWS = (2, 4, 8, 16)
POOL_CG = D_POOL // len(POOL_WINDOWS)
N_EXPERTS = 16
EC_CAPACITY_FACTOR = 2
EXPERT_FF = D_MODEL
N_MOD = 6
RMS_EPS = 1e-6

kernel_name = 'hybrid_s5_pool_ecmoe_prefix_dit'


def rmsnorm(x, g):
    xf = x.astype(jnp.float32)
    y = xf * lax.rsqrt(jnp.mean(xf * xf, axis=-1, keepdims=True) + RMS_EPS)
    return (y * g.astype(jnp.float32)).astype(x.dtype)


def modulate(h, shift, scale):
    return h * (1 + scale) + shift


def s5_discretize(lam_re, lam_im, log_dt, b_re, b_im):
    lam = lax.complex(lam_re.astype(jnp.float32), lam_im.astype(jnp.float32))
    dt = jnp.exp(log_dt.astype(jnp.float32))[:, None]
    a_bar = jnp.exp(lam * dt)
    b_mat = lax.complex(b_re.astype(jnp.float32), b_im.astype(jnp.float32))
    b_bar = ((a_bar - 1) / lam)[:, :, None] * b_mat
    return a_bar, b_bar


def _ssm_combine(left, right):
    a1, b1 = left
    a2, b2 = right
    return a1 * a2, a2 * b1 + b2


def s5_scan(u, a_bar, b_bar, h0, reverse):
    bu = jnp.einsum('btgh,gph->btgp', u.astype(jnp.complex64), b_bar)
    if h0 is not None:
        edge = -1 if reverse else 0
        bu = bu.at[:, edge].add(a_bar[None] * h0)
    a = jnp.broadcast_to(a_bar[None, None], (1, u.shape[1]) + a_bar.shape)
    _, h = lax.associative_scan(_ssm_combine, (a, bu), reverse=reverse, axis=1)
    return h


def s5_glu(y, w_glu):
    y = jax.nn.gelu(y)
    return y * jax.nn.sigmoid(y @ w_glu.astype(jnp.float32))


def s5_mixer(u_x, u_c, lam_re, lam_im, log_dt, b_re, b_im, c_re, c_im, d_skip, w_glu, with_ctx):
    bn, t_len, _ = u_x.shape
    l_len = u_c.shape[1]
    ux = u_x.astype(jnp.float32).reshape(bn, t_len, S5_G, S5_H)
    uc = u_c.astype(jnp.float32).reshape(bn, l_len, S5_G, S5_H)
    d = d_skip.astype(jnp.float32).reshape(S5_G, S5_H)
    y_x = d * ux
    y_c = d * uc if with_ctx else None
    for direction in range(N_DIRS):
        reverse = direction == 1
        a_bar, b_bar = s5_discretize(lam_re[direction], lam_im[direction], log_dt[direction],
                                     b_re[direction], b_im[direction])
        cmat = lax.complex(c_re[direction].astype(jnp.float32), c_im[direction].astype(jnp.float32))
        h_c = s5_scan(uc, a_bar, b_bar, None, reverse)
        h0 = h_c[:, 0] if reverse else h_c[:, -1]
        h_x = s5_scan(ux, a_bar, b_bar, h0, reverse)
        y_x = y_x + jnp.einsum('ghp,btgp->btgh', cmat, h_x).real
        if with_ctx:
            y_c = y_c + jnp.einsum('ghp,btgp->btgh', cmat, h_c).real
    out_x = s5_glu(y_x.reshape(bn, t_len, D_S5), w_glu).astype(u_x.dtype)
    out_c = s5_glu(y_c.reshape(bn, l_len, D_S5), w_glu).astype(u_c.dtype) if with_ctx else None
    return out_x, out_c


def box_mean(v, w, axis):
    n = v.shape[axis]
    cs = jnp.cumsum(v, axis=axis)
    pad = [(0, 0)] * v.ndim
    pad[axis] = (1, 0)
    cs = jnp.pad(cs, pad)
    t = jnp.arange(n)
    lo = jnp.clip(t - w // 2, 0, n)
    hi = jnp.clip(t + w // 2, 0, n)
    shape = [1] * v.ndim
    shape[axis] = n
    cnt = (hi - lo).astype(v.dtype).reshape(shape)
    return (jnp.take(cs, hi, axis=axis) - jnp.take(cs, lo, axis=axis)) / cnt


def pool_mixer(v, pool_w, pool_scale, grid):
    bn, t_len, _ = v.shape
    vf = v.astype(jnp.float32)
    outs = []
    for i, w in enumerate(POOL_WINDOWS):
        vg = vf[..., i * POOL_CG:(i + 1) * POOL_CG]
        if grid:
            rows = t_len // GRID_W
            v4 = vg.reshape(bn, rows, GRID_W, POOL_CG)
            m = box_mean(box_mean(v4, w, 1), w, 2).reshape(bn, t_len, POOL_CG)
        else:
            m = box_mean(vg, w, 1)
        outs.append(m - vg)
    z = jnp.stack(outs, axis=2)
    z = jnp.einsum('btgc,gcd->btgd', z, pool_w.astype(jnp.float32)).reshape(bn, t_len, D_POOL)
    return (z * pool_scale.astype(jnp.float32)).astype(v.dtype)


def ec_moe(h, w_router, w_gate, w_up, w_down):
    bn, t_len, d = h.shape
    cap = EC_CAPACITY_FACTOR * t_len // N_EXPERTS
    logits = jnp.einsum('btd,de->bte', h.astype(jnp.float32), w_router.astype(jnp.float32))
    affinity = jax.nn.softmax(logits, axis=-1)
    gate, idx = lax.top_k(jnp.swapaxes(affinity, 1, 2), cap)
    xs = jax.vmap(lambda hb, ib: hb[ib])(h, idx)
    a = jnp.einsum('becd,edf->becf', xs, w_gate)
    g = jnp.einsum('becd,edf->becf', xs, w_up)
    y = jnp.einsum('becf,efd->becd', jax.nn.silu(a) * g, w_down)
    y = y * gate[..., None].astype(y.dtype)
    out = jax.vmap(lambda yb, ib: jnp.zeros((t_len, d), yb.dtype).at[ib.reshape(-1)].add(yb.reshape(-1, d)))(y, idx)
    return out


def setup_inputs(seed: int = 0) -> dict:
    key = jax.random.key(seed)
    ks = jax.random.split(key, 32)

    def nrm(k, shape, scale):
        return jax.random.normal(k, shape, jnp.float32) * scale

    lam_im_base = jnp.broadcast_to(math.pi * jnp.arange(S5_P, dtype=jnp.float32), (DEPTH, N_DIRS, S5_G, S5_P))
    return {
        'x': nrm(ks[0], (BATCH, SEQ, D_MODEL), 1.0),
        'c': nrm(ks[1], (BATCH, D_MODEL), 1.0),
        'ctx': nrm(ks[2], (BATCH, CTX_LEN, D_MODEL), 1.0),
        'c_ctx': nrm(ks[3], (D_MODEL,), 1.0),
        'w_mod': nrm(ks[4], (DEPTH, D_MODEL, N_MOD * D_MODEL), 0.5 * D_MODEL ** -0.5),
        'b_mod': nrm(ks[5], (DEPTH, N_MOD * D_MODEL), 0.02),
        'g_mix_pre': 1.0 + nrm(ks[6], (DEPTH, D_MODEL), 0.02),
        'g_mix_post': 1.0 + nrm(ks[7], (DEPTH, D_MODEL), 0.02),
        'g_ffn_pre': 1.0 + nrm(ks[8], (DEPTH, D_MODEL), 0.02),
        'g_ffn_post': 1.0 + nrm(ks[9], (DEPTH, D_MODEL), 0.02),
        'w_in': nrm(ks[10], (DEPTH, D_MODEL, D_MIX), D_MODEL ** -0.5),
        's5_lam_re': -0.5 + nrm(ks[11], (DEPTH, N_DIRS, S5_G, S5_P), 0.01),
        's5_lam_im': lam_im_base + nrm(ks[12], (DEPTH, N_DIRS, S5_G, S5_P), 0.01),
        's5_log_dt': jax.random.uniform(ks[13], (DEPTH, N_DIRS, S5_G), jnp.float32, math.log(1e-3), math.log(1e-1)),
        's5_b_re': nrm(ks[14], (DEPTH, N_DIRS, S5_G, S5_P, S5_H), (2.0 * S5_H) ** -0.5),
        's5_b_im': nrm(ks[15], (DEPTH, N_DIRS, S5_G, S5_P, S5_H), (2.0 * S5_H) ** -0.5),
        's5_c_re': nrm(ks[16], (DEPTH, N_DIRS, S5_G, S5_H, S5_P), (2.0 * S5_P) ** -0.5),
        's5_c_im': nrm(ks[17], (DEPTH, N_DIRS, S5_G, S5_H, S5_P), (2.0 * S5_P) ** -0.5),
        's5_d': nrm(ks[18], (DEPTH, D_S5), 1.0),
        's5_w_glu': nrm(ks[19], (DEPTH, D_S5, D_S5), D_S5 ** -0.5),
        'pool_w': nrm(ks[20], (DEPTH, len(POOL_WINDOWS), POOL_CG, POOL_CG), POOL_CG ** -0.5),
        'pool_scale': 1.0 + nrm(ks[21], (DEPTH, D_POOL), 0.1),
        'w_out': nrm(ks[22], (DEPTH, D_MIX, D_MODEL), D_MIX ** -0.5),
        'w_router': nrm(ks[23], (DEPTH, D_MODEL, N_EXPERTS), D_MODEL ** -0.5),
        'w_gate': nrm(ks[24], (DEPTH, N_EXPERTS, D_MODEL, EXPERT_FF), D_MODEL ** -0.5),
        'w_up': nrm(ks[25], (DEPTH, N_EXPERTS, D_MODEL, EXPERT_FF), D_MODEL ** -0.5),
        'w_down': nrm(ks[26], (DEPTH, N_EXPERTS, EXPERT_FF, D_MODEL), EXPERT_FF ** -0.5),
    }


def reference(x, c, ctx, c_ctx, w_mod, b_mod, g_mix_pre, g_mix_post, g_ffn_pre, g_ffn_post,
              w_in, s5_lam_re, s5_lam_im, s5_log_dt, s5_b_re, s5_b_im, s5_c_re, s5_c_im,
              s5_d, s5_w_glu, pool_w, pool_scale, w_out, w_router, w_gate, w_up, w_down):
    for l in range(DEPTH):
        last = l == DEPTH - 1
        wm = w_mod[l].astype(jnp.float32)
        bm = b_mod[l].astype(jnp.float32)
        mod_x = (jax.nn.silu(c.astype(jnp.float32)) @ wm + bm).astype(x.dtype)[:, None, :]
        mod_c = (jax.nn.silu(c_ctx.astype(jnp.float32)) @ wm + bm).astype(ctx.dtype)
        shx1, scx1, gtx1, shx2, scx2, gtx2 = jnp.split(mod_x, N_MOD, axis=-1)
        shc1, scc1, gtc1, shc2, scc2, gtc2 = jnp.split(mod_c, N_MOD, axis=-1)

        hx = modulate(rmsnorm(x, g_mix_pre[l]), shx1, scx1)
        hc = modulate(rmsnorm(ctx, g_mix_pre[l]), shc1, scc1)
        px = hx @ w_in[l]
        pc = hc @ w_in[l]
        s5_x, s5_c = s5_mixer(px[..., :D_S5], pc[..., :D_S5], s5_lam_re[l], s5_lam_im[l], s5_log_dt[l],
                              s5_b_re[l], s5_b_im[l], s5_c_re[l], s5_c_im[l], s5_d[l], s5_w_glu[l],
                              not last)
        pool_x = pool_mixer(px[..., D_S5:], pool_w[l], pool_scale[l], True)
        mix_x = jnp.concatenate([s5_x, pool_x], axis=-1) @ w_out[l]
        x = x + gtx1 * rmsnorm(mix_x, g_mix_post[l])
        if not last:
            pool_c = pool_mixer(pc[..., D_S5:], pool_w[l], pool_scale[l], False)
            mix_c = jnp.concatenate([s5_c, pool_c], axis=-1) @ w_out[l]
            ctx = ctx + gtc1 * rmsnorm(mix_c, g_mix_post[l])

        hx = modulate(rmsnorm(x, g_ffn_pre[l]), shx2, scx2)
        x = x + gtx2 * rmsnorm(ec_moe(hx, w_router[l], w_gate[l], w_up[l], w_down[l]), g_ffn_post[l])
        if not last:
            hc = modulate(rmsnorm(ctx, g_ffn_pre[l]), shc2, scc2)
            ctx = ctx + gtc2 * rmsnorm(ec_moe(hc, w_router[l], w_gate[l], w_up[l], w_down[l]), g_ffn_post[l])
    return x
```

```cpp
#include <hip/hip_runtime.h>
#include <cstdio>
#include <cstdint>

#define GAS __attribute__((address_space(1)))
#define LAS __attribute__((address_space(3)))
typedef unsigned short bf16_t;
typedef short bf16x8 __attribute__((ext_vector_type(8)));
typedef float f32x4 __attribute__((ext_vector_type(4)));
typedef float f32x2 __attribute__((ext_vector_type(2)));
typedef unsigned u32x4 __attribute__((ext_vector_type(4)));
typedef unsigned u32x2 __attribute__((ext_vector_type(2)));

constexpr int D = 1024, NB = 8, T = 8192, LC = 256;
constexpr int MX = NB * T, MC = NB * LC, MT = MX + MC;
constexpr int NE = 16, CAPX = 1024, CAPC = 32;
constexpr int PX = NB * NE * CAPX, PC = NE * NB * CAPC, PT = PX + PC;
constexpr int NSEQ = LC + T;
constexpr int DS5 = 512, NG = 32, SH = 16, SP = 64;
constexpr float RMS_EPS = 1e-6f;
constexpr int NMOD = 6 * D;

constexpr size_t MiB = 1u << 20;
constexpr size_t WS_CTL = 0, CTL_ZERO_BYTES = 1 * MiB;
constexpr size_t WS_MOD = 1 * MiB;
constexpr size_t WS_AFF = 2 * MiB;
constexpr size_t WS_AFFC = 6 * MiB;
constexpr size_t WS_SELI = 7 * MiB;
constexpr size_t WS_SELG = 8 * MiB;
constexpr size_t WS_INV = 9 * MiB;
constexpr size_t WS_WRT = 14 * MiB;
constexpr size_t WS_CTXS = 16 * MiB;
constexpr size_t WS_WIN = 24 * MiB;
constexpr size_t WS_WOUT = 28 * MiB;
constexpr size_t WS_WGLU = 32 * MiB;
constexpr size_t WS_WPOOL = 33 * MiB;
constexpr size_t WS_WGU = 34 * MiB;
constexpr size_t WS_WD = 162 * MiB;
constexpr size_t WS_HX = 226 * MiB;
constexpr size_t WS_R1 = 358 * MiB;
constexpr size_t WS_R2 = 622 * MiB;
constexpr size_t WS_END = 886 * MiB;
constexpr size_t R1_US5 = 0, R1_VP = 66 * MiB, R1_YG = 132 * MiB, R1_Z = 198 * MiB;

constexpr int LDS_BYTES = 147456;
constexpr int STAGE_OFF = 0, LDSCTL_OFF = 131072, MISC_OFF = LDSCTL_OFF + 320;

__device__ __forceinline__ unsigned f2bf(float f) { unsigned u = __float_as_uint(f); return (u + 0x7fffu + ((u >> 16) & 1u)) >> 16; }
__device__ __forceinline__ unsigned pk2(float lo, float hi) { return f2bf(lo) | (f2bf(hi) << 16); }
__device__ __forceinline__ float bflo(unsigned w) { return __uint_as_float(w << 16); }
__device__ __forceinline__ float bfhi(unsigned w) { return __uint_as_float(w & 0xffff0000u); }
__device__ __forceinline__ float wave_sum(float v) {
#pragma unroll
    for (int o = 1; o < 64; o <<= 1) v += __shfl_xor(v, o);
    return v;
}
__device__ __forceinline__ float sigmoidf_(float x) { return 1.0f / (1.0f + __expf(-x)); }
__device__ __forceinline__ float gelu_tanh(float x) { const float u = 0.7978845608028654f * (x + 0.044715f * x * x * x); return 0.5f * x * (1.0f + tanhf(u)); }

__device__ __forceinline__ int launder(int v) { asm volatile("" : "+v"(v)); return v; }
__device__ __forceinline__ int launder_s(int v) { asm volatile("" : "+s"(v)); return v; }

#define XB_TMO      128
#define XB_XCNT(j)  (256  + 64 * (j))
#define XB_XSUB(j)  (1280 + 64 * (j))
#define XB_XGEN(j)  (2304 + 64 * (j))
#define XB_TOP      3328
#define XB_TOPGEN   3392
#define XCD_BAR_WORDS 3456
#define XB_SPIN_CAP (1u << 18)

__device__ __forceinline__ unsigned xb_ld(unsigned* p)              { return __hip_atomic_load(p, __ATOMIC_RELAXED, __HIP_MEMORY_SCOPE_AGENT); }
__device__ __forceinline__ unsigned xb_add(unsigned* p, unsigned v) { return __hip_atomic_fetch_add(p, v, __ATOMIC_RELAXED, __HIP_MEMORY_SCOPE_AGENT); }
__device__ __forceinline__ unsigned xb_xcc_id() { return (unsigned)__builtin_amdgcn_s_getreg((3 << 11) | 20) & 0xFu; }
#define XB_SPIN(cond, bar) do { unsigned _sp = 0; while (cond) { __builtin_amdgcn_s_sleep(1); \
    if ((++_sp & 255u) == 0u) { if (xb_ld(&(bar)[XB_TMO])) break; if (_sp > XB_SPIN_CAP) { atomicAdd(&(bar)[XB_TMO], 1u); break; } } } } while (0)

struct XcdBarrier { unsigned* bar; unsigned x; volatile LAS unsigned* st; };

__device__ __forceinline__ XcdBarrier xcd_barrier_post(unsigned* bar, volatile LAS unsigned* st) {
    XcdBarrier b; b.bar = bar; b.x = xb_xcc_id(); b.st = st;
    if (threadIdx.x == 0) (void)xb_add(&bar[XB_XCNT(b.x)], 1u);
    return b;
}
__device__ __forceinline__ void xcd_barrier_complete(unsigned* bar, unsigned x, unsigned& nloc, unsigned& nx) {
    const unsigned G = gridDim.x * gridDim.y * gridDim.z;
    unsigned sum, cnt, mine, sp = 0u;
    for (;;) {
        sum = 0u; cnt = 0u; mine = 0u;
#pragma unroll
        for (unsigned j = 0; j < 16; ++j) { const unsigned c = xb_ld(&bar[XB_XCNT(j)]); sum += c; cnt += (c > 0u) ? 1u : 0u; mine = (j == x) ? c : mine; }
        if (sum == G) break;
        __builtin_amdgcn_s_sleep(1);
        if ((++sp & 255u) == 0u) { if (xb_ld(&bar[XB_TMO])) break; if (sp > XB_SPIN_CAP) { atomicAdd(&bar[XB_TMO], 1u); break; } }
    }
    nloc = mine > 0u ? mine : 1u; nx = cnt > 0u ? cnt : 1u;
}
__device__ __forceinline__ void xcd_barrier(const XcdBarrier& b) {
    asm volatile("s_waitcnt vmcnt(0)" ::: "memory");
    __syncthreads();
    if (threadIdx.x == 0) {
        unsigned* bar = b.bar;
        __builtin_amdgcn_s_waitcnt(0);
        unsigned nloc = b.st[0], nx = b.st[1];
        if (nloc == 0u) { xcd_barrier_complete(bar, b.x, nloc, nx); b.st[0] = nloc; b.st[1] = nx; }
        const unsigned old = xb_add(&bar[XB_XSUB(b.x)], 1u);
        const unsigned gen = old / nloc;
        if (old + 1u == (gen + 1u) * nloc) {
            __builtin_amdgcn_fence(__ATOMIC_RELEASE, "agent");
            asm volatile("s_waitcnt vmcnt(0)" ::: "memory");
            const unsigned og = xb_add(&bar[XB_TOP], 1u);
            const unsigned tg = og / nx;
            if (og + 1u == (tg + 1u) * nx) xb_add(&bar[XB_TOPGEN], 1u);
            else XB_SPIN(xb_ld(&bar[XB_TOPGEN]) == tg, bar);
            __builtin_amdgcn_fence(__ATOMIC_ACQUIRE, "agent");
            xb_add(&bar[XB_XGEN(b.x)], 1u);
            asm volatile("s_waitcnt vmcnt(0)" ::: "memory");
        } else {
            XB_SPIN(xb_ld(&bar[XB_XGEN(b.x)]) == gen, bar);
            __builtin_amdgcn_fence(__ATOMIC_ACQUIRE, "agent");
            asm volatile("s_waitcnt vmcnt(0)" ::: "memory");
        }
    }
    __syncthreads();
}

namespace pg8 {
constexpr int BM = 256, BK = 64, HALF = 128, HTB = HALF * BK * 2, STAGE_BYTES = 8 * HTB;
__device__ __forceinline__ int lds_byte(int r, int c) { const int st = (r >> 4) * 2 + (c >> 5), rr = r & 15, cc = c & 31, ob = rr * 64 + cc * 2; return st * 1024 + (ob ^ (((ob >> 9) & 1) << 5)); }
__device__ __forceinline__ void stage_rc(int b, int& R, int& C) { const int st = b / 1024, sb = b % 1024, swz = sb ^ (((sb >> 9) & 1) << 5); R = (st >> 1) * 16 + swz / 64; C = (st & 1) * 32 + (swz % 64) / 2; }
__device__ __forceinline__ int perm32(int rho) { const int n = rho >> 4, i = rho & 15; return 8 * (i >> 2) + 4 * n + (i & 3); }
struct Unit { int pm, pn; };
__device__ __forceinline__ unsigned cvt_pk_bf16(float lo, float hi) { unsigned r; asm volatile("v_cvt_pk_bf16_f32 %0, %1, %2" : "=v"(r) : "v"(lo), "v"(hi)); return r; }

struct LinOrder {
    int nunits, nN, G, c;
    __device__ __forceinline__ bool next(int i, Unit& u) const { const long L = (long)i * G + c; if (L >= nunits) return false; u.pn = (int)(L % nN); u.pm = (int)(L / nN); return true; }
    __device__ __forceinline__ void a_ready(const Unit&) const {}
    __device__ __forceinline__ void done(const Unit&) const {}
};
struct AddrPlain {
    const bf16_t* A; const bf16_t* Bt; int K;
    __device__ __forceinline__ const char* Aof(const Unit& u) const { return (const char*)A + (size_t)u.pm * BM * K * 2; }
    __device__ __forceinline__ const char* Bof(const Unit& u) const { return (const char*)Bt + (size_t)u.pn * BM * K * 2; }
};
struct AddrMoE {
    const bf16_t* A; const bf16_t* W; size_t wstride; int K;
    __device__ __forceinline__ static int expert(int pm) { return pm < (PX / BM) ? ((pm >> 2) & 15) : (pm - PX / BM); }
    __device__ __forceinline__ const char* Aof(const Unit& u) const { return (const char*)A + (size_t)u.pm * BM * K * 2; }
    __device__ __forceinline__ const char* Bof(const Unit& u) const { return (const char*)(W + (size_t)expert(u.pm) * wstride) + (size_t)u.pn * BM * K * 2; }
};

template <class Epi, class Sched, class Addr>
__device__ __forceinline__ void gemm_phase(LAS unsigned char* lds, const Addr g, const Sched& S, const Epi& E) {
    const int tid = launder((int)threadIdx.x), wid = __builtin_amdgcn_readfirstlane(tid >> 6), lane = tid & 63, wr = wid >> 2, wc = wid & 3, fr = lane & 15, fq = lane >> 4;
    const int K = g.K, nt = K / BK;
    unsigned voffA[2], voffB[2];
#pragma unroll
    for (int i = 0; i < 2; ++i) { int R, C; stage_rc(tid * 16 + i * 8192, R, C); const int Rb = ((R & ~31) + perm32(R & 31));
        voffA[i] = (unsigned)(R * K + C) * 2u; voffB[i] = (unsigned)(Rb * K + C) * 2u; }
    const size_t kstep = (size_t)(BK * 2);
    const size_t hstep = (size_t)HALF * K * 2;
    const unsigned ldsw = (unsigned)wid * 1024u;
    const int aoff = lds_byte(wr * 64 + fr, fq * 8), boff = lds_byte(wc * 32 + fr, fq * 8);
#define PG8_SA(b, h) (((b) * 2 + (h)) * HTB)
#define PG8_SB(b, h) ((4 + (b) * 2 + (h)) * HTB)
#define PG8_STAGE(bufoff, gbase, voff) do { _Pragma("unroll") for (int _i = 0; _i < 2; ++_i) \
        __builtin_amdgcn_global_load_lds((const unsigned*)((const char*)(gbase) + (voff)[_i]), (LAS unsigned*)(lds + (bufoff) + ldsw + _i * 8192), 16, 0, 0); } while (0)
#define PG8_LDA(dst, b, h) do { _Pragma("unroll") for (int m = 0; m < 4; ++m) _Pragma("unroll") for (int k = 0; k < 2; ++k) dst[m][k] = *(const LAS bf16x8*)(lds + PG8_SA(b, h) + aoff + m * 2048 + k * 1024); } while (0)
#define PG8_LDB(dst, b, h) do { _Pragma("unroll") for (int n = 0; n < 2; ++n) _Pragma("unroll") for (int k = 0; k < 2; ++k) dst[n][k] = *(const LAS bf16x8*)(lds + PG8_SB(b, h) + boff + n * 2048 + k * 1024); } while (0)
#define PG8_MMA(ai, bj, At, Bt) do { __builtin_amdgcn_s_setprio(1); _Pragma("unroll") for (int m = 0; m < 4; ++m) _Pragma("unroll") for (int n = 0; n < 2; ++n) _Pragma("unroll") for (int k = 0; k < 2; ++k) \
        acc[ai][bj][m][n] = __builtin_amdgcn_mfma_f32_16x16x32_bf16(Bt[n][k], At[m][k], acc[ai][bj][m][n], 0, 0, 0); __builtin_amdgcn_s_setprio(0); } while (0)
#define PG8_WAIT_V(n) asm volatile("s_waitcnt vmcnt(" #n ")" ::: "memory")
#define PG8_WAIT_L(n) asm volatile("s_waitcnt lgkmcnt(" #n ")" ::: "memory")
#define PG8_BAR __builtin_amdgcn_s_barrier()
#define PG8_SCHED __builtin_amdgcn_sched_barrier(0)
    Unit cur, nxt; int ui = 0;
    if (!S.next(0, cur)) return;
    f32x4 acc[2][2][4][2];
#pragma unroll
    for (int a = 0; a < 2; ++a)
#pragma unroll
        for (int b = 0; b < 2; ++b)
#pragma unroll
            for (int m = 0; m < 4; ++m)
#pragma unroll
                for (int n = 0; n < 2; ++n) acc[a][b][m][n] = (f32x4){0.f, 0.f, 0.f, 0.f};
    bf16x8 At[4][2], B0[2][2], B1[2][2];
    const char* cA = g.Aof(cur); const char* cB = g.Bof(cur);
    S.a_ready(cur);
    PG8_STAGE(PG8_SB(0, 0), cB, voffB); PG8_STAGE(PG8_SA(0, 0), cA, voffA); PG8_STAGE(PG8_SB(0, 1), cB + hstep, voffB); PG8_STAGE(PG8_SA(0, 1), cA + hstep, voffA);
    if (wr == 1) PG8_BAR;
    PG8_WAIT_V(4); PG8_BAR;
    PG8_STAGE(PG8_SB(1, 0), cB + kstep, voffB); PG8_STAGE(PG8_SA(1, 0), cA + kstep, voffA); PG8_STAGE(PG8_SB(1, 1), cB + hstep + kstep, voffB);
    PG8_WAIT_V(6); PG8_BAR;
    for (;;) {
        const bool has_next = S.next(ui + 1, nxt);
        const char* nA = has_next ? g.Aof(nxt) : cA; const char* nB = has_next ? g.Bof(nxt) : cB;
        for (int t = 0; t < nt; t += 2) {
            const bool last = (t == nt - 2);
            const char* a1 = cA + (size_t)(t + 1) * kstep;
            const char* a2 = last ? nA : cA + (size_t)(t + 2) * kstep; const char* b2 = last ? nB : cB + (size_t)(t + 2) * kstep;
            const char* a3 = a2 + kstep; const char* b3 = b2 + kstep;
            if (last && has_next) S.a_ready(nxt);
            PG8_LDB(B0, 0, 0); PG8_SCHED; PG8_LDA(At, 0, 0); PG8_STAGE(PG8_SA(1, 1), a1 + hstep, voffA);
            PG8_WAIT_L(8); PG8_BAR; PG8_WAIT_L(0); PG8_MMA(0, 0, At, B0); PG8_BAR; PG8_SCHED;
            PG8_LDB(B1, 0, 1); PG8_STAGE(PG8_SB(0, 0), b2, voffB);
            PG8_BAR; PG8_WAIT_L(0); PG8_MMA(0, 1, At, B1); PG8_BAR;
            PG8_LDA(At, 0, 1); PG8_STAGE(PG8_SA(0, 0), a2, voffA);
            PG8_BAR; PG8_WAIT_L(0); PG8_MMA(1, 0, At, B0); PG8_BAR; PG8_SCHED;
            PG8_STAGE(PG8_SB(0, 1), b2 + hstep, voffB);
            PG8_WAIT_V(6); PG8_BAR; PG8_MMA(1, 1, At, B1); PG8_BAR;
            PG8_LDB(B0, 1, 0); PG8_SCHED; PG8_LDA(At, 1, 0); PG8_STAGE(PG8_SA(0, 1), a2 + hstep, voffA);
            PG8_WAIT_L(8); PG8_BAR; PG8_WAIT_L(0); PG8_MMA(0, 0, At, B0); PG8_BAR; PG8_SCHED;
            PG8_LDB(B1, 1, 1); PG8_STAGE(PG8_SB(1, 0), b3, voffB);
            PG8_BAR; PG8_WAIT_L(0); PG8_MMA(0, 1, At, B1); PG8_BAR;
            PG8_LDA(At, 1, 1); PG8_STAGE(PG8_SA(1, 0), a3, voffA);
            PG8_BAR; PG8_WAIT_L(0); PG8_MMA(1, 0, At, B0); PG8_BAR; PG8_SCHED;
            PG8_STAGE(PG8_SB(1, 1), b3 + hstep, voffB);
            PG8_WAIT_V(6); PG8_BAR; PG8_MMA(1, 1, At, B1); PG8_BAR;
        }
        E(acc, cur, wr, wc, fr, fq); S.done(cur);
        if (!has_next) break;
#pragma unroll
        for (int a = 0; a < 2; ++a)
#pragma unroll
            for (int b = 0; b < 2; ++b)
#pragma unroll
                for (int m = 0; m < 4; ++m)
#pragma unroll
                    for (int n = 0; n < 2; ++n) acc[a][b][m][n] = (f32x4){0.f, 0.f, 0.f, 0.f};
        cur = nxt; cA = nA; cB = nB; ++ui;
    }
    PG8_WAIT_V(0);
    if (wr == 0) PG8_BAR;
    PG8_BAR;
#undef PG8_SA
#undef PG8_SB
#undef PG8_STAGE
#undef PG8_LDA
#undef PG8_LDB
#undef PG8_MMA
#undef PG8_WAIT_V
#undef PG8_WAIT_L
#undef PG8_BAR
#undef PG8_SCHED
}

typedef f32x4 Acc[2][2][4][2];
__device__ __forceinline__ u32x4 pack8(const f32x4& v0, const f32x4& v1) { u32x4 w; w.x = cvt_pk_bf16(v0[0], v0[1]); w.y = cvt_pk_bf16(v0[2], v0[3]); w.z = cvt_pk_bf16(v1[0], v1[1]); w.w = cvt_pk_bf16(v1[2], v1[3]); return w; }

struct EpiPlain {
    bf16_t* O; int ldc;
    __device__ __forceinline__ void operator()(const Acc& acc, const Unit& u, int wr, int wc, int fr, int fq) const {
        const int row0 = u.pm * BM + wr * 64 + fr, col0 = u.pn * BM + wc * 32 + 8 * fq;
#pragma unroll
        for (int ai = 0; ai < 2; ++ai)
#pragma unroll
            for (int m = 0; m < 4; ++m) { bf16_t* rowp = O + (size_t)(row0 + ai * HALF + m * 16) * ldc + col0;
#pragma unroll
                for (int bj = 0; bj < 2; ++bj) *(u32x4*)(rowp + bj * HALF) = pack8(acc[ai][bj][m][0], acc[ai][bj][m][1]); }
    }
};
struct EpiWin {
    bf16_t* Us5; bf16_t* Vp;
    __device__ __forceinline__ void operator()(const Acc& acc, const Unit& u, int wr, int wc, int fr, int fq) const {
        const int row0 = u.pm * BM + wr * 64 + fr, col0 = u.pn * BM + wc * 32 + 8 * fq;
#pragma unroll
        for (int ai = 0; ai < 2; ++ai)
#pragma unroll
            for (int m = 0; m < 4; ++m) { const int r = row0 + ai * HALF + m * 16; int b, n;
                if (r < MX) { b = r >> 13; n = LC + (r & (T - 1)); } else { const int rc = r - MX; b = rc >> 8; n = rc & (LC - 1); }
#pragma unroll
                for (int bj = 0; bj < 2; ++bj) { const int c = col0 + bj * HALF; const u32x4 w = pack8(acc[ai][bj][m][0], acc[ai][bj][m][1]);
                    if (u.pn < 2) { const int gi = c >> 4, half = (c >> 3) & 1; *(u32x4*)(Us5 + ((size_t)(b * NG + gi) * NSEQ + n) * 16 + 8 * half) = w; }
                    else *(u32x4*)(Vp + (size_t)r * 512 + (c - 512)) = w; } }
    }
};
struct EpiGlu {
    const bf16_t* Yg; bf16_t* O;
    __device__ __forceinline__ void operator()(const Acc& acc, const Unit& u, int wr, int wc, int fr, int fq) const {
        const int row0 = u.pm * BM + wr * 64 + fr, col0 = u.pn * BM + wc * 32 + 8 * fq;
#pragma unroll
        for (int ai = 0; ai < 2; ++ai)
#pragma unroll
            for (int m = 0; m < 4; ++m) { const int r = row0 + ai * HALF + m * 16;
#pragma unroll
                for (int bj = 0; bj < 2; ++bj) { const int c = col0 + bj * HALF; const u32x4 y = *(const u32x4*)(Yg + (size_t)r * 512 + c);
                    f32x4 v0 = acc[ai][bj][m][0], v1 = acc[ai][bj][m][1];
                    v0[0] = bflo(y.x) * sigmoidf_(v0[0]); v0[1] = bfhi(y.x) * sigmoidf_(v0[1]); v0[2] = bflo(y.y) * sigmoidf_(v0[2]); v0[3] = bfhi(y.y) * sigmoidf_(v0[3]);
                    v1[0] = bflo(y.z) * sigmoidf_(v1[0]); v1[1] = bfhi(y.z) * sigmoidf_(v1[1]); v1[2] = bflo(y.w) * sigmoidf_(v1[2]); v1[3] = bfhi(y.w) * sigmoidf_(v1[3]);
                    *(u32x4*)(O + (size_t)r * 1024 + c) = pack8(v0, v1); } }
    }
};
struct EpiPoolS {
    const float* scale; bf16_t* O;
    __device__ __forceinline__ void operator()(const Acc& acc, const Unit& u, int wr, int wc, int fr, int fq) const {
        const int row0 = u.pm * BM + wr * 64 + fr, col0 = u.pn * BM + wc * 32 + 8 * fq;
        f32x4 s[2][2];
#pragma unroll
        for (int bj = 0; bj < 2; ++bj) { s[bj][0] = *(const f32x4*)(scale + col0 + bj * HALF); s[bj][1] = *(const f32x4*)(scale + col0 + bj * HALF + 4); }
#pragma unroll
        for (int ai = 0; ai < 2; ++ai)
#pragma unroll
            for (int m = 0; m < 4; ++m) { const int r = row0 + ai * HALF + m * 16;
#pragma unroll
                for (int bj = 0; bj < 2; ++bj) { const int c = col0 + bj * HALF;
                    *(u32x4*)(O + (size_t)r * 1024 + 512 + c) = pack8(acc[ai][bj][m][0] * s[bj][0], acc[ai][bj][m][1] * s[bj][1]); } }
    }
};
struct EpiSwiglu {
    bf16_t* H;
    __device__ __forceinline__ void operator()(const Acc& acc, const Unit& u, int wr, int wc, int fr, int fq) const {
        const int row0 = u.pm * BM + wr * 64 + fr, col0 = u.pn * HALF + wc * 32 + 8 * fq;
#pragma unroll
        for (int ai = 0; ai < 2; ++ai)
#pragma unroll
            for (int m = 0; m < 4; ++m) { const int r = row0 + ai * HALF + m * 16; f32x4 o[2];
#pragma unroll
                for (int n = 0; n < 2; ++n)
#pragma unroll
                    for (int j = 0; j < 4; ++j) { const float a = acc[ai][0][m][n][j], gq = acc[ai][1][m][n][j]; o[n][j] = a * sigmoidf_(a) * gq; }
                *(u32x4*)(H + (size_t)r * 1024 + col0) = pack8(o[0], o[1]); }
    }
};
struct EpiDown {
    const float* gate; bf16_t* O;
    __device__ __forceinline__ void operator()(const Acc& acc, const Unit& u, int wr, int wc, int fr, int fq) const {
        const int row0 = u.pm * BM + wr * 64 + fr, col0 = u.pn * BM + wc * 32 + 8 * fq;
#pragma unroll
        for (int ai = 0; ai < 2; ++ai)
#pragma unroll
            for (int m = 0; m < 4; ++m) { const int r = row0 + ai * HALF + m * 16; const float gt = gate[r];
#pragma unroll
                for (int bj = 0; bj < 2; ++bj) *(u32x4*)(O + (size_t)r * 1024 + col0 + bj * HALF) = pack8(acc[ai][bj][m][0] * gt, acc[ai][bj][m][1] * gt); }
    }
};
}

struct Frame {
    LAS unsigned char* lds;
    int tid, lane, wave, vcu, G;
    float* out; unsigned char* ws;
};
struct Args { const float* in[27]; float* out; unsigned char* ws; int ph_lo, ph_hi; };

enum { I_X = 0, I_C, I_CTX, I_CCTX, I_WMOD, I_BMOD, I_GMPRE, I_GMPOST, I_GFPRE, I_GFPOST, I_WIN, I_LRE, I_LIM, I_LDT, I_BRE, I_BIM, I_CRE, I_CIM, I_S5D, I_WGLU, I_POOLW, I_POOLS, I_WOUT, I_WROUTER, I_WGATE, I_WUP, I_WDOWN };

__device__ __forceinline__ void tr_item(const float* W, int ldw, bf16_t* WT, int ldt, int k0, int n0, int drow0, int dk0, LAS float* scr, int lane) {
#pragma unroll 8
    for (int i = 0; i < 32; ++i) { const int kk = 2 * i + (lane >> 5); scr[kk * 33 + (lane & 31)] = W[(size_t)(k0 + kk) * ldw + n0 + (lane & 31)]; }
    asm volatile("s_waitcnt lgkmcnt(0)" ::: "memory");
    const int c = lane & 7;
#pragma unroll
    for (int j = 0; j < 4; ++j) { const int n = (lane >> 3) + 8 * j; const LAS float* s = scr + (8 * c) * 33 + n;
        u32x4 o; o.x = pk2(s[0 * 33], s[1 * 33]); o.y = pk2(s[2 * 33], s[3 * 33]); o.z = pk2(s[4 * 33], s[5 * 33]); o.w = pk2(s[6 * 33], s[7 * 33]);
        *(u32x4*)(WT + (size_t)(drow0 + n) * ldt + dk0 + k0 + 8 * c) = o; }
    asm volatile("s_waitcnt lgkmcnt(0)" ::: "memory");
}
__device__ __forceinline__ void p0_prologue(Frame& F, const Args& A) {
    unsigned char* ws = F.ws;
    const int gw = F.vcu * 8 + F.wave, NGW = F.G * 8;
    LAS float* sil = (LAS float*)(F.lds);
    for (int i = F.tid; i < 9 * 1024; i += 512) { const float v = (i < 8192) ? A.in[I_C][i] : A.in[I_CCTX][i - 8192]; sil[i] = v * sigmoidf_(v); }
    __syncthreads();
    LAS float* scr = (LAS float*)(F.lds + 40960 + F.wave * 8448);
    float* mod = (float*)(ws + WS_MOD);
    for (int it = gw; it < 2 * 96; it += NGW) {
        const int l = it / 96, n = (it % 96) * 64 + F.lane;
        const float* W = A.in[I_WMOD] + (size_t)l * D * NMOD + n;
        float acc[9];
#pragma unroll
        for (int r = 0; r < 9; ++r) acc[r] = 0.f;
#pragma unroll 4
        for (int k = 0; k < D; ++k) { const float w = W[(size_t)k * NMOD];
#pragma unroll
            for (int r = 0; r < 9; ++r) acc[r] += sil[r * 1024 + k] * w; }
        const float bm = A.in[I_BMOD][l * NMOD + n];
#pragma unroll
        for (int r = 0; r < 9; ++r) mod[((size_t)l * 9 + r) * NMOD + n] = acc[r] + bm;
    }
    constexpr int IT_SQ = 16 * 32;
    constexpr int IT_GLU = 8 * 16, IT_POOL = 4 * 2 * 4;
    constexpr int PER_L = 2 * IT_SQ + IT_GLU + IT_POOL;
    constexpr int N_SMALL = 2 * PER_L;
    constexpr int N_GU = 2 * 16 * 2 * IT_SQ, N_D = 2 * 16 * IT_SQ;
    for (int it = gw; it < N_SMALL + N_GU + N_D; it += NGW) {
        int r = it;
        if (r < N_SMALL) {
            const int l = r / PER_L; r -= l * PER_L;
            if (r < IT_SQ) { const int kb = r / 32, nb = r % 32; tr_item(A.in[I_WIN] + (size_t)l * D * D, D, (bf16_t*)(ws + WS_WIN) + (size_t)l * D * D, D, kb * 64, nb * 32, nb * 32, 0, scr, F.lane); continue; }
            r -= IT_SQ;
            if (r < IT_SQ) { const int kb = r / 32, nb = r % 32; tr_item(A.in[I_WOUT] + (size_t)l * D * D, D, (bf16_t*)(ws + WS_WOUT) + (size_t)l * D * D, D, kb * 64, nb * 32, nb * 32, 0, scr, F.lane); continue; }
            r -= IT_SQ;
            if (r < IT_GLU) { const int kb = r / 16, nb = r % 16; tr_item(A.in[I_WGLU] + (size_t)l * DS5 * DS5, DS5, (bf16_t*)(ws + WS_WGLU) + (size_t)l * DS5 * DS5, DS5, kb * 64, nb * 32, nb * 32, 0, scr, F.lane); continue; }
            r -= IT_GLU;
            { const int gi = r / 8, q = r % 8, kb = q / 4, nb = q % 4;
              tr_item(A.in[I_POOLW] + ((size_t)l * 4 + gi) * 128 * 128, 128, (bf16_t*)(ws + WS_WPOOL) + (size_t)l * 512 * 512, 512, kb * 64, nb * 32, gi * 128 + nb * 32, gi * 128, scr, F.lane); continue; }
        }
        r -= N_SMALL;
        if (r < N_GU) {
            const int le = r / (2 * IT_SQ); int q = r % (2 * IT_SQ); const int up = q / IT_SQ; q %= IT_SQ; const int kb = q / 32, nb = q % 32, n0 = nb * 32;
            const float* W = (up ? A.in[I_WUP] : A.in[I_WGATE]) + (size_t)le * D * D;
            tr_item(W, D, (bf16_t*)(ws + WS_WGU) + (size_t)le * 2048 * D, D, kb * 64, n0, 256 * (n0 / 128) + (n0 % 128) + up * 128, 0, scr, F.lane); continue;
        }
        r -= N_GU;
        { const int le = r / IT_SQ, q = r % IT_SQ, kb = q / 32, nb = q % 32;
          tr_item(A.in[I_WDOWN] + (size_t)le * D * D, D, (bf16_t*)(ws + WS_WD) + (size_t)le * D * D, D, kb * 64, nb * 32, nb * 32, 0, scr, F.lane); }
    }
    const int gt = F.vcu * 512 + F.tid, NGT = F.G * 512;
    for (int i = gt; i < 2 * 512 * 64; i += NGT) { const int row = (i / 64) % 512, c8 = i % 64; if ((row >> 7) != (c8 >> 4)) *(u32x4*)((bf16_t*)(ws + WS_WPOOL) + (size_t)i * 8) = (u32x4){0u, 0u, 0u, 0u}; }
    for (int i = gt; i < 2 * 16 * 1024; i += NGT) { const int l = i / 16384, e = (i / 1024) % 16, k = i % 1024; ((float*)(ws + WS_WRT))[i] = A.in[I_WROUTER][((size_t)l * D + k) * NE + e]; }
}

__device__ __forceinline__ void p1_norm(Frame& F, const Args& A, int l, const float* xsrc, const float* csrc) {
    const int gw = F.vcu * 8 + F.wave, NGW = F.G * 8;
    const float* gpre = A.in[I_GMPRE] + l * D; const float* mod = (const float*)(F.ws + WS_MOD) + (size_t)l * 9 * NMOD;
    bf16_t* hx = (bf16_t*)(F.ws + WS_HX);
    for (int row = gw; row < MT; row += NGW) {
        const float* src = row < MX ? xsrc + (size_t)row * D : csrc + (size_t)(row - MX) * D;
        const int bi = row < MX ? (row >> 13) : 8;
        const float* mb = mod + (size_t)bi * NMOD;
        f32x4 v[4]; float ss = 0.f;
#pragma unroll
        for (int j = 0; j < 4; ++j) { v[j] = *(const f32x4*)(src + 4 * F.lane + 256 * j); ss += v[j][0] * v[j][0] + v[j][1] * v[j][1] + v[j][2] * v[j][2] + v[j][3] * v[j][3]; }
        const float rstd = rsqrtf(wave_sum(ss) * (1.0f / D) + RMS_EPS);
#pragma unroll
        for (int j = 0; j < 4; ++j) { const int col = 4 * F.lane + 256 * j;
            const f32x4 gv = *(const f32x4*)(gpre + col), sh = *(const f32x4*)(mb + col), sc = *(const f32x4*)(mb + D + col);
            f32x4 o;
#pragma unroll
            for (int q = 0; q < 4; ++q) o[q] = v[j][q] * rstd * gv[q] * (1.0f + sc[q]) + sh[q];
            u32x2 w; w.x = pk2(o[0], o[1]); w.y = pk2(o[2], o[3]);
            *(u32x2*)(hx + (size_t)row * D + col) = w; }
    }
}

__device__ __forceinline__ float reduce16(float (&v)[16], int lane) {
#pragma unroll
    for (int i = 0; i < 8; ++i) { const float send = (lane & 32) ? v[i] : v[i + 8], keep = (lane & 32) ? v[i + 8] : v[i]; v[i] = keep + __shfl_xor(send, 32); }
#pragma unroll
    for (int i = 0; i < 4; ++i) { const float send = (lane & 16) ? v[i] : v[i + 4], keep = (lane & 16) ? v[i + 4] : v[i]; v[i] = keep + __shfl_xor(send, 16); }
#pragma unroll
    for (int i = 0; i < 2; ++i) { const float send = (lane & 8) ? v[i] : v[i + 2], keep = (lane & 8) ? v[i + 2] : v[i]; v[i] = keep + __shfl_xor(send, 8); }
    { const float send = (lane & 4) ? v[0] : v[1], keep = (lane & 4) ? v[1] : v[0]; v[0] = keep + __shfl_xor(send, 4); }
    v[0] += __shfl_xor(v[0], 2); v[0] += __shfl_xor(v[0], 1);
    return v[0];
}
__device__ __forceinline__ void s5_naive(Frame& F, const Args& A, int l) {
    const int gw = F.vcu * 8 + F.wave, NGW = F.G * 8, lane = F.lane;
    const bf16_t* Us5 = (const bf16_t*)(F.ws + WS_R1 + R1_US5);
    bf16_t* Yg = (bf16_t*)(F.ws + WS_R1 + R1_YG);
    float* YR = (float*)(F.ws + WS_R2);
    const int hidx = ((lane >> 5) & 1) * 8 + ((lane >> 4) & 1) * 4 + ((lane >> 3) & 1) * 2 + ((lane >> 2) & 1);
    for (int bg = gw; bg < NB * NG; bg += NGW) {
        const int b = bg / NG, g = bg % NG;
        const bf16_t* useq = Us5 + (size_t)bg * NSEQ * 16;
        float* yrs = YR + (size_t)bg * NSEQ * 16;
        for (int dir = 1; dir >= 0; --dir) {
            const size_t pg = ((size_t)(l * 2 + dir) * NG + g);
            const float lre = A.in[I_LRE][pg * SP + lane], lim = A.in[I_LIM][pg * SP + lane], dt = __expf(A.in[I_LDT][pg]);
            const float mag = __expf(lre * dt); float sn, cs; sincosf(lim * dt, &sn, &cs);
            const float are = mag * cs, aim = mag * sn;
            const float nre = are - 1.0f, nim = aim, den = lre * lre + lim * lim;
            const float cre_ = (nre * lre + nim * lim) / den, cim_ = (nim * lre - nre * lim) / den;
            float Bre[16], Bim[16], Cre[16], Cim[16];
#pragma unroll
            for (int h = 0; h < 16; ++h) { const float br = A.in[I_BRE][(pg * SP + lane) * SH + h], bi = A.in[I_BIM][(pg * SP + lane) * SH + h];
                Bre[h] = cre_ * br - cim_ * bi; Bim[h] = cre_ * bi + cim_ * br;
                Cre[h] = A.in[I_CRE][(pg * SH + h) * SP + lane]; Cim[h] = A.in[I_CIM][(pg * SH + h) * SP + lane]; }
            const float dsk = A.in[I_S5D][l * DS5 + g * 16 + hidx];
            float hre = 0.f, him = 0.f;
            for (int s = 0; s < NSEQ; ++s) {
                int n;
                if (dir == 0) n = s; else n = (s < LC) ? (LC - 1 - s) : (NSEQ - 1 - (s - LC));
                const u32x4 u0 = *(const u32x4*)(useq + (size_t)n * 16), u1 = *(const u32x4*)(useq + (size_t)n * 16 + 8);
                float u[16];
                u[0] = bflo(u0.x); u[1] = bfhi(u0.x); u[2] = bflo(u0.y); u[3] = bfhi(u0.y); u[4] = bflo(u0.z); u[5] = bfhi(u0.z); u[6] = bflo(u0.w); u[7] = bfhi(u0.w);
                u[8] = bflo(u1.x); u[9] = bfhi(u1.x); u[10] = bflo(u1.y); u[11] = bfhi(u1.y); u[12] = bflo(u1.z); u[13] = bfhi(u1.z); u[14] = bflo(u1.w); u[15] = bfhi(u1.w);
                float bur = 0.f, bui = 0.f;
#pragma unroll
                for (int h = 0; h < 16; ++h) { bur += Bre[h] * u[h]; bui += Bim[h] * u[h]; }
                const float nr = are * hre - aim * him + bur, ni = are * him + aim * hre + bui;
                hre = nr; him = ni;
                float v[16];
#pragma unroll
                for (int h = 0; h < 16; ++h) v[h] = Cre[h] * hre - Cim[h] * him;
                const float tot = reduce16(v, lane);
                if (dir == 1) { if ((lane & 3) == 0) yrs[(size_t)n * 16 + hidx] = tot; }
                else if ((lane & 3) == 0) {
                    float uh = u[0];
#pragma unroll
                    for (int h = 1; h < 16; ++h) uh = (hidx == h) ? u[h] : uh;
                    const float y = dsk * uh + tot + yrs[(size_t)n * 16 + hidx];
                    const float ge = gelu_tanh(y);
                    const int row = (n < LC) ? (MX + b * LC + n) : (b * T + (n - LC));
                    Yg[(size_t)row * 512 + g * 16 + hidx] = (bf16_t)f2bf(ge);
                }
            }
        }
    }
}
__device__ __forceinline__ void pool_naive(Frame& F, bool with_ctx) {
    const int gw = F.vcu * 8 + F.wave, NGW = F.G * 8, lane = F.lane;
    const bf16_t* Vp = (const bf16_t*)(F.ws + WS_R1 + R1_VP);
    bf16_t* Z = (bf16_t*)(F.ws + WS_R1 + R1_Z);
    const int nrows = with_ctx ? MT : MX;
    for (int it = gw; it < nrows * 4; it += NGW) {
        const int row = it >> 2, i = it & 3, w = 2 << i, hw = w >> 1;
        const int cho = i * 128 + 2 * lane;
        float s0 = 0.f, s1 = 0.f; int cnt;
        if (row < MX) {
            const int b = row >> 13, t = row & (T - 1), r = t >> 6, c = t & 63;
            const int r0 = max(r - hw, 0), r1 = min(r + hw, 128), c0 = max(c - hw, 0), c1 = min(c + hw, 64);
            for (int rr = r0; rr < r1; ++rr) for (int cc = c0; cc < c1; ++cc) { const unsigned x = *(const unsigned*)(Vp + (size_t)(b * T + rr * 64 + cc) * 512 + cho); s0 += bflo(x); s1 += bfhi(x); }
            cnt = (r1 - r0) * (c1 - c0);
        } else {
            const int rc = row - MX, b = rc >> 8, p = rc & 255;
            const int p0 = max(p - hw, 0), p1 = min(p + hw, LC);
            for (int pp = p0; pp < p1; ++pp) { const unsigned x = *(const unsigned*)(Vp + (size_t)(MX + b * LC + pp) * 512 + cho); s0 += bflo(x); s1 += bfhi(x); }
            cnt = p1 - p0;
        }
        const unsigned xs = *(const unsigned*)(Vp + (size_t)row * 512 + cho);
        const float inv = 1.0f / (float)cnt;
        *(unsigned*)(Z + (size_t)row * 512 + cho) = pk2(s0 * inv - bflo(xs), s1 * inv - bfhi(xs));
    }
}

__device__ __forceinline__ void p6_rows(Frame& F, const Args& A, int l, const float* xsrc, float* xdst, const float* csrc, float* cdst, bool with_ctx) {
    const int gw = F.vcu * 8 + F.wave, NGW = F.G * 8, lane = F.lane;
    LAS float* wr_ = (LAS float*)F.lds;
    const float* wrt = (const float*)(F.ws + WS_WRT) + (size_t)l * 16 * 1024;
    for (int i = F.tid; i < 16 * 1024; i += 512) wr_[i] = wrt[i];
    __syncthreads();
    const float* gpost = A.in[I_GMPOST] + l * D; const float* gpre = A.in[I_GFPRE] + l * D;
    const float* mod = (const float*)(F.ws + WS_MOD) + (size_t)l * 9 * NMOD;
    const bf16_t* mix = (const bf16_t*)(F.ws + WS_R1);
    bf16_t* hx2 = (bf16_t*)(F.ws + WS_HX);
    float* aff = (float*)(F.ws + WS_AFF); float* affc = (float*)(F.ws + WS_AFFC);
    const int nrows = with_ctx ? MT : MX;
    for (int row = gw; row < nrows; row += NGW) {
        const bool isx = row < MX;
        const float* src = isx ? xsrc + (size_t)row * D : csrc + (size_t)(row - MX) * D;
        float* dst = isx ? xdst + (size_t)row * D : cdst + (size_t)(row - MX) * D;
        const int bi = isx ? (row >> 13) : 8;
        const float* mb = mod + (size_t)bi * NMOD;
        f32x4 mv[4], xv[4]; float ss = 0.f;
#pragma unroll
        for (int j = 0; j < 4; ++j) { const int col = 4 * lane + 256 * j; const u32x2 m2 = *(const u32x2*)(mix + (size_t)row * D + col);
            mv[j] = (f32x4){bflo(m2.x), bfhi(m2.x), bflo(m2.y), bfhi(m2.y)}; xv[j] = *(const f32x4*)(src + col);
            ss += mv[j][0] * mv[j][0] + mv[j][1] * mv[j][1] + mv[j][2] * mv[j][2] + mv[j][3] * mv[j][3]; }
        const float rstd = rsqrtf(wave_sum(ss) * (1.0f / D) + RMS_EPS);
        float ss2 = 0.f;
#pragma unroll
        for (int j = 0; j < 4; ++j) { const int col = 4 * lane + 256 * j; const f32x4 gp = *(const f32x4*)(gpost + col), gt = *(const f32x4*)(mb + 2 * D + col);
#pragma unroll
            for (int q = 0; q < 4; ++q) { xv[j][q] = xv[j][q] + gt[q] * (mv[j][q] * rstd * gp[q]); ss2 += xv[j][q] * xv[j][q]; }
            *(f32x4*)(dst + col) = xv[j]; }
        const float rstd2 = rsqrtf(wave_sum(ss2) * (1.0f / D) + RMS_EPS);
        float lg[16];
#pragma unroll
        for (int j = 0; j < 4; ++j) { const int col = 4 * lane + 256 * j; const f32x4 gv = *(const f32x4*)(gpre + col), sh = *(const f32x4*)(mb + 3 * D + col), sc = *(const f32x4*)(mb + 4 * D + col);
#pragma unroll
            for (int q = 0; q < 4; ++q) xv[j][q] = xv[j][q] * rstd2 * gv[q] * (1.0f + sc[q]) + sh[q];
            u32x2 w; w.x = pk2(xv[j][0], xv[j][1]); w.y = pk2(xv[j][2], xv[j][3]);
            *(u32x2*)(hx2 + (size_t)row * D + col) = w; }
        float mx = -3.0e38f;
#pragma unroll
        for (int e = 0; e < 16; ++e) { float p = 0.f;
#pragma unroll
            for (int j = 0; j < 4; ++j) { const f32x4 wv = *(const LAS f32x4*)(wr_ + e * 1024 + 4 * lane + 256 * j); p += xv[j][0] * wv[0] + xv[j][1] * wv[1] + xv[j][2] * wv[2] + xv[j][3] * wv[3]; }
            lg[e] = wave_sum(p); mx = fmaxf(mx, lg[e]);
            if (e & 1) asm volatile("" ::: "memory"); }
        float se = 0.f;
#pragma unroll
        for (int e = 0; e < 16; ++e) { lg[e] = __expf(lg[e] - mx); se += lg[e]; }
        const float inv = 1.0f / se;
        float mine = lg[0];
#pragma unroll
        for (int e = 1; e < 16; ++e) mine = (lane == e) ? lg[e] : mine;
        if (lane < 16) {
            if (isx) aff[((size_t)(bi * 16 + lane)) * T + (row & (T - 1))] = mine * inv;
            else { const int rc = row - MX, b = rc >> 8, p = rc & 255; affc[((size_t)(lane * 8 + b)) * LC + p] = mine * inv; }
        }
    }
}

__device__ __forceinline__ int block_sum_i(int v, LAS int* red, int wave, int lane) {
#pragma unroll
    for (int o = 1; o < 64; o <<= 1) v += __shfl_xor(v, o);
    __syncthreads();
    if (lane == 0) red[wave] = v;
    __syncthreads();
    int s = 0;
#pragma unroll
    for (int w = 0; w < 8; ++w) s += red[w];
    return s;
}
__device__ __forceinline__ void p7_topk(Frame& F, bool with_ctx) {
    LAS int* red = (LAS int*)F.lds;
    LAS int* wtot = (LAS int*)(F.lds + 64);
    const float* aff = (const float*)(F.ws + WS_AFF); const float* affc = (const float*)(F.ws + WS_AFFC);
    int* seli = (int*)(F.ws + WS_SELI); float* selg = (float*)(F.ws + WS_SELG); int* inv = (int*)(F.ws + WS_INV);
    const int nprob = with_ctx ? 256 : 128;
    for (int q = F.vcu; q < nprob; q += F.G) {
        const float* src; int n, cap, pbase, rbase, e;
        if (q < 128) { src = aff + (size_t)q * T; n = T; cap = CAPX; pbase = q * CAPX; rbase = (q >> 4) * T; e = q & 15; }
        else { const int qq = q - 128; src = affc + (size_t)qq * LC; n = LC; cap = CAPC; pbase = PX + qq * CAPC; rbase = MX + (qq & 7) * LC; e = qq >> 3; }
        const int t0 = F.tid * 16;
        unsigned key[16]; const bool valid = t0 < n;
#pragma unroll
        for (int i = 0; i < 16; ++i) key[i] = 0u;
        if (valid) {
#pragma unroll
            for (int i4 = 0; i4 < 4; ++i4) { const f32x4 v = *(const f32x4*)(src + t0 + 4 * i4);
#pragma unroll
                for (int j = 0; j < 4; ++j) key[i4 * 4 + j] = __float_as_uint(v[j]); }
        }
        unsigned cur = 0u;
        for (int bit = 31; bit >= 0; --bit) {
            const unsigned cand = cur | (1u << bit); int c = 0;
#pragma unroll
            for (int i = 0; i < 16; ++i) c += (key[i] >= cand) ? 1 : 0;
            const int tot = block_sum_i(c, red, F.wave, F.lane);
            if (tot >= cap) cur = cand;
        }
        int cg = 0, ce = 0;
#pragma unroll
        for (int i = 0; i < 16; ++i) { cg += (key[i] > cur) ? 1 : 0; ce += (valid && key[i] == cur) ? 1 : 0; }
        const int ngt = block_sum_i(cg, red, F.wave, F.lane);
        const int need = cap - ngt;
        int x = cg | (ce << 16);
        int incl = x;
#pragma unroll
        for (int o = 1; o < 64; o <<= 1) { const int y = __shfl_up(incl, o); if (F.lane >= o) incl += y; }
        __syncthreads();
        if (F.lane == 63) wtot[F.wave] = incl;
        __syncthreads();
        int wpre = 0;
#pragma unroll
        for (int w = 0; w < 8; ++w) wpre += (w < F.wave) ? wtot[w] : 0;
        const int excl = wpre + incl - x;
        int pg = excl & 0xffff, pe = excl >> 16;
        if (valid) {
#pragma unroll
            for (int i = 0; i < 16; ++i) {
                const bool gt = key[i] > cur, eq = key[i] == cur;
                const bool sel = gt || (eq && pe < need);
                const int slot = pg + min(pe, need);
                const int trow = rbase + t0 + i;
                if (sel) { seli[pbase + slot] = trow; selg[pbase + slot] = __uint_as_float(key[i]); inv[(size_t)trow * 16 + e] = pbase + slot; }
                else inv[(size_t)trow * 16 + e] = -1;
                pg += gt ? 1 : 0; pe += eq ? 1 : 0;
            }
        }
        __syncthreads();
    }
}

__device__ __forceinline__ void p8a_gather(Frame& F, bool with_ctx) {
    const int gw = F.vcu * 8 + F.wave, NGW = F.G * 8, lane = F.lane;
    const int* seli = (const int*)(F.ws + WS_SELI);
    const bf16_t* hx2 = (const bf16_t*)(F.ws + WS_HX); bf16_t* Xg = (bf16_t*)(F.ws + WS_R2);
    const int np = with_ctx ? PT : PX;
    for (int pr = gw; pr < np; pr += NGW) {
        const int tr = seli[pr];
        const u32x4* s = (const u32x4*)(hx2 + (size_t)tr * D); u32x4* d = (u32x4*)(Xg + (size_t)pr * D);
        const u32x4 a = s[lane], b = s[lane + 64]; d[lane] = a; d[lane + 64] = b;
    }
}

__device__ __forceinline__ void p10_combine(Frame& F, const Args& A, int l, float* xio, float* cio, bool with_ctx) {
    const int gw = F.vcu * 8 + F.wave, NGW = F.G * 8, lane = F.lane;
    const int* inv = (const int*)(F.ws + WS_INV); const bf16_t* Yd = (const bf16_t*)(F.ws + WS_R2);
    const float* gpost = A.in[I_GFPOST] + l * D; const float* mod = (const float*)(F.ws + WS_MOD) + (size_t)l * 9 * NMOD;
    const int nrows = with_ctx ? MT : MX;
    for (int row = gw; row < nrows; row += NGW) {
        const bool isx = row < MX;
        float* xr = isx ? xio + (size_t)row * D : cio + (size_t)(row - MX) * D;
        const int bi = isx ? (row >> 13) : 8;
        const float* mb = mod + (size_t)bi * NMOD;
        f32x4 acc[4];
#pragma unroll
        for (int j = 0; j < 4; ++j) acc[j] = (f32x4){0.f, 0.f, 0.f, 0.f};
        const int myinv = (lane < 16) ? inv[(size_t)row * 16 + lane] : -1;
        for (int e = 0; e < 16; ++e) {
            const int pr = __shfl(myinv, e);
            if (pr >= 0) {
#pragma unroll
                for (int j = 0; j < 4; ++j) { const u32x2 y = *(const u32x2*)(Yd + (size_t)pr * D + 4 * lane + 256 * j);
                    acc[j][0] += bflo(y.x); acc[j][1] += bfhi(y.x); acc[j][2] += bflo(y.y); acc[j][3] += bfhi(y.y); }
            }
        }
        float ss = 0.f;
#pragma unroll
        for (int j = 0; j < 4; ++j) ss += acc[j][0] * acc[j][0] + acc[j][1] * acc[j][1] + acc[j][2] * acc[j][2] + acc[j][3] * acc[j][3];
        const float rstd = rsqrtf(wave_sum(ss) * (1.0f / D) + RMS_EPS);
#pragma unroll
        for (int j = 0; j < 4; ++j) { const int col = 4 * lane + 256 * j; const f32x4 gp = *(const f32x4*)(gpost + col), gt = *(const f32x4*)(mb + 5 * D + col);
            f32x4 xv = *(const f32x4*)(xr + col);
#pragma unroll
            for (int q = 0; q < 4; ++q) xv[q] += gt[q] * (acc[j][q] * rstd * gp[q]);
            *(f32x4*)(xr + col) = xv; }
    }
}

constexpr int NPL = 11, NPHASE = 1 + 2 * NPL;
__global__ void __launch_bounds__(512, 2) fwd(Args args) {
    extern __shared__ __attribute__((aligned(16))) unsigned char lds_raw[];
    Frame F;
    F.lds = (LAS unsigned char*)lds_raw;
    F.tid = threadIdx.x; F.lane = F.tid & 63; F.wave = __builtin_amdgcn_readfirstlane(F.tid >> 6);
    F.G = gridDim.x; { const int bx = blockIdx.x; F.vcu = (F.G % 8 == 0) ? (bx % 8) * (F.G / 8) + bx / 8 : bx; }
    F.out = args.out; F.ws = args.ws;
    volatile LAS unsigned* MISC = (volatile LAS unsigned*)(F.lds + MISC_OFF);
    for (int u = F.tid; u < (LDS_BYTES - LDSCTL_OFF) / 4; u += 512) ((LAS unsigned*)(F.lds + LDSCTL_OFF))[u] = 0u;
    __syncthreads();
    const int lo = args.ph_lo, hi = args.ph_hi;
    const bool multi = (hi - lo) > 1;
    XcdBarrier bar; bar.bar = (unsigned*)(F.ws + WS_CTL) + 4096; bar.x = 0; bar.st = MISC + 8;
    if (multi) bar = xcd_barrier_post((unsigned*)(F.ws + WS_CTL) + 4096, MISC + 8);
#ifndef PH_MASK
#define PH_MASK 0xFFFFFFFFu
#endif
#define IN(k) (lo <= (k) && (k) < hi)
#define EN(j) ((PH_MASK >> (j)) & 1u)
#define FRESH() do { F.tid = launder((int)threadIdx.x); F.lane = F.tid & 63; } while (0)
#define SEAM(k) do { if (multi && IN((k) + 1)) xcd_barrier(bar); } while (0)

    if (EN(0) && IN(0)) { FRESH(); p0_prologue(F, args); SEAM(0); }

    bf16_t* HX = (bf16_t*)(F.ws + WS_HX);
    float* CTXS = (float*)(F.ws + WS_CTXS);
#pragma nounroll
    for (int l = 0; l < 2; ++l) {
        const int pb = 1 + l * NPL;
        const bool wctx = (l == 0);
        const float* xsrc = (l == 0) ? args.in[I_X] : F.out;
        const float* csrc = (l == 0) ? args.in[I_CTX] : CTXS;
        if (EN(1) && IN(pb + 0)) { FRESH(); p1_norm(F, args, l, xsrc, csrc); SEAM(pb + 0); }
        if (EN(2) && IN(pb + 1)) { FRESH();
            pg8::AddrPlain g{HX, (const bf16_t*)(F.ws + WS_WIN) + (size_t)l * D * D, D};
            pg8::LinOrder S{(MT / 256) * 4, 4, F.G, F.vcu};
            pg8::EpiWin E{(bf16_t*)(F.ws + WS_R1 + R1_US5), (bf16_t*)(F.ws + WS_R1 + R1_VP)};
            pg8::gemm_phase(F.lds + STAGE_OFF, g, S, E);
            SEAM(pb + 1);
        }
        if (EN(3) && IN(pb + 2)) { FRESH(); s5_naive(F, args, l); pool_naive(F, wctx); SEAM(pb + 2); }
        if (EN(4) && IN(pb + 3)) { FRESH();
            const int mrows = wctx ? MT : MX;
            { pg8::AddrPlain g{(const bf16_t*)(F.ws + WS_R1 + R1_YG), (const bf16_t*)(F.ws + WS_WGLU) + (size_t)l * DS5 * DS5, DS5};
              pg8::LinOrder S{(mrows / 256) * 2, 2, F.G, F.vcu};
              pg8::EpiGlu E{(const bf16_t*)(F.ws + WS_R1 + R1_YG), HX};
              pg8::gemm_phase(F.lds + STAGE_OFF, g, S, E); }
            { pg8::AddrPlain g{(const bf16_t*)(F.ws + WS_R1 + R1_Z), (const bf16_t*)(F.ws + WS_WPOOL) + (size_t)l * 512 * 512, 512};
              pg8::LinOrder S{(mrows / 256) * 2, 2, F.G, F.vcu};
              pg8::EpiPoolS E{args.in[I_POOLS] + l * 512, HX};
              pg8::gemm_phase(F.lds + STAGE_OFF, g, S, E); }
            SEAM(pb + 3);
        }
        if (EN(5) && IN(pb + 4)) { FRESH();
            const int mrows = wctx ? MT : MX;
            pg8::AddrPlain g{HX, (const bf16_t*)(F.ws + WS_WOUT) + (size_t)l * D * D, D};
            pg8::LinOrder S{(mrows / 256) * 4, 4, F.G, F.vcu};
            pg8::EpiPlain E{(bf16_t*)(F.ws + WS_R1), D};
            pg8::gemm_phase(F.lds + STAGE_OFF, g, S, E);
            SEAM(pb + 4);
        }
        if (EN(6) && IN(pb + 5)) { FRESH(); p6_rows(F, args, l, xsrc, F.out, csrc, CTXS, wctx); SEAM(pb + 5); }
        if (EN(7) && IN(pb + 6)) { FRESH(); p7_topk(F, wctx); SEAM(pb + 6); }
        if (EN(8) && IN(pb + 7)) { FRESH(); p8a_gather(F, wctx); SEAM(pb + 7); }
        if (EN(9) && IN(pb + 8)) { FRESH();
            const int ptiles = (wctx ? PT : PX) / 256;
            pg8::AddrMoE g{(const bf16_t*)(F.ws + WS_R2), (const bf16_t*)(F.ws + WS_WGU) + (size_t)l * 16 * 2048 * D, (size_t)2048 * D, D};
            pg8::LinOrder S{ptiles * 8, 8, F.G, F.vcu};
            pg8::EpiSwiglu E{(bf16_t*)(F.ws + WS_R1)};
            pg8::gemm_phase(F.lds + STAGE_OFF, g, S, E);
            SEAM(pb + 8);
        }
        if (EN(10) && IN(pb + 9)) { FRESH();
            const int ptiles = (wctx ? PT : PX) / 256;
            pg8::AddrMoE g{(const bf16_t*)(F.ws + WS_R1), (const bf16_t*)(F.ws + WS_WD) + (size_t)l * 16 * D * D, (size_t)D * D, D};
            pg8::LinOrder S{ptiles * 4, 4, F.G, F.vcu};
            pg8::EpiDown E{(const float*)(F.ws + WS_SELG), (bf16_t*)(F.ws + WS_R2)};
            pg8::gemm_phase(F.lds + STAGE_OFF, g, S, E);
            SEAM(pb + 9);
        }
        if (EN(11) && IN(pb + 10)) { FRESH(); p10_combine(F, args, l, F.out, CTXS, wctx); SEAM(pb + 10); }
    }
#undef IN
#undef SEAM
}

#ifndef MK_ONE_LAUNCH
#define MK_ONE_LAUNCH 0
#endif
extern "C" void kernel_launch(void* const* d_in, const int* in_sizes, int n_in, void* d_out, int out_size, void* d_ws, size_t ws_size, hipStream_t stream) {
    static int grid = 0;
    if (grid == 0) {
        if (n_in != 27 || out_size != MX * D || ws_size < WS_END) { fprintf(stderr, "kernel_launch: unexpected shapes (n_in %d out %d ws %zu)\n", n_in, out_size, ws_size); grid = -1; return; }
        int dev = 0, cus = 0, per_cu = 0;
        if (hipGetDevice(&dev) != hipSuccess || hipDeviceGetAttribute(&cus, hipDeviceAttributeMultiprocessorCount, dev) != hipSuccess) { grid = -1; return; }
        if (hipFuncSetAttribute((const void*)fwd, hipFuncAttributeMaxDynamicSharedMemorySize, LDS_BYTES) != hipSuccess) { fprintf(stderr, "kernel_launch: hipFuncSetAttribute failed\n"); grid = -1; return; }
        if (hipOccupancyMaxActiveBlocksPerMultiprocessor(&per_cu, (const void*)fwd, 512, LDS_BYTES) != hipSuccess || per_cu < 1) fprintf(stderr, "kernel_launch: occupancy query says %d\n", per_cu);
        (void)hipGetLastError();
        grid = cus;
    }
    if (grid < 0) return;
    (void)hipMemsetAsync((char*)d_ws + WS_CTL, 0, CTL_ZERO_BYTES, stream);
    Args a{};
    for (int i = 0; i < 27; ++i) a.in[i] = (const float*)d_in[i];
    a.out = (float*)d_out; a.ws = (unsigned char*)d_ws;
#if MK_ONE_LAUNCH
    a.ph_lo = 0; a.ph_hi = NPHASE;
    hipLaunchKernelGGL(fwd, dim3(grid), dim3(512), LDS_BYTES, stream, a);
#else
    for (int p = 0; p < NPHASE; ++p) { a.ph_lo = p; a.ph_hi = p + 1; hipLaunchKernelGGL(fwd, dim3(grid), dim3(512), LDS_BYTES, stream, a); }
#endif
}
```

```cpp
#include <hip/hip_runtime.h>
#include <cstdio>
#include <cstdint>

#define GAS __attribute__((address_space(1)))
#define LAS __attribute__((address_space(3)))
typedef unsigned short bf16_t;
typedef short bf16x8 __attribute__((ext_vector_type(8)));
typedef float f32x4 __attribute__((ext_vector_type(4)));
typedef float f32x2 __attribute__((ext_vector_type(2)));
typedef unsigned u32x4 __attribute__((ext_vector_type(4)));
typedef unsigned u32x2 __attribute__((ext_vector_type(2)));
typedef int i32x4 __attribute__((ext_vector_type(4)));
typedef int i32x8 __attribute__((ext_vector_type(8)));

constexpr int D = 1024, NB = 8, T = 8192, LC = 256;
constexpr int MX = NB * T, MC = NB * LC, MT = MX + MC;
constexpr int NE = 16, CAPX = 1024, CAPC = 32;
constexpr int PX = NB * NE * CAPX, PC = NE * NB * CAPC, PT = PX + PC;
constexpr int NSEQ = LC + T;
constexpr int DS5 = 512, NG = 32, SH = 16, SP = 64;
constexpr float RMS_EPS = 1e-6f;
constexpr int NMOD = 6 * D;

constexpr size_t MiB = 1u << 20;
constexpr size_t WS_CTL = 0, CTL_ZERO_BYTES = 1 * MiB;
constexpr size_t WS_MOD = 1 * MiB;
constexpr size_t WS_AFF = 2 * MiB;
constexpr size_t WS_AFFC = 6 * MiB;
constexpr size_t WS_SELI = 7 * MiB;
constexpr size_t WS_SELG = 8 * MiB;
constexpr size_t WS_INV = 9 * MiB;
constexpr size_t WS_WRT = 14 * MiB;
constexpr size_t WS_IDENT = 15 * MiB;
constexpr size_t WS_CTXS = 16 * MiB;
constexpr size_t WS_WIN = 24 * MiB;
constexpr size_t WS_WOUT = 28 * MiB;
constexpr size_t WS_WGLU = 32 * MiB;
constexpr size_t WS_WPOOL = 33 * MiB;
constexpr size_t WS_WGU = 34 * MiB;
constexpr size_t WS_WD = 98 * MiB;
constexpr size_t WS_XB = 130 * MiB;
constexpr size_t WS_HX = 262 * MiB;
constexpr size_t WS_R1 = 394 * MiB;
constexpr size_t WS_R2 = 658 * MiB;
constexpr size_t WS_S5W = 922 * MiB;
constexpr size_t S5W_STRIDE = 288 * 1024;
constexpr int S5_OFF_WSF = 0, S5_OFF_WSR = 65536, S5_OFF_WOF = 131072, S5_OFF_WOR = 196608, S5_OFF_TT = 262144, S5_OFF_A16 = 262144 + 16384;
constexpr size_t WS_END = 940 * MiB;
constexpr size_t R1_US5 = 0, R1_VP = 66 * MiB, R1_YG = 132 * MiB, R1_Z = 198 * MiB;

constexpr int LDS_BYTES = 147456;
constexpr int STAGE_OFF = 0, LDSCTL_OFF = 131072, MISC_OFF = LDS_BYTES - 256;

__device__ __forceinline__ unsigned f2bf(float f) { unsigned u = __float_as_uint(f); return (u + 0x7fffu + ((u >> 16) & 1u)) >> 16; }
__device__ __forceinline__ unsigned pk2(float lo, float hi) { unsigned r; asm("v_cvt_pk_bf16_f32 %0, %1, %2" : "=v"(r) : "v"(lo), "v"(hi)); return r; }
__device__ __forceinline__ float bflo(unsigned w) { return __uint_as_float(w << 16); }
__device__ __forceinline__ float bfhi(unsigned w) { return __uint_as_float(w & 0xffff0000u); }
template <int CTRL> __device__ __forceinline__ float dppx(float v) { return __int_as_float(__builtin_amdgcn_update_dpp(0, __float_as_int(v), CTRL, 0xF, 0xF, false)); }
__device__ __forceinline__ float wave_sum(float v) {
    v += dppx<0xB1>(v); v += dppx<0x4E>(v); v += dppx<0x141>(v); v += dppx<0x140>(v);
    const int vi = __float_as_int(v);
    return (__int_as_float(__builtin_amdgcn_readlane(vi, 0)) + __int_as_float(__builtin_amdgcn_readlane(vi, 16))) + (__int_as_float(__builtin_amdgcn_readlane(vi, 32)) + __int_as_float(__builtin_amdgcn_readlane(vi, 48)));
}
__device__ __forceinline__ unsigned pk4_fp8(float a, float b, float c, float d) {
    a = __builtin_amdgcn_fmed3f(a, -448.f, 448.f); b = __builtin_amdgcn_fmed3f(b, -448.f, 448.f); c = __builtin_amdgcn_fmed3f(c, -448.f, 448.f); d = __builtin_amdgcn_fmed3f(d, -448.f, 448.f);
    int w = 0; w = __builtin_amdgcn_cvt_pk_fp8_f32(a, b, w, false); w = __builtin_amdgcn_cvt_pk_fp8_f32(c, d, w, true); return (unsigned)w; }
constexpr float W8_SCALE = 256.f, H8_SCALE = 4.f;
constexpr int SC_ONE = 0x7f7f7f7f, SC_W8 = 0x77777777, SC_H8 = 0x7d7d7d7d;
__device__ __forceinline__ float sigmoidf_(float x) { return __builtin_amdgcn_rcpf(1.0f + __builtin_amdgcn_exp2f(-1.4426950408889634f * x)); }
__device__ __forceinline__ float gelu_tanh(float x) { const float u2 = 1.5957691216057308f * (x + 0.044715f * x * x * x); return x * __builtin_amdgcn_rcpf(1.0f + __builtin_amdgcn_exp2f(-1.4426950408889634f * u2)); }

__device__ __forceinline__ int launder(int v) { asm volatile("" : "+v"(v)); return v; }
__device__ __forceinline__ int launder_s(int v) { asm volatile("" : "+s"(v)); return v; }

#define XB_TMO      128
#define XB_XCNT(j)  (256  + 64 * (j))
#define XB_XSUB(j)  (1280 + 64 * (j))
#define XB_XGEN(j)  (2304 + 64 * (j))
#define XB_TOP      3328
#define XB_TOPGEN   3392
#define XCD_BAR_WORDS 3456
#define XB_SPIN_CAP (1u << 18)

__device__ __forceinline__ unsigned xb_ld(unsigned* p)              { return __hip_atomic_load(p, __ATOMIC_RELAXED, __HIP_MEMORY_SCOPE_AGENT); }
__device__ __forceinline__ unsigned xb_add(unsigned* p, unsigned v) { return __hip_atomic_fetch_add(p, v, __ATOMIC_RELAXED, __HIP_MEMORY_SCOPE_AGENT); }
__device__ __forceinline__ unsigned xb_xcc_id() { return (unsigned)__builtin_amdgcn_s_getreg((3 << 11) | 20) & 0xFu; }
#define XB_SPIN(cond, bar) do { unsigned _sp = 0; while (cond) { __builtin_amdgcn_s_sleep(1); \
    if ((++_sp & 255u) == 0u) { if (xb_ld(&(bar)[XB_TMO])) break; if (_sp > XB_SPIN_CAP) { atomicAdd(&(bar)[XB_TMO], 1u); break; } } } } while (0)

struct XcdBarrier { unsigned* bar; unsigned x; volatile LAS unsigned* st; };

__device__ __forceinline__ XcdBarrier xcd_barrier_post(unsigned* bar, volatile LAS unsigned* st) {
    XcdBarrier b; b.bar = bar; b.x = xb_xcc_id(); b.st = st;
    if (threadIdx.x == 0) (void)xb_add(&bar[XB_XCNT(b.x)], 1u);
    return b;
}
__device__ __forceinline__ void xcd_barrier_complete(unsigned* bar, unsigned x, unsigned& nloc, unsigned& nx) {
    const unsigned G = gridDim.x * gridDim.y * gridDim.z;
    unsigned sum, cnt, mine, sp = 0u;
    for (;;) {
        sum = 0u; cnt = 0u; mine = 0u;
#pragma unroll
        for (unsigned j = 0; j < 16; ++j) { const unsigned c = xb_ld(&bar[XB_XCNT(j)]); sum += c; cnt += (c > 0u) ? 1u : 0u; mine = (j == x) ? c : mine; }
        if (sum == G) break;
        __builtin_amdgcn_s_sleep(1);
        if ((++sp & 255u) == 0u) { if (xb_ld(&bar[XB_TMO])) break; if (sp > XB_SPIN_CAP) { atomicAdd(&bar[XB_TMO], 1u); break; } }
    }
    nloc = mine > 0u ? mine : 1u; nx = cnt > 0u ? cnt : 1u;
}
__device__ __forceinline__ void xcd_barrier(const XcdBarrier& b) {
    asm volatile("s_waitcnt vmcnt(0)" ::: "memory");
    __syncthreads();
    if (threadIdx.x == 0) {
        unsigned* bar = b.bar;
        __builtin_amdgcn_s_waitcnt(0);
        unsigned nloc = b.st[0], nx = b.st[1];
        if (nloc == 0u) { xcd_barrier_complete(bar, b.x, nloc, nx); b.st[0] = nloc; b.st[1] = nx; }
        const unsigned old = xb_add(&bar[XB_XSUB(b.x)], 1u);
        const unsigned gen = old / nloc;
        if (old + 1u == (gen + 1u) * nloc) {
            __builtin_amdgcn_fence(__ATOMIC_RELEASE, "agent");
            asm volatile("s_waitcnt vmcnt(0)" ::: "memory");
            const unsigned og = xb_add(&bar[XB_TOP], 1u);
            const unsigned tg = og / nx;
            if (og + 1u == (tg + 1u) * nx) xb_add(&bar[XB_TOPGEN], 1u);
            else XB_SPIN(xb_ld(&bar[XB_TOPGEN]) == tg, bar);
            __builtin_amdgcn_fence(__ATOMIC_ACQUIRE, "agent");
            xb_add(&bar[XB_XGEN(b.x)], 1u);
            asm volatile("s_waitcnt vmcnt(0)" ::: "memory");
        } else {
            XB_SPIN(xb_ld(&bar[XB_XGEN(b.x)]) == gen, bar);
            __builtin_amdgcn_fence(__ATOMIC_ACQUIRE, "agent");
            asm volatile("s_waitcnt vmcnt(0)" ::: "memory");
        }
    }
    __syncthreads();
}

namespace pg8 {
constexpr int BM = 256, BK = 64, HALF = 128, HTB = HALF * BK * 2, STAGE_BYTES = 8 * HTB;
__device__ __forceinline__ int lds_byte(int r, int c) { const int st = (r >> 4) * 2 + (c >> 5), rr = r & 15, cc = c & 31, ob = rr * 64 + cc * 2; return st * 1024 + (ob ^ (((ob >> 9) & 1) << 5)); }
__device__ __forceinline__ void stage_rc(int b, int& R, int& C) { const int st = b / 1024, sb = b % 1024, swz = sb ^ (((sb >> 9) & 1) << 5); R = (st >> 1) * 16 + swz / 64; C = (st & 1) * 32 + (swz % 64) / 2; }
__device__ __forceinline__ int perm32(int rho) { const int n = rho >> 4, i = rho & 15; return 8 * (i >> 2) + 4 * n + (i & 3); }
struct Unit { int pm, pn; };
__device__ __forceinline__ unsigned cvt_pk_bf16(float lo, float hi) { unsigned r; asm volatile("v_cvt_pk_bf16_f32 %0, %1, %2" : "=v"(r) : "v"(lo), "v"(hi)); return r; }

struct LinOrder {
    int nunits, nN, G, c;
    __device__ __forceinline__ bool next(int i, Unit& u) const { const long L = (long)i * G + c; if (L >= nunits) return false; u.pn = (int)(L % nN); u.pm = (int)(L / nN); return true; }
    __device__ __forceinline__ void a_ready(const Unit&) const {}
    __device__ __forceinline__ void done(const Unit&) const {}
};
struct AddrPlain {
    static constexpr bool GATHER = false, FP8 = false; static constexpr int SCW = 0, SCW1 = 0, SCX = 0;
    const bf16_t* A; const bf16_t* Bt; int K;
    __device__ __forceinline__ int nt(const Unit&) const { return K / BK; }
    __device__ __forceinline__ const int* idx(const Unit&) const { return nullptr; }
    __device__ __forceinline__ const char* Aof(const Unit& u) const { return (const char*)A + (size_t)u.pm * BM * K * 2; }
    __device__ __forceinline__ const char* Bof(const Unit& u) const { return (const char*)Bt + (size_t)u.pn * BM * K * 2; }
};
struct AddrMoE {
    static constexpr bool GATHER = false, FP8 = true; static constexpr int SCW = SC_W8, SCW1 = SC_W8, SCX = SC_H8;
    const unsigned char* A; const unsigned char* W; size_t wstride; int K;
    __device__ __forceinline__ int nt(const Unit&) const { return K / BK; }
    __device__ __forceinline__ const int* idx(const Unit&) const { return nullptr; }
    __device__ __forceinline__ static int expert(int pm) { return pm < (PX / BM) ? ((pm >> 2) & 15) : (pm - PX / BM); }
    __device__ __forceinline__ const char* Aof(const Unit& u) const { return (const char*)A + (size_t)u.pm * BM * K * 2; }
    __device__ __forceinline__ const char* Bof(const Unit& u) const { return (const char*)(W + (size_t)expert(u.pm) * wstride) + (size_t)u.pn * BM * K * 2; }
};
struct AddrMoEGather {
    static constexpr bool GATHER = true, FP8 = true; static constexpr int SCW = SC_W8, SCW1 = 0x79797979  , SCX = SC_ONE;
    const unsigned char* A; const int* sel; const unsigned char* W; size_t wstride; int K;
    __device__ __forceinline__ int nt(const Unit&) const { return K / BK; }
    __device__ __forceinline__ const int* idx(const Unit& u) const { return sel + (size_t)u.pm * BM; }
    __device__ __forceinline__ const char* Aof(const Unit&) const { return (const char*)A; }
    __device__ __forceinline__ const char* Bof(const Unit& u) const { return (const char*)(W + (size_t)AddrMoE::expert(u.pm) * wstride) + (size_t)u.pn * BM * K * 2; }
};

struct AddrMoEGatherH {
    static constexpr bool GATHER = true, FP8 = true; static constexpr int SCW = SC_W8, SCW1 = SC_W8, SCX = 0x81818181  ;
    const unsigned char* A; const int* sel; const unsigned char* W; size_t wstride; int K;
    __device__ __forceinline__ int nt(const Unit&) const { return K / BK; }
    __device__ __forceinline__ const int* idx(const Unit& u) const { return sel + (size_t)u.pm * BM; }
    __device__ __forceinline__ const char* Aof(const Unit&) const { return (const char*)A; }
    __device__ __forceinline__ const char* Bof(const Unit& u) const { return (const char*)(W + (size_t)AddrMoE::expert(u.pm) * wstride) + (size_t)u.pn * BM * K * 2; }
};

struct MidOrder {
    int nunits, G, c;
    __device__ __forceinline__ bool next(int i, Unit& u) const { const long L = (long)i * G + c; if (L >= nunits) return false; u.pn = (int)((L + i) & 3); u.pm = (int)(L >> 2); return true; }
    __device__ __forceinline__ void a_ready(const Unit&) const {}
    __device__ __forceinline__ void done(const Unit&) const {}
};
struct AddrMid {
    static constexpr bool GATHER = false, FP8 = false; static constexpr int SCW = 0, SCW1 = 0, SCX = 0;
    const bf16_t* Yg; const bf16_t* Z; const bf16_t* Wg; const bf16_t* Wp; int K;
    __device__ __forceinline__ int nt(const Unit& u) const { return u.pn < 2 ? 8 : 4; }
    __device__ __forceinline__ const int* idx(const Unit&) const { return nullptr; }
    __device__ __forceinline__ const char* Aof(const Unit& u) const { return u.pn < 2 ? (const char*)(Yg + (size_t)u.pm * BM * 512) : (const char*)(Z + (size_t)u.pm * BM * 512 + 256 * (u.pn - 2)); }
    __device__ __forceinline__ const char* Bof(const Unit& u) const { return u.pn < 2 ? (const char*)(Wg + (size_t)u.pn * BM * 512) : (const char*)(Wp + (size_t)(u.pn - 2) * BM * 512 + 256 * (u.pn - 2)); }
};

template <class Epi, class Sched, class Addr>
__device__ __forceinline__ void gemm_phase(LAS unsigned char* lds, const Addr g, const Sched& S, const Epi& E) {
    const int tid = launder((int)threadIdx.x), wid = __builtin_amdgcn_readfirstlane(tid >> 6), lane = tid & 63, wr = wid >> 2, wc = wid & 3, fr = lane & 15, fq = lane >> 4;
    const int K = g.K;
    unsigned vA[2][2], voffB[2];
    const size_t kstep = (size_t)(BK * 2);
    const size_t hstep = (size_t)HALF * K * 2;
    LAS int* idxl = (LAS int*)(lds + 131072 + 1024);
#pragma unroll
    for (int i = 0; i < 2; ++i) { int R, C; stage_rc(tid * 16 + i * 8192, R, C); const int Rb = ((R & ~31) + perm32(R & 31));
        vA[0][i] = (unsigned)(R * K + C) * 2u; vA[1][i] = vA[0][i] + (unsigned)hstep; voffB[i] = (unsigned)(Rb * K + C) * 2u; }
    const unsigned ldsw = (unsigned)wid * 1024u;
    const int aoff = lds_byte(wr * 64 + fr, fq * 8), boff = lds_byte(wc * 32 + fr, fq * 8);
#define PG8_SA(b, h) (((b) * 2 + (h)) * HTB)
#define PG8_SB(b, h) ((4 + (b) * 2 + (h)) * HTB)
#define PG8_STAGE(bufoff, gbase, voff) do { _Pragma("unroll") for (int _i = 0; _i < 2; ++_i) \
        __builtin_amdgcn_global_load_lds((const unsigned*)((const char*)(gbase) + (voff)[_i]), (LAS unsigned*)(lds + (bufoff) + ldsw + _i * 8192), 16, 0, 0); } while (0)
#define PG8_LDA(dst, b, h) do { _Pragma("unroll") for (int m = 0; m < 4; ++m) _Pragma("unroll") for (int k = 0; k < 2; ++k) dst[m][k] = *(const LAS bf16x8*)(lds + PG8_SA(b, h) + aoff + m * 2048 + k * 1024); } while (0)
#define PG8_LDB(dst, b, h) do { _Pragma("unroll") for (int n = 0; n < 2; ++n) _Pragma("unroll") for (int k = 0; k < 2; ++k) dst[n][k] = *(const LAS bf16x8*)(lds + PG8_SB(b, h) + boff + n * 2048 + k * 1024); } while (0)
#define PG8_MMA(ai, bj, At, Bt) do { __builtin_amdgcn_s_setprio(1); _Pragma("unroll") for (int m = 0; m < 4; ++m) _Pragma("unroll") for (int n = 0; n < 2; ++n) { \
        if constexpr (Addr::FP8) { const i32x4 b0 = __builtin_bit_cast(i32x4, Bt[n][0]), b1 = __builtin_bit_cast(i32x4, Bt[n][1]), a0 = __builtin_bit_cast(i32x4, At[m][0]), a1 = __builtin_bit_cast(i32x4, At[m][1]); \
            acc[ai][bj][m][n] = __builtin_amdgcn_mfma_scale_f32_16x16x128_f8f6f4(__builtin_shufflevector(b0, b1, 0, 1, 2, 3, 4, 5, 6, 7), __builtin_shufflevector(a0, a1, 0, 1, 2, 3, 4, 5, 6, 7), acc[ai][bj][m][n], 0, 0, 0, (bj) ? Addr::SCW1 : Addr::SCW, 0, Addr::SCX); } \
        else { _Pragma("unroll") for (int k = 0; k < 2; ++k) acc[ai][bj][m][n] = __builtin_amdgcn_mfma_f32_16x16x32_bf16(Bt[n][k], At[m][k], acc[ai][bj][m][n], 0, 0, 0); } } \
        __builtin_amdgcn_s_setprio(0); } while (0)
#define PG8_WAIT_V(n) asm volatile("s_waitcnt vmcnt(" #n ")" ::: "memory")
#define PG8_WAIT_L(n) asm volatile("s_waitcnt lgkmcnt(" #n ")" ::: "memory")
#define PG8_BAR __builtin_amdgcn_s_barrier()
#define PG8_SCHED __builtin_amdgcn_sched_barrier(0)
    Unit cur, nxt; int ui = 0;
    if (!S.next(0, cur)) return;
    f32x4 acc[2][2][4][2];
#pragma unroll
    for (int a = 0; a < 2; ++a)
#pragma unroll
        for (int b = 0; b < 2; ++b)
#pragma unroll
            for (int m = 0; m < 4; ++m)
#pragma unroll
                for (int n = 0; n < 2; ++n) acc[a][b][m][n] = (f32x4){0.f, 0.f, 0.f, 0.f};
    bf16x8 At[4][2], B0[2][2], B1[2][2];
    const char* cA = g.Aof(cur); const char* cB = g.Bof(cur);
    int nt = g.nt(cur);
    S.a_ready(cur);
    if constexpr (Addr::GATHER) { const int* ip = g.idx(cur);
#pragma unroll
        for (int i = 0; i < 2; ++i) { int R, C; stage_rc(tid * 16 + i * 8192, R, C);
#pragma unroll
            for (int h = 0; h < 2; ++h) vA[h][i] = (unsigned)ip[h * HALF + R] * (unsigned)(K * 2) + (unsigned)(C * 2); }
        Unit n1; if (S.next(1, n1) && wid == 0) __builtin_amdgcn_global_load_lds((const unsigned*)(g.idx(n1) + lane * 4), (LAS unsigned*)idxl, 16, 0, 0); }
    PG8_STAGE(PG8_SB(0, 0), cB, voffB); PG8_STAGE(PG8_SA(0, 0), cA, vA[0]); PG8_STAGE(PG8_SB(0, 1), cB + hstep, voffB); PG8_STAGE(PG8_SA(0, 1), cA, vA[1]);
    if (wr == 1) PG8_BAR;
    PG8_WAIT_V(4); PG8_BAR;
    PG8_STAGE(PG8_SB(1, 0), cB + kstep, voffB); PG8_STAGE(PG8_SA(1, 0), cA + kstep, vA[0]); PG8_STAGE(PG8_SB(1, 1), cB + hstep + kstep, voffB);
    PG8_WAIT_V(6); PG8_BAR;
    for (;;) {
        const bool has_next = S.next(ui + 1, nxt);
        const char* nA = has_next ? g.Aof(nxt) : cA; const char* nB = has_next ? g.Bof(nxt) : cB;
        for (int t = 0; t < nt; t += 2) {
            const bool last = (t == nt - 2);
            const char* a1 = cA + (size_t)(t + 1) * kstep;
            const char* a2 = last ? nA : cA + (size_t)(t + 2) * kstep; const char* b2 = last ? nB : cB + (size_t)(t + 2) * kstep;
            const char* a3 = a2 + kstep; const char* b3 = b2 + kstep;
            if (last && has_next) S.a_ready(nxt);
            PG8_LDB(B0, 0, 0); PG8_SCHED; PG8_LDA(At, 0, 0); PG8_STAGE(PG8_SA(1, 1), a1, vA[1]);
            if constexpr (Addr::GATHER) {
                if (last && has_next) {
#pragma unroll
                    for (int i = 0; i < 2; ++i) { int R, C; stage_rc(tid * 16 + i * 8192, R, C);
#pragma unroll
                        for (int h = 0; h < 2; ++h) vA[h][i] = (unsigned)idxl[h * HALF + R] * (unsigned)(K * 2) + (unsigned)(C * 2); } }
            }
            PG8_WAIT_L(8); PG8_BAR; PG8_WAIT_L(0); PG8_MMA(0, 0, At, B0); PG8_BAR; PG8_SCHED;
            PG8_LDB(B1, 0, 1); PG8_STAGE(PG8_SB(0, 0), b2, voffB);
            PG8_BAR; PG8_WAIT_L(0); PG8_MMA(0, 1, At, B1); PG8_BAR;
            PG8_LDA(At, 0, 1); PG8_STAGE(PG8_SA(0, 0), a2, vA[0]);
            PG8_BAR; PG8_WAIT_L(0); PG8_MMA(1, 0, At, B0); PG8_BAR; PG8_SCHED;
            PG8_STAGE(PG8_SB(0, 1), b2 + hstep, voffB);
            PG8_WAIT_V(6); PG8_BAR; PG8_MMA(1, 1, At, B1); PG8_BAR;
            PG8_LDB(B0, 1, 0); PG8_SCHED; PG8_LDA(At, 1, 0); PG8_STAGE(PG8_SA(0, 1), a2, vA[1]);
            PG8_WAIT_L(8); PG8_BAR; PG8_WAIT_L(0); PG8_MMA(0, 0, At, B0); PG8_BAR; PG8_SCHED;
            PG8_LDB(B1, 1, 1); PG8_STAGE(PG8_SB(1, 0), b3, voffB);
            PG8_BAR; PG8_WAIT_L(0); PG8_MMA(0, 1, At, B1); PG8_BAR;
            PG8_LDA(At, 1, 1); PG8_STAGE(PG8_SA(1, 0), a3, vA[0]);
            PG8_BAR; PG8_WAIT_L(0); PG8_MMA(1, 0, At, B0); PG8_BAR; PG8_SCHED;
            PG8_STAGE(PG8_SB(1, 1), b3 + hstep, voffB);
            PG8_WAIT_V(6); PG8_BAR; PG8_MMA(1, 1, At, B1); PG8_BAR;
        }
        E(acc, cur, wr, wc, fr, fq); S.done(cur);
        if (!has_next) break;
        if constexpr (Addr::GATHER) { Unit n2; if (S.next(ui + 2, n2) && wid == 0) __builtin_amdgcn_global_load_lds((const unsigned*)(g.idx(n2) + lane * 4), (LAS unsigned*)idxl, 16, 0, 0); }
#pragma unroll
        for (int a = 0; a < 2; ++a)
#pragma unroll
            for (int b = 0; b < 2; ++b)
#pragma unroll
                for (int m = 0; m < 4; ++m)
#pragma unroll
                    for (int n = 0; n < 2; ++n) acc[a][b][m][n] = (f32x4){0.f, 0.f, 0.f, 0.f};
        cur = nxt; cA = nA; cB = nB; ++ui; nt = g.nt(cur);
    }
    PG8_WAIT_V(0);
    if (wr == 0) PG8_BAR;
    PG8_BAR;
#undef PG8_SA
#undef PG8_SB
#undef PG8_STAGE
#undef PG8_LDA
#undef PG8_LDB
#undef PG8_MMA
#undef PG8_WAIT_V
#undef PG8_WAIT_L
#undef PG8_BAR
#undef PG8_SCHED
}

typedef f32x4 Acc[2][2][4][2];
__device__ __forceinline__ u32x4 pack8(const f32x4& v0, const f32x4& v1) { u32x4 w; w.x = cvt_pk_bf16(v0[0], v0[1]); w.y = cvt_pk_bf16(v0[2], v0[3]); w.z = cvt_pk_bf16(v1[0], v1[1]); w.w = cvt_pk_bf16(v1[2], v1[3]); return w; }

struct EpiPlain {
    bf16_t* O; int ldc;
    __device__ __forceinline__ void operator()(const Acc& acc, const Unit& u, int wr, int wc, int fr, int fq) const {
        const int row0 = u.pm * BM + wr * 64 + fr, col0 = u.pn * BM + wc * 32 + 8 * fq;
#pragma unroll
        for (int ai = 0; ai < 2; ++ai)
#pragma unroll
            for (int m = 0; m < 4; ++m) { bf16_t* rowp = O + (size_t)(row0 + ai * HALF + m * 16) * ldc + col0;
#pragma unroll
                for (int bj = 0; bj < 2; ++bj) *(u32x4*)(rowp + bj * HALF) = pack8(acc[ai][bj][m][0], acc[ai][bj][m][1]); }
    }
};
constexpr float YD_SCALE = 16.f;
struct EpiYd8 {
    unsigned char* O;
    __device__ __forceinline__ void operator()(const Acc& acc, const Unit& u, int wr, int wc, int fr, int fq) const {
        const int row0 = u.pm * BM + wr * 64 + fr, col0 = u.pn * BM + wc * 32 + 8 * fq;
#pragma unroll
        for (int ai = 0; ai < 2; ++ai)
#pragma unroll
            for (int m = 0; m < 4; ++m) { unsigned char* rowp = O + (size_t)(row0 + ai * HALF + m * 16) * 1024 + col0;
#pragma unroll
                for (int bj = 0; bj < 2; ++bj) { const f32x4 a = acc[ai][bj][m][0], b = acc[ai][bj][m][1];
                    u32x2 w; w.x = pk4_fp8(a[0], a[1], a[2], a[3]); w.y = pk4_fp8(b[0], b[1], b[2], b[3]);
                    *(u32x2*)(rowp + bj * HALF) = w; } }
    }
};
struct EpiWin {
    bf16_t* Us5; bf16_t* Vp;
    __device__ __forceinline__ void operator()(const Acc& acc, const Unit& u, int wr, int wc, int fr, int fq) const {
        const int rl = wr * 64 + fr, col0 = u.pn * BM + wc * 32 + 8 * fq;
        if (u.pn < 2) {
            const int b = u.pm < MX / BM ? (u.pm >> 5) : (u.pm - MX / BM), n0 = u.pm < MX / BM ? LC + (u.pm & 31) * BM : 0;
            bf16_t* base = Us5 + ((size_t)b * NG * NSEQ + n0 + rl) * 16;
#pragma unroll
            for (int bj = 0; bj < 2; ++bj) { const int c = col0 + bj * HALF; bf16_t* pb = base + (size_t)(c >> 4) * NSEQ * 16 + (c & 8);
#pragma unroll
                for (int ai = 0; ai < 2; ++ai)
#pragma unroll
                    for (int m = 0; m < 4; ++m) *(u32x4*)(pb + (ai * HALF + m * 16) * 16) = pack8(acc[ai][bj][m][0], acc[ai][bj][m][1]); }
        } else {
            bf16_t* base = Vp + (size_t)(u.pm * BM + rl) * 512 + (col0 - 512);
#pragma unroll
            for (int ai = 0; ai < 2; ++ai)
#pragma unroll
                for (int m = 0; m < 4; ++m)
#pragma unroll
                    for (int bj = 0; bj < 2; ++bj) *(u32x4*)(base + (size_t)(ai * HALF + m * 16) * 512 + bj * HALF) = pack8(acc[ai][bj][m][0], acc[ai][bj][m][1]);
        }
    }
};
struct EpiGlu {
    const bf16_t* Yg; bf16_t* O;
    __device__ __forceinline__ void operator()(const Acc& acc, const Unit& u, int wr, int wc, int fr, int fq) const {
        const int row0 = u.pm * BM + wr * 64 + fr, col0 = u.pn * BM + wc * 32 + 8 * fq;
#pragma unroll
        for (int ai = 0; ai < 2; ++ai)
#pragma unroll
            for (int m = 0; m < 4; ++m) { const int r = row0 + ai * HALF + m * 16;
#pragma unroll
                for (int bj = 0; bj < 2; ++bj) { const int c = col0 + bj * HALF; const u32x4 y = *(const u32x4*)(Yg + (size_t)r * 512 + c);
                    f32x4 v0 = acc[ai][bj][m][0], v1 = acc[ai][bj][m][1];
                    v0[0] = bflo(y.x) * sigmoidf_(v0[0]); v0[1] = bfhi(y.x) * sigmoidf_(v0[1]); v0[2] = bflo(y.y) * sigmoidf_(v0[2]); v0[3] = bfhi(y.y) * sigmoidf_(v0[3]);
                    v1[0] = bflo(y.z) * sigmoidf_(v1[0]); v1[1] = bfhi(y.z) * sigmoidf_(v1[1]); v1[2] = bflo(y.w) * sigmoidf_(v1[2]); v1[3] = bfhi(y.w) * sigmoidf_(v1[3]);
                    *(u32x4*)(O + (size_t)r * 1024 + c) = pack8(v0, v1); } }
    }
};
struct EpiPoolS {
    const float* scale; bf16_t* O;
    __device__ __forceinline__ void operator()(const Acc& acc, const Unit& u, int wr, int wc, int fr, int fq) const {
        const int row0 = u.pm * BM + wr * 64 + fr, col0 = u.pn * BM + wc * 32 + 8 * fq;
        f32x4 s[2][2];
#pragma unroll
        for (int bj = 0; bj < 2; ++bj) { s[bj][0] = *(const f32x4*)(scale + col0 + bj * HALF); s[bj][1] = *(const f32x4*)(scale + col0 + bj * HALF + 4); }
#pragma unroll
        for (int ai = 0; ai < 2; ++ai)
#pragma unroll
            for (int m = 0; m < 4; ++m) { const int r = row0 + ai * HALF + m * 16;
#pragma unroll
                for (int bj = 0; bj < 2; ++bj) { const int c = col0 + bj * HALF;
                    *(u32x4*)(O + (size_t)r * 1024 + 512 + c) = pack8(acc[ai][bj][m][0] * s[bj][0], acc[ai][bj][m][1] * s[bj][1]); } }
    }
};
struct EpiMid {
    const bf16_t* Yg; const float* scale; bf16_t* O;
    __device__ __forceinline__ void operator()(const Acc& acc, const Unit& u, int wr, int wc, int fr, int fq) const {
        if (u.pn < 2) { EpiGlu E{Yg, O}; E(acc, u, wr, wc, fr, fq); }
        else { EpiPoolS E{scale, O}; Unit v = u; v.pn = u.pn - 2; E(acc, v, wr, wc, fr, fq); }
    }
};
struct EpiSwiglu {
    unsigned char* H;
    __device__ __forceinline__ void operator()(const Acc& acc, const Unit& u, int wr, int wc, int fr, int fq) const {
        const int row0 = u.pm * BM + wr * 64 + fr, col0 = u.pn * HALF + wc * 32 + 8 * fq;
#pragma unroll
        for (int ai = 0; ai < 2; ++ai)
#pragma unroll
            for (int m = 0; m < 4; ++m) { const int r = row0 + ai * HALF + m * 16; f32x4 o[2];
#pragma unroll
                for (int n = 0; n < 2; ++n)
#pragma unroll
                    for (int j = 0; j < 4; ++j) { const float a = acc[ai][0][m][n][j], gq = acc[ai][1][m][n][j]; o[n][j] = a * sigmoidf_(a) * gq; }
                u32x2 w; w.x = pk4_fp8(o[0][0], o[0][1], o[0][2], o[0][3]); w.y = pk4_fp8(o[1][0], o[1][1], o[1][2], o[1][3]);
                *(u32x2*)(H + (size_t)r * 1024 + col0) = w; }
    }
};
struct EpiDown {
    const float* gate; bf16_t* O;
    __device__ __forceinline__ void operator()(const Acc& acc, const Unit& u, int wr, int wc, int fr, int fq) const {
        const int row0 = u.pm * BM + wr * 64 + fr, col0 = u.pn * BM + wc * 32 + 8 * fq;
#pragma unroll
        for (int ai = 0; ai < 2; ++ai)
#pragma unroll
            for (int m = 0; m < 4; ++m) { const int r = row0 + ai * HALF + m * 16; const float gt = gate[r];
#pragma unroll
                for (int bj = 0; bj < 2; ++bj) *(u32x4*)(O + (size_t)r * 1024 + col0 + bj * HALF) = pack8(acc[ai][bj][m][0] * gt, acc[ai][bj][m][1] * gt);
                asm volatile("" ::: "memory"); }
    }
};
}

struct Frame {
    LAS unsigned char* lds;
    int tid, lane, wave, vcu, G;
    float* out; unsigned char* ws;
};
struct Args { const float* in[27]; float* out; unsigned char* ws; int ph_lo, ph_hi; };

enum { I_X = 0, I_C, I_CTX, I_CCTX, I_WMOD, I_BMOD, I_GMPRE, I_GMPOST, I_GFPRE, I_GFPOST, I_WIN, I_LRE, I_LIM, I_LDT, I_BRE, I_BIM, I_CRE, I_CIM, I_S5D, I_WGLU, I_POOLW, I_POOLS, I_WOUT, I_WROUTER, I_WGATE, I_WUP, I_WDOWN };

__device__ __forceinline__ void tr_item(const float* W, int ldw, bf16_t* WT, int ldt, int k0, int n0, int drow0, int dk0, LAS float* scr, int lane) {
#pragma unroll 8
    for (int i = 0; i < 32; ++i) { const int kk = 2 * i + (lane >> 5); scr[kk * 33 + (lane & 31)] = W[(size_t)(k0 + kk) * ldw + n0 + (lane & 31)]; }
    asm volatile("s_waitcnt lgkmcnt(0)" ::: "memory");
    const int c = lane & 7;
#pragma unroll
    for (int j = 0; j < 4; ++j) { const int n = (lane >> 3) + 8 * j; const LAS float* s = scr + (8 * c) * 33 + n;
        u32x4 o; o.x = pk2(s[0 * 33], s[1 * 33]); o.y = pk2(s[2 * 33], s[3 * 33]); o.z = pk2(s[4 * 33], s[5 * 33]); o.w = pk2(s[6 * 33], s[7 * 33]);
        *(u32x4*)(WT + (size_t)(drow0 + n) * ldt + dk0 + k0 + 8 * c) = o; }
    asm volatile("s_waitcnt lgkmcnt(0)" ::: "memory");
}

__device__ __forceinline__ void tr_item8(const float* W, int ldw, unsigned char* WT, int ldt, int k0, int n0, int drow0, LAS float* scr, int lane) {
#pragma unroll 8
    for (int i = 0; i < 32; ++i) { const int kk = 2 * i + (lane >> 5); scr[kk * 33 + (lane & 31)] = W[(size_t)(k0 + kk) * ldw + n0 + (lane & 31)]; }
    asm volatile("s_waitcnt lgkmcnt(0)" ::: "memory");
    const int c = lane & 3;
#pragma unroll
    for (int j = 0; j < 2; ++j) { const int n = (lane >> 2) + 16 * j; const LAS float* sp = scr + (16 * c) * 33 + n;
        u32x4 o; o.x = pk4_fp8(sp[0 * 33] * W8_SCALE, sp[1 * 33] * W8_SCALE, sp[2 * 33] * W8_SCALE, sp[3 * 33] * W8_SCALE);
        o.y = pk4_fp8(sp[4 * 33] * W8_SCALE, sp[5 * 33] * W8_SCALE, sp[6 * 33] * W8_SCALE, sp[7 * 33] * W8_SCALE);
        o.z = pk4_fp8(sp[8 * 33] * W8_SCALE, sp[9 * 33] * W8_SCALE, sp[10 * 33] * W8_SCALE, sp[11 * 33] * W8_SCALE);
        o.w = pk4_fp8(sp[12 * 33] * W8_SCALE, sp[13 * 33] * W8_SCALE, sp[14 * 33] * W8_SCALE, sp[15 * 33] * W8_SCALE);
        *(u32x4*)(WT + (size_t)(drow0 + n) * ldt + k0 + 16 * c) = o; }
    asm volatile("s_waitcnt lgkmcnt(0)" ::: "memory");
}

__device__ __forceinline__ void s5_prep(Frame& F, const Args& A, int lg) {
    const int l = lg >> 5, g = lg & 31, tid = F.tid;
    LAS f32x2* apow = (LAS f32x2*)(F.lds + 40960);
    LAS f32x2* Bb = apow + 2 * 17 * 65;
    LAS f32x2* Cc = Bb + 2 * 64 * 16;
    for (int i = tid; i < 2 * 17 * 64; i += 512) { const int d = i / (17 * 64), k = (i / 64) % 17, p = i % 64; const size_t pg = (size_t)(l * 2 + d) * NG + g;
        const float lre = A.in[I_LRE][pg * SP + p], lim = A.in[I_LIM][pg * SP + p], dt = __expf(A.in[I_LDT][pg]);
        const float mag = __expf((float)k * lre * dt); float sn, cs; sincosf((float)k * lim * dt, &sn, &cs);
        apow[(d * 17 + k) * 65 + p] = (f32x2){mag * cs, mag * sn}; }
    for (int i = tid; i < 2 * 64 * 16; i += 512) { const int d = i >> 10, p = (i >> 4) & 63, h = i & 15; const size_t pg = (size_t)(l * 2 + d) * NG + g;
        const float lre = A.in[I_LRE][pg * SP + p], lim = A.in[I_LIM][pg * SP + p], dt = __expf(A.in[I_LDT][pg]);
        const float mag = __expf(lre * dt); float sn, cs; sincosf(lim * dt, &sn, &cs);
        const float nre = mag * cs - 1.0f, nim = mag * sn, den = lre * lre + lim * lim;
        const float cr = (nre * lre + nim * lim) / den, ci = (nim * lre - nre * lim) / den;
        const float br = A.in[I_BRE][(pg * SP + p) * SH + h], bi = A.in[I_BIM][(pg * SP + p) * SH + h];
        Bb[i] = (f32x2){cr * br - ci * bi, cr * bi + ci * br};
        Cc[(d * 16 + h) * 65 + p] = (f32x2){A.in[I_CRE][(pg * SH + h) * SP + p], A.in[I_CIM][(pg * SH + h) * SP + p]}; }
    __syncthreads();
    unsigned char* W = F.ws + WS_S5W + (size_t)lg * S5W_STRIDE;
    for (int i = tid; i < 8192; i += 512) {
        const int r = i >> 12, x = i & 4095, nt = x >> 9, kk = (x >> 6) & 7, ln = x & 63, c = ln & 15, q = ln >> 4;
        const int n = 16 * nt + c, p = n >> 1, ri = n & 1, j = 2 * kk + (q >> 1), h0 = 8 * (q & 1), pw = r ? j : 15 - j;
        const f32x2 ap = apow[(r * 17 + pw) * 65 + p]; float v[8];
#pragma unroll
        for (int jj = 0; jj < 8; ++jj) { const f32x2 bb = Bb[(r * 64 + p) * 16 + h0 + jj]; v[jj] = ri ? (ap.x * bb.y + ap.y * bb.x) : (ap.x * bb.x - ap.y * bb.y); }
        u32x4 o; o.x = pk2(v[0], v[1]); o.y = pk2(v[2], v[3]); o.z = pk2(v[4], v[5]); o.w = pk2(v[6], v[7]);
        *(u32x4*)(W + (r ? S5_OFF_WSR : S5_OFF_WSF) + (size_t)x * 16) = o; }
    for (int i = tid; i < 8192; i += 512) {
        const int r = i >> 12, x = i & 4095, nt = x >> 8, kk = (x >> 6) & 3, ln = x & 63, h = ln & 15, q = ln >> 4;
        const int pw = r ? 16 - nt : nt + 1; float v[8];
#pragma unroll
        for (int jj = 0; jj < 8; ++jj) { const int p = 16 * kk + 4 * q + (jj >> 1); const f32x2 ap = apow[(r * 17 + pw) * 65 + p], cc = Cc[(r * 16 + h) * 65 + p];
            v[jj] = (jj & 1) ? -(cc.x * ap.y + cc.y * ap.x) : (cc.x * ap.x - cc.y * ap.y); }
        u32x4 o; o.x = pk2(v[0], v[1]); o.y = pk2(v[2], v[3]); o.z = pk2(v[4], v[5]); o.w = pk2(v[6], v[7]);
        *(u32x4*)(W + (r ? S5_OFF_WOR : S5_OFF_WOF) + (size_t)x * 16) = o; }
    if (tid < 31 * 16) {
        const int di = tid >> 4, h = tid & 15, dl = di - 15; float acc[16];
#pragma unroll
        for (int k = 0; k < 16; ++k) acc[k] = 0.f;
#pragma unroll
        for (int d = 0; d < 2; ++d) {
            if ((d == 0 && dl >= 0) || (d == 1 && dl <= 0)) { const int tau = d ? -dl : dl;
                for (int p = 0; p < 64; ++p) { const f32x2 cc = Cc[(d * 16 + h) * 65 + p], ap = apow[(d * 17 + tau) * 65 + p];
                    const float zr = cc.x * ap.x - cc.y * ap.y, zi = cc.x * ap.y + cc.y * ap.x;
#pragma unroll
                    for (int k = 0; k < 16; ++k) { const f32x2 bb = Bb[(d * 64 + p) * 16 + k]; acc[k] += zr * bb.x - zi * bb.y; } } } }
        { const float dsk = (dl == 0) ? A.in[I_S5D][l * DS5 + g * 16 + h] : 0.f;
#pragma unroll
          for (int k = 0; k < 16; ++k) acc[k] += (k == h) ? dsk : 0.f; }
        u32x4 o0, o1; o0.x = pk2(acc[0], acc[1]); o0.y = pk2(acc[2], acc[3]); o0.z = pk2(acc[4], acc[5]); o0.w = pk2(acc[6], acc[7]);
        o1.x = pk2(acc[8], acc[9]); o1.y = pk2(acc[10], acc[11]); o1.z = pk2(acc[12], acc[13]); o1.w = pk2(acc[14], acc[15]);
        *(u32x4*)(W + S5_OFF_TT + (size_t)tid * 32) = o0; *(u32x4*)(W + S5_OFF_TT + (size_t)tid * 32 + 16) = o1;
    }
    if (tid < 128) ((f32x2*)(W + S5_OFF_A16))[tid] = apow[((tid >> 6) * 17 + 16) * 65 + (tid & 63)];
    __syncthreads();
}
__device__ __forceinline__ void p0_prologue(Frame& F, const Args& A) {
    unsigned char* ws = F.ws;
    const int gw = F.vcu * 8 + F.wave, NGW = F.G * 8;
    LAS float* sil = (LAS float*)(F.lds);
    for (int i = F.tid; i < 9 * 1024; i += 512) { const float v = (i < 8192) ? A.in[I_C][i] : A.in[I_CCTX][i - 8192]; sil[i] = v * sigmoidf_(v); }
    __syncthreads();
    LAS float* scr = (LAS float*)(F.lds + 40960 + F.wave * 8448);
    float* mod = (float*)(ws + WS_MOD);
    if (F.vcu >= 64 || F.G < 256) {
        LAS float* part = (LAS float*)(F.lds + 40960);
        for (int it = (F.G < 256 ? F.vcu : F.vcu - 64); it < 2 * 96; it += (F.G < 256 ? F.G : F.G - 64)) {
            const int l = it / 96, n0 = (it % 96) * 64, n = n0 + F.lane;
            const float* W = A.in[I_WMOD] + (size_t)l * D * NMOD + n + (size_t)(F.wave * 128) * NMOD;
            float acc[9];
#pragma unroll
            for (int r = 0; r < 9; ++r) acc[r] = 0.f;
#pragma unroll 32
            for (int k = 0; k < 128; ++k) { const float w = W[(size_t)k * NMOD];
#pragma unroll
                for (int r = 0; r < 9; ++r) acc[r] += sil[r * 1024 + F.wave * 128 + k] * w; }
#pragma unroll
            for (int r = 0; r < 9; ++r) part[(F.wave * 9 + r) * 64 + F.lane] = acc[r];
            __syncthreads();
            for (int o = F.tid; o < 9 * 64; o += 512) { float sm = 0.f;
#pragma unroll
                for (int w = 0; w < 8; ++w) sm += part[w * 576 + o];
                const int r = o >> 6, nn = n0 + (o & 63);
                mod[((size_t)l * 9 + r) * NMOD + nn] = sm + A.in[I_BMOD][l * NMOD + nn]; }
            __syncthreads();
        }
    }
    for (int lg = F.vcu; lg < 64; lg += F.G) s5_prep(F, A, lg);
    constexpr int IT_SQ = 16 * 32;
    constexpr int IT_GLU = 8 * 16, IT_POOL = 4 * 2 * 4;
    constexpr int PER_L = 2 * IT_SQ + IT_GLU + IT_POOL;
    constexpr int N_SMALL = 2 * PER_L;
    constexpr int N_GU = 2 * 16 * 2 * IT_SQ, N_D = 2 * 16 * IT_SQ;
    for (int it = gw; it < N_SMALL + N_GU + N_D; it += NGW) {
        int r = it;
        if (r < N_SMALL) {
            const int l = r / PER_L; r -= l * PER_L;
            if (r < IT_SQ) { const int kb = r / 32, nb = r % 32; tr_item(A.in[I_WIN] + (size_t)l * D * D, D, (bf16_t*)(ws + WS_WIN) + (size_t)l * D * D, D, kb * 64, nb * 32, nb * 32, 0, scr, F.lane); continue; }
            r -= IT_SQ;
            if (r < IT_SQ) { const int kb = r / 32, nb = r % 32; tr_item(A.in[I_WOUT] + (size_t)l * D * D, D, (bf16_t*)(ws + WS_WOUT) + (size_t)l * D * D, D, kb * 64, nb * 32, nb * 32, 0, scr, F.lane); continue; }
            r -= IT_SQ;
            if (r < IT_GLU) { const int kb = r / 16, nb = r % 16; tr_item(A.in[I_WGLU] + (size_t)l * DS5 * DS5, DS5, (bf16_t*)(ws + WS_WGLU) + (size_t)l * DS5 * DS5, DS5, kb * 64, nb * 32, nb * 32, 0, scr, F.lane); continue; }
            r -= IT_GLU;
            { const int gi = r / 8, q = r % 8, kb = q / 4, nb = q % 4;
              tr_item(A.in[I_POOLW] + ((size_t)l * 4 + gi) * 128 * 128, 128, (bf16_t*)(ws + WS_WPOOL) + (size_t)l * 512 * 512, 512, kb * 64, nb * 32, gi * 128 + nb * 32, gi * 128, scr, F.lane); continue; }
        }
        r -= N_SMALL;
        if (r < N_GU) {
            const int le = r / (2 * IT_SQ); int q = r % (2 * IT_SQ); const int up = q / IT_SQ; q %= IT_SQ; const int kb = q / 32, nb = q % 32, n0 = nb * 32;
            const float* W = (up ? A.in[I_WUP] : A.in[I_WGATE]) + (size_t)le * D * D;
            tr_item8(W, D, (unsigned char*)(ws + WS_WGU) + (size_t)le * 2048 * D, D, kb * 64, n0, 256 * (n0 / 128) + (n0 % 128) + up * 128, scr, F.lane); continue;
        }
        r -= N_GU;
        { const int le = r / IT_SQ, q = r % IT_SQ, kb = q / 32, nb = q % 32;
          tr_item8(A.in[I_WDOWN] + (size_t)le * D * D, D, (unsigned char*)(ws + WS_WD) + (size_t)le * D * D, D, kb * 64, nb * 32, nb * 32, scr, F.lane); }
    }
    const int gt = F.vcu * 512 + F.tid, NGT = F.G * 512;
    for (int i = gt; i < 2 * 512 * 64; i += NGT) { const int row = (i / 64) % 512, c8 = i % 64; if ((row >> 7) != (c8 >> 4)) *(u32x4*)((bf16_t*)(ws + WS_WPOOL) + (size_t)i * 8) = (u32x4){0u, 0u, 0u, 0u}; }
    for (int i = gt; i < PT; i += NGT) ((int*)(ws + WS_IDENT))[i] = i;
    for (int i = gt; i < 2 * 16 * 1024; i += NGT) { const int l = i / 16384, e = (i / 1024) % 16, k = i % 1024; ((float*)(ws + WS_WRT))[i] = A.in[I_WROUTER][((size_t)l * D + k) * NE + e]; }
}

struct RowF32 { f32x4 v[4]; };
__device__ __forceinline__ void ld_row_f32(RowF32& r, const float* p, int lane) {
#pragma unroll
    for (int j = 0; j < 2; ++j) { r.v[2 * j] = *(const f32x4*)(p + 8 * lane + 512 * j); r.v[2 * j + 1] = *(const f32x4*)(p + 8 * lane + 512 * j + 4); }
}
__device__ __forceinline__ void ld_vec16(float (&o)[16], const float* p, int lane) {
#pragma unroll
    for (int j = 0; j < 2; ++j) { const f32x4 a = *(const f32x4*)(p + 8 * lane + 512 * j), b = *(const f32x4*)(p + 8 * lane + 512 * j + 4);
#pragma unroll
        for (int q = 0; q < 4; ++q) { o[8 * j + q] = a[q]; o[8 * j + 4 + q] = b[q]; } }
}
__device__ __forceinline__ void st_row_bf16(bf16_t* p, const float (&h)[16], int lane) {
#pragma unroll
    for (int j = 0; j < 2; ++j) { u32x4 w; w.x = pk2(h[8 * j], h[8 * j + 1]); w.y = pk2(h[8 * j + 2], h[8 * j + 3]); w.z = pk2(h[8 * j + 4], h[8 * j + 5]); w.w = pk2(h[8 * j + 6], h[8 * j + 7]);
        *(u32x4*)(p + 8 * lane + 512 * j) = w; }
}
struct RowRaw { u32x4 v[4]; };
__device__ __forceinline__ void ld_row_raw(RowRaw& r, const void* p, bool bf, int lane) {
    if (bf) { const bf16_t* q = (const bf16_t*)p; r.v[0] = *(const u32x4*)(q + 8 * lane); r.v[1] = *(const u32x4*)(q + 8 * lane + 512); }
    else { const float* q = (const float*)p; r.v[0] = *(const u32x4*)(q + 8 * lane); r.v[1] = *(const u32x4*)(q + 8 * lane + 4); r.v[2] = *(const u32x4*)(q + 8 * lane + 512); r.v[3] = *(const u32x4*)(q + 8 * lane + 516); }
}
__device__ __forceinline__ void row_to_f32(const RowRaw& r, bool bf, float (&x)[16]) {
    if (bf) {
#pragma unroll
        for (int j = 0; j < 2; ++j) { x[8 * j] = bflo(r.v[j].x); x[8 * j + 1] = bfhi(r.v[j].x); x[8 * j + 2] = bflo(r.v[j].y); x[8 * j + 3] = bfhi(r.v[j].y);
            x[8 * j + 4] = bflo(r.v[j].z); x[8 * j + 5] = bfhi(r.v[j].z); x[8 * j + 6] = bflo(r.v[j].w); x[8 * j + 7] = bfhi(r.v[j].w); }
    } else {
#pragma unroll
        for (int k = 0; k < 4; ++k) { x[4 * k] = __uint_as_float(r.v[k].x); x[4 * k + 1] = __uint_as_float(r.v[k].y); x[4 * k + 2] = __uint_as_float(r.v[k].z); x[4 * k + 3] = __uint_as_float(r.v[k].w); }
    }
}
__device__ __forceinline__ void st_row_f32(float* p, const float (&x)[16], int lane) {
#pragma unroll
    for (int j = 0; j < 2; ++j) { *(f32x4*)(p + 8 * lane + 512 * j) = (f32x4){x[8 * j], x[8 * j + 1], x[8 * j + 2], x[8 * j + 3]};
                                  *(f32x4*)(p + 8 * lane + 512 * j + 4) = (f32x4){x[8 * j + 4], x[8 * j + 5], x[8 * j + 6], x[8 * j + 7]}; }
}
__device__ __forceinline__ void p1_norm(Frame& F, const Args& A, int l, const float* xsrc, const float* csrc) {
    const int gw = F.vcu * 8 + F.wave, NGW = F.G * 8, lane = F.lane;
    const float* gpre = A.in[I_GMPRE] + l * D; const float* mod = (const float*)(F.ws + WS_MOD) + (size_t)l * 9 * NMOD;
    bf16_t* hx = (bf16_t*)(F.ws + WS_HX);
    const int rpw = (MT + NGW - 1) / NGW, r0 = gw * rpw, r1 = min(r0 + rpw, MT);
    if (r0 >= r1) return;
    float PA[16], PS[16]; int cur_bi = -1;
    RowF32 cur, nxt;
    ld_row_f32(cur, r0 < MX ? xsrc + (size_t)r0 * D : csrc + (size_t)(r0 - MX) * D, lane);
    for (int row = r0; row < r1; ++row) {
        if (row + 1 < r1) { const int rn = row + 1; ld_row_f32(nxt, rn < MX ? xsrc + (size_t)rn * D : csrc + (size_t)(rn - MX) * D, lane); }
        const int bi = row < MX ? (row >> 13) : 8;
        if (bi != cur_bi) { cur_bi = bi; const float* mb = mod + (size_t)bi * NMOD; float g_[16], sc[16]; ld_vec16(g_, gpre, lane); ld_vec16(sc, mb + D, lane); ld_vec16(PS, mb, lane);
#pragma unroll
            for (int k = 0; k < 16; ++k) PA[k] = g_[k] * (1.0f + sc[k]); }
        float ss = 0.f;
#pragma unroll
        for (int k = 0; k < 4; ++k) ss += cur.v[k][0] * cur.v[k][0] + cur.v[k][1] * cur.v[k][1] + cur.v[k][2] * cur.v[k][2] + cur.v[k][3] * cur.v[k][3];
        const float rstd = rsqrtf(wave_sum(ss) * (1.0f / D) + RMS_EPS);
        float h[16];
#pragma unroll
        for (int k = 0; k < 4; ++k)
#pragma unroll
            for (int q = 0; q < 4; ++q) h[4 * k + q] = cur.v[k][q] * rstd * PA[4 * k + q] + PS[4 * k + q];
        st_row_bf16(hx + (size_t)row * D, h, lane);
        cur = nxt;
    }
}

constexpr int L_U = 0, L_X = 33792, L_SF = 67072, L_SR = 84480, L_TT = 101888;
__device__ __forceinline__ void s5_mfma(Frame& F, int l, bool wctx) {
    const int tid = F.tid, lane = F.lane, wave = F.wave, c = lane & 15, q = lane >> 4;
    LAS unsigned char* lds = F.lds;
    LAS float* Xs = (LAS float*)(lds + L_X);
    const bf16_t* Us5 = (const bf16_t*)(F.ws + WS_R1 + R1_US5);
    bf16_t* Yg = (bf16_t*)(F.ws + WS_R1 + R1_YG);
    for (int bg = F.vcu; bg < NB * NG; bg += F.G) {
        const int b = bg / NG, g = bg % NG;
        const unsigned char* W = F.ws + WS_S5W + (size_t)(l * NG + g) * S5W_STRIDE;
        const unsigned char* useq = (const unsigned char*)(Us5 + (size_t)bg * NSEQ * 16);
        unsigned char* srs = F.ws + WS_R2 + (size_t)bg * (528 * 256);
        for (int x = tid; x < 31 * 16 * 2; x += 512) { const int row = x >> 1, half = x & 1; *(LAS u32x4*)(lds + L_TT + row * 48 + half * 16) = *(const u32x4*)(W + S5_OFF_TT + row * 32 + half * 16); }
        bf16x8 Bw[8];
#pragma unroll
        for (int kk = 0; kk < 8; ++kk) Bw[kk] = *(const bf16x8*)(W + (S5_OFF_WSR + (wave * 8 + kk) * 1024) + (unsigned)lane * 16u);
        f32x2 a16 = ((const f32x2*)(W + S5_OFF_A16))[64 + lane];
        float sre = 0.f, sim = 0.f;
        u32x4 pu[4];
#pragma unroll
        for (int k = 0; k < 4; ++k) { const int x = tid + 512 * k; if (x < 16 * 32) pu[k] = *(const u32x4*)(useq + 8192 * k + (unsigned)tid * 16u); }
#pragma nounroll
        for (int mbi = 0; mbi < 9; ++mbi) {
            const int mb = (mbi == 0) ? 0 : 9 - mbi;
            const int c0 = (mb == 0) ? 0 : 16 + 64 * (mb - 1), nch = (mb == 0) ? 16 : 64, nmt = nch >> 4;
#pragma unroll
            for (int k = 0; k < 4; ++k) { const int x = tid + 512 * k; if (x < nch * 32) *(LAS u32x4*)(lds + L_U + (x >> 5) * 528 + (x & 31) * 16) = pu[k]; }
            if (mbi < 8) { const int c0n = 16 + 64 * (7 - mbi);
#pragma unroll
                for (int k = 0; k < 4; ++k) pu[k] = *(const u32x4*)(useq + (c0n * 512 + 8192 * k) + (unsigned)tid * 16u); }
            __syncthreads();
#pragma nounroll
            for (int mt = 0; mt < nmt; ++mt) {
                f32x4 acc = (f32x4){0.f, 0.f, 0.f, 0.f};
#pragma unroll
                for (int kk = 0; kk < 8; ++kk) { const bf16x8 Af = *(const LAS bf16x8*)(lds + L_U + (16 * mt + c) * 528 + kk * 64 + q * 16); acc = __builtin_amdgcn_mfma_f32_16x16x32_bf16(Af, Bw[kk], acc, 0, 0, 0);
                    if ((kk & 3) == 3) asm volatile("" ::: "memory"); }
#pragma unroll
                for (int jj = 0; jj < 4; ++jj) Xs[(16 * mt + 4 * q + jj) * 130 + 16 * wave + c] = acc[jj];
            }
            __syncthreads();
            if (wave == 0) {
                for (int cb = nch - 4; cb >= 0; cb -= 4) { f32x2 xv[4];
#pragma unroll
                    for (int k = 0; k < 4; ++k) xv[k] = *(const LAS f32x2*)(Xs + (cb + k) * 130 + 2 * lane);
#pragma unroll
                    for (int k = 3; k >= 0; --k) { *(LAS unsigned*)(lds + L_SR + (cb + k) * 272 + lane * 4) = pk2(sre, sim);
                        const float nr = a16.x * sre - a16.y * sim + xv[k].x, ni = a16.x * sim + a16.y * sre + xv[k].y; sre = nr; sim = ni; } }
            }
            __syncthreads();
            for (int x = tid; x < nch * 16; x += 512) *(u32x4*)(srs + c0 * 256 + (unsigned)x * 16u) = *(const LAS u32x4*)(lds + L_SR + (x >> 4) * 272 + (x & 15) * 16);
            __syncthreads();
        }
        __threadfence(); __syncthreads(); __builtin_amdgcn_fence(__ATOMIC_ACQUIRE, "agent");
        const int tidF = launder(tid), laneF = tidF & 63, cF = laneF & 15, qF = laneF >> 4;
#pragma unroll
        for (int kk = 0; kk < 8; ++kk) Bw[kk] = *(const bf16x8*)(W + (S5_OFF_WSF + (wave * 8 + kk) * 1024) + (unsigned)laneF * 16u);
        a16 = ((const f32x2*)(W + S5_OFF_A16))[laneF];
        sre = 0.f; sim = 0.f;
        u32x4 ps[2];
#pragma unroll
        for (int k = 0; k < 4; ++k) { const int x = tidF + 512 * k; if (x < 16 * 32) pu[k] = *(const u32x4*)(useq + 8192 * k + (unsigned)tidF * 16u); }
#pragma unroll
        for (int k = 0; k < 2; ++k) { const int x = tidF + 512 * k; if (x < 16 * 16) ps[k] = *(const u32x4*)(srs + 8192 * k + (unsigned)tidF * 16u); }
#pragma nounroll
        for (int mb = 0; mb < 9; ++mb) {
            const int c0 = (mb == 0) ? 0 : 16 + 64 * (mb - 1), nch = (mb == 0) ? 16 : 64, nmt = nch >> 4;
#pragma unroll
            for (int k = 0; k < 4; ++k) { const int x = tidF + 512 * k; if (x < nch * 32) *(LAS u32x4*)(lds + L_U + (x >> 5) * 528 + (x & 31) * 16) = pu[k]; }
#pragma unroll
            for (int k = 0; k < 2; ++k) { const int x = tidF + 512 * k; if (x < nch * 16) *(LAS u32x4*)(lds + L_SR + (x >> 4) * 272 + (x & 15) * 16) = ps[k]; }
            if (mb < 8) { const int c0n = 16 + 64 * mb;
#pragma unroll
                for (int k = 0; k < 4; ++k) pu[k] = *(const u32x4*)(useq + (c0n * 512 + 8192 * k) + (unsigned)tidF * 16u);
#pragma unroll
                for (int k = 0; k < 2; ++k) ps[k] = *(const u32x4*)(srs + (c0n * 256 + 8192 * k) + (unsigned)tidF * 16u); }
            __syncthreads();
#pragma nounroll
            for (int mt = 0; mt < nmt; ++mt) {
                f32x4 acc = (f32x4){0.f, 0.f, 0.f, 0.f};
#pragma unroll
                for (int kk = 0; kk < 8; ++kk) { const bf16x8 Af = *(const LAS bf16x8*)(lds + L_U + (16 * mt + cF) * 528 + kk * 64 + qF * 16); acc = __builtin_amdgcn_mfma_f32_16x16x32_bf16(Af, Bw[kk], acc, 0, 0, 0);
                    if ((kk & 3) == 3) asm volatile("" ::: "memory"); }
#pragma unroll
                for (int jj = 0; jj < 4; ++jj) Xs[(16 * mt + 4 * qF + jj) * 130 + 16 * wave + cF] = acc[jj];
            }
            __syncthreads();
            if (wave == 0) {
                for (int cb = 0; cb < nch; cb += 4) { f32x2 xv[4];
#pragma unroll
                    for (int k = 0; k < 4; ++k) xv[k] = *(const LAS f32x2*)(Xs + (cb + k) * 130 + 2 * laneF);
#pragma unroll
                    for (int k = 0; k < 4; ++k) { *(LAS unsigned*)(lds + L_SF + (cb + k) * 272 + laneF * 4) = pk2(sre, sim);
                        const float nr = a16.x * sre - a16.y * sim + xv[k].x, ni = a16.x * sim + a16.y * sre + xv[k].y; sre = nr; sim = ni; } }
            }
            __syncthreads();
            if (mb > 0 || wctx) {
                bf16x8 Bo[2][4], Br[2][4];
#pragma unroll
                for (int e = 0; e < 2; ++e)
#pragma unroll
                    for (int kk = 0; kk < 4; ++kk) { Bo[e][kk] = *(const bf16x8*)(W + (S5_OFF_WOF + ((2 * wave + e) * 4 + kk) * 1024) + (unsigned)laneF * 16u);
                                                     Br[e][kk] = *(const bf16x8*)(W + (S5_OFF_WOR + ((2 * wave + e) * 4 + kk) * 1024) + (unsigned)laneF * 16u); }
#pragma nounroll
                for (int mt = 0; mt < nmt; ++mt) {
                    f32x4 acc[2];
                    acc[0] = (f32x4){0.f, 0.f, 0.f, 0.f}; acc[1] = acc[0];
#pragma unroll
                    for (int kk = 0; kk < 8; ++kk) { const bf16x8 Af = *(const LAS bf16x8*)(lds + L_U + (16 * mt + cF) * 528 + kk * 64 + qF * 16);
#pragma unroll
                        for (int e = 0; e < 2; ++e) { const int dl = (2 * wave + e) - 2 * kk - (qF >> 1);
                            const bf16x8 Tf = *(const LAS bf16x8*)(lds + L_TT + ((dl + 15) * 16 + cF) * 48 + (qF & 1) * 16);
                            acc[e] = __builtin_amdgcn_mfma_f32_16x16x32_bf16(Tf, Af, acc[e], 0, 0, 0); }
                        if (kk & 1) asm volatile("" ::: "memory"); }
#pragma unroll
                    for (int kk = 0; kk < 4; ++kk) { const bf16x8 Sf = *(const LAS bf16x8*)(lds + L_SF + (16 * mt + cF) * 272 + kk * 64 + qF * 16), Sr = *(const LAS bf16x8*)(lds + L_SR + (16 * mt + cF) * 272 + kk * 64 + qF * 16);
#pragma unroll
                        for (int e = 0; e < 2; ++e) { acc[e] = __builtin_amdgcn_mfma_f32_16x16x32_bf16(Bo[e][kk], Sf, acc[e], 0, 0, 0); acc[e] = __builtin_amdgcn_mfma_f32_16x16x32_bf16(Br[e][kk], Sr, acc[e], 0, 0, 0); }
                        if (kk & 1) asm volatile("" ::: "memory"); }
#pragma unroll
                    for (int e = 0; e < 2; ++e) { const int n = (c0 + 16 * mt + cF) * 16 + 2 * wave + e;
                        const int row = (n < LC) ? (MX + b * LC + n) : (b * T + (n - LC));
                        u32x2 w; w.x = pk2(gelu_tanh(acc[e][0]), gelu_tanh(acc[e][1])); w.y = pk2(gelu_tanh(acc[e][2]), gelu_tanh(acc[e][3]));
                        *(u32x2*)(Yg + (size_t)row * 512 + g * 16 + 4 * qF) = w; }
                }
            }
            __syncthreads();
        }
    }
}
__device__ __forceinline__ void add8(float (&s)[8], const u32x4& x, float w) {
    s[0] += w * bflo(x.x); s[1] += w * bfhi(x.x); s[2] += w * bflo(x.y); s[3] += w * bfhi(x.y); s[4] += w * bflo(x.z); s[5] += w * bfhi(x.z); s[6] += w * bflo(x.w); s[7] += w * bfhi(x.w);
}
template <bool SUBV>
__device__ __forceinline__ void pool_line(const bf16_t* src, const bf16_t* vsub, bf16_t* dst, size_t stride, int n, int p0, int hw) {
    float s[8];
#pragma unroll
    for (int k = 0; k < 8; ++k) s[k] = 0.f;
    {
        u32x4 x[16];
#pragma unroll
        for (int k = 0; k < 16; ++k) { const int pos = p0 - 8 + k; x[k] = *(const u32x4*)(src + (size_t)min(max(pos, 0), n - 1) * stride); }
#pragma unroll
        for (int k = 0; k < 16; ++k) { const int pos = p0 - 8 + k; const bool in = pos >= max(p0 - hw, 0) && pos < min(p0 + hw, n); add8(s, x[k], in ? 1.0f : 0.0f); }
    }
#pragma nounroll
    for (int pb = p0; pb < p0 + 32; pb += 4) {
        u32x4 xa[4], xs[4], xv[4];
#pragma unroll
        for (int k = 0; k < 4; ++k) { const int p = pb + k; xa[k] = *(const u32x4*)(src + (size_t)min(p + hw, n - 1) * stride); xs[k] = *(const u32x4*)(src + (size_t)max(p - hw, 0) * stride);
            if (SUBV) xv[k] = *(const u32x4*)(vsub + (size_t)p * stride); }
#pragma unroll
        for (int k = 0; k < 4; ++k) { const int p = pb + k;
            const float inv = 1.0f / (float)(min(p + hw, n) - max(p - hw, 0));
            float o[8];
#pragma unroll
            for (int j = 0; j < 8; ++j) o[j] = s[j] * inv;
            if (SUBV) add8(o, xv[k], -1.0f);
            u32x4 w; w.x = pk2(o[0], o[1]); w.y = pk2(o[2], o[3]); w.z = pk2(o[4], o[5]); w.w = pk2(o[6], o[7]);
            *(u32x4*)(dst + (size_t)p * stride) = w;
            add8(s, xa[k], (p + hw < n) ? 1.0f : 0.0f); add8(s, xs[k], (p - hw >= 0) ? -1.0f : 0.0f); }
    }
}
constexpr size_t R2_HV = 64 * MiB;
__device__ __forceinline__ void pool_v(Frame& F) {
    const int gw = F.vcu * 8 + F.wave, NGW = F.G * 8, lane = F.lane, hw = 1 << (lane >> 4);
    const bf16_t* Vp = (const bf16_t*)(F.ws + WS_R1 + R1_VP);
    bf16_t* Hv = (bf16_t*)(F.ws + WS_R2 + R2_HV);
    for (int it = gw; it < NB * 64 * 4; it += NGW) {
        const int rq = it & 3, c = (it >> 2) & 63, b = it >> 8;
        const size_t base = ((size_t)(b * T + c)) * 512 + 8 * lane;
        pool_line<false>(Vp + base, nullptr, Hv + base, (size_t)64 * 512, 128, rq * 32, hw);
    }
}
__device__ __forceinline__ void pool_h(Frame& F, bool with_ctx) {
    const int gw = F.vcu * 8 + F.wave, NGW = F.G * 8, lane = F.lane, hw = 1 << (lane >> 4);
    const bf16_t* Vp = (const bf16_t*)(F.ws + WS_R1 + R1_VP);
    const bf16_t* Hv = (const bf16_t*)(F.ws + WS_R2 + R2_HV);
    bf16_t* Z = (bf16_t*)(F.ws + WS_R1 + R1_Z);
    const int nx = NB * 128 * 2, ntask = nx + (with_ctx ? NB * 8 : 0);
    for (int it = gw; it < ntask; it += NGW) {
        if (it < nx) { const int ch = it & 1, r = (it >> 1) & 127, b = it >> 8; const size_t base = ((size_t)(b * T + r * 64)) * 512 + 8 * lane;
            pool_line<true>(Hv + base, Vp + base, Z + base, 512, 64, ch * 32, hw); }
        else { const int j = it - nx, lq = j & 7, b = j >> 3; const size_t base = ((size_t)(MX + b * LC)) * 512 + 8 * lane;
            pool_line<true>(Vp + base, Vp + base, Z + base, 512, LC, lq * 32, hw); }
    }
}

__device__ __forceinline__ float xor4f(float x) { return dppx<0x1B>(dppx<0x141>(x)); }
__device__ __forceinline__ float xor8f(float x) { return dppx<0x128>(x); }
__device__ __forceinline__ void swap32(float& a, float& b) { const auto r = __builtin_amdgcn_permlane32_swap(__float_as_uint(a), __float_as_uint(b), false, false); a = __uint_as_float(r[0]); b = __uint_as_float(r[1]); }
__device__ __forceinline__ void swap16(float& a, float& b) { const auto r = __builtin_amdgcn_permlane16_swap(__float_as_uint(a), __float_as_uint(b), false, false); a = __uint_as_float(r[0]); b = __uint_as_float(r[1]); }
__device__ __forceinline__ float reduce16(float (&v)[16], int lane) {
#pragma unroll
    for (int i = 0; i < 8; ++i) { float a = v[i], b = v[i + 8]; swap32(a, b); v[i] = a + b; }
#pragma unroll
    for (int i = 0; i < 4; ++i) { float a = v[i], b = v[i + 4]; swap16(a, b); v[i] = a + b; }
#pragma unroll
    for (int i = 0; i < 2; ++i) { const float send = (lane & 8) ? v[i] : v[i + 2], keep = (lane & 8) ? v[i + 2] : v[i]; v[i] = keep + xor8f(send); }
    { const float send = (lane & 4) ? v[0] : v[1], keep = (lane & 4) ? v[1] : v[0]; v[0] = keep + xor4f(send); }
    v[0] += dppx<0x4E>(v[0]); v[0] += dppx<0xB1>(v[0]);
    return v[0];
}
__device__ __forceinline__ float max_idx16(float m) {
    m = fmaxf(m, xor4f(m)); m = fmaxf(m, xor8f(m));
    { float a = m, b = m; swap16(a, b); m = fmaxf(a, b); }
    { float a = m, b = m; swap32(a, b); m = fmaxf(a, b); }
    return m;
}
__device__ __forceinline__ float sum_idx16(float x) {
    x += xor4f(x); x += xor8f(x);
    { float a = x, b = x; swap16(a, b); x = a + b; }
    { float a = x, b = x; swap32(a, b); x = a + b; }
    return x;
}
struct Row6 { u32x4 m[2]; RowRaw x; };
constexpr int P6_WB = 0, P6_HT = 65536, P6_HSTR = 2064, P6_RED = P6_HT + 2 * 16 * P6_HSTR;
static_assert(P6_RED + 8192 <= MISC_OFF, "P6 LDS map");
__device__ __forceinline__ void p6_rows(Frame& F, const Args& A, int l, const float* xf32, const float* csrc, float* cdst, bool with_ctx) {
    bf16_t* XB = (bf16_t*)(F.ws + WS_XB); const bool xbf = (l != 0);
    const int lane = F.lane, wave = F.wave;
    LAS unsigned char* lds = F.lds;
    { const float* wrt = (const float*)(F.ws + WS_WRT) + (size_t)l * 16 * 1024;
      for (int i = F.tid; i < 32 * 64; i += 512) { const int kk = i >> 6, ln = i & 63, e = ln & 15, q = ln >> 4; const float* wp = wrt + e * 1024 + 32 * kk + 8 * q;
          const f32x4 w0 = *(const f32x4*)wp, w1 = *(const f32x4*)(wp + 4); float hi[8], lo[8];
#pragma unroll
          for (int j = 0; j < 4; ++j) { hi[j] = __uint_as_float(f2bf(w0[j]) << 16); lo[j] = w0[j] - hi[j]; hi[4 + j] = __uint_as_float(f2bf(w1[j]) << 16); lo[4 + j] = w1[j] - hi[4 + j]; }
          u32x4 h, lw; h.x = pk2(hi[0], hi[1]); h.y = pk2(hi[2], hi[3]); h.z = pk2(hi[4], hi[5]); h.w = pk2(hi[6], hi[7]);
          lw.x = pk2(lo[0], lo[1]); lw.y = pk2(lo[2], lo[3]); lw.z = pk2(lo[4], lo[5]); lw.w = pk2(lo[6], lo[7]);
          *(LAS u32x4*)(lds + P6_WB + i * 16) = h; *(LAS u32x4*)(lds + P6_WB + 32768 + i * 16) = lw; } }
    __syncthreads();
    const float* gpost = A.in[I_GMPOST] + l * D; const float* gpre = A.in[I_GFPRE] + l * D;
    const float* mod = (const float*)(F.ws + WS_MOD) + (size_t)l * 9 * NMOD;
    const bf16_t* mix = (const bf16_t*)(F.ws + WS_R1);
    unsigned char* hx8 = (unsigned char*)(F.ws + WS_HX);
    float* aff = (float*)(F.ws + WS_AFF); float* affc = (float*)(F.ws + WS_AFFC);
    const int nrows = with_ctx ? MT : MX;
    const int rpb = ((nrows + F.G - 1) / F.G + 1) & ~1;
    const int R0 = F.vcu * rpb, R1 = min(R0 + rpb, nrows);
#define LD_ROW6(dstv, rr) do { const int _r = (rr); _Pragma("unroll") for (int _j = 0; _j < 2; ++_j) (dstv).m[_j] = *(const u32x4*)(mix + (size_t)_r * D + 8 * lane + 512 * _j); \
        if (_r < MX) ld_row_raw((dstv).x, xbf ? (const void*)(XB + (size_t)_r * D) : (const void*)(xf32 + (size_t)_r * D), xbf, lane); else ld_row_raw((dstv).x, csrc + (size_t)(_r - MX) * D, false, lane); } while (0)
#define BI_OF(rr) (((rr) < MX) ? ((rr) >> 13) : 8)
    float PA1[16], PA2[16], PS2[16]; int cur_bi = -1;
    Row6 raw[2];
    if (R0 + 2 * wave < R1) { LD_ROW6(raw[0], R0 + 2 * wave); LD_ROW6(raw[1], R0 + 2 * wave + 1); }
#pragma nounroll
    for (int g0 = R0; g0 < R1; g0 += 16) {
        const int ra = g0 + 2 * wave; const bool act = ra < R1;
        if (act) {
            const int bi = BI_OF(ra); const bool isx = ra < MX;
            if (bi != cur_bi) { cur_bi = bi; const float* mb = mod + (size_t)bi * NMOD; float t0[16], t1[16];
                ld_vec16(t0, gpost, lane); ld_vec16(t1, mb + 2 * D, lane);
#pragma unroll
                for (int k = 0; k < 16; ++k) PA1[k] = t0[k] * t1[k];
                ld_vec16(t0, gpre, lane); ld_vec16(t1, mb + 4 * D, lane); ld_vec16(PS2, mb + 3 * D, lane);
#pragma unroll
                for (int k = 0; k < 16; ++k) PA2[k] = t0[k] * (1.0f + t1[k]); }
#pragma unroll
            for (int r = 0; r < 2; ++r) {
                const int rw = ra + r;
                float mv[16], xv[16];
#pragma unroll
                for (int j = 0; j < 2; ++j) { mv[8 * j] = bflo(raw[r].m[j].x); mv[8 * j + 1] = bfhi(raw[r].m[j].x); mv[8 * j + 2] = bflo(raw[r].m[j].y); mv[8 * j + 3] = bfhi(raw[r].m[j].y);
                    mv[8 * j + 4] = bflo(raw[r].m[j].z); mv[8 * j + 5] = bfhi(raw[r].m[j].z); mv[8 * j + 6] = bflo(raw[r].m[j].w); mv[8 * j + 7] = bfhi(raw[r].m[j].w); }
                float ss = 0.f;
#pragma unroll
                for (int k = 0; k < 16; ++k) ss += mv[k] * mv[k];
                const float rstd = rsqrtf(wave_sum(ss) * (1.0f / D) + RMS_EPS);
                float ss2 = 0.f;
                row_to_f32(raw[r].x, isx && xbf, xv);
#pragma unroll
                for (int k = 0; k < 16; ++k) { const float v = xv[k] + mv[k] * rstd * PA1[k]; xv[k] = v; ss2 += v * v; }
                if (isx) st_row_bf16(XB + (size_t)rw * D, xv, lane); else st_row_f32(cdst + (size_t)(rw - MX) * D, xv, lane);
                const float rstd2 = rsqrtf(wave_sum(ss2) * (1.0f / D) + RMS_EPS);
#pragma unroll
                for (int k = 0; k < 16; ++k) xv[k] = xv[k] * rstd2 * PA2[k] + PS2[k];
#pragma unroll
                for (int j = 0; j < 2; ++j) { u32x2 w; w.x = pk4_fp8(xv[8 * j], xv[8 * j + 1], xv[8 * j + 2], xv[8 * j + 3]); w.y = pk4_fp8(xv[8 * j + 4], xv[8 * j + 5], xv[8 * j + 6], xv[8 * j + 7]);
                    *(u32x2*)(hx8 + (size_t)rw * D + 8 * lane + 512 * j) = w; }
                LAS unsigned char* hrow = lds + P6_HT + (2 * wave + r) * P6_HSTR + lane * 16;
#pragma unroll
                for (int j = 0; j < 2; ++j) { u32x4 h, lw; float lo[8];
                    h.x = pk2(xv[8 * j], xv[8 * j + 1]); h.y = pk2(xv[8 * j + 2], xv[8 * j + 3]); h.z = pk2(xv[8 * j + 4], xv[8 * j + 5]); h.w = pk2(xv[8 * j + 6], xv[8 * j + 7]);
                    lo[0] = xv[8 * j] - bflo(h.x); lo[1] = xv[8 * j + 1] - bfhi(h.x); lo[2] = xv[8 * j + 2] - bflo(h.y); lo[3] = xv[8 * j + 3] - bfhi(h.y);
                    lo[4] = xv[8 * j + 4] - bflo(h.z); lo[5] = xv[8 * j + 5] - bfhi(h.z); lo[6] = xv[8 * j + 6] - bflo(h.w); lo[7] = xv[8 * j + 7] - bfhi(h.w);
                    lw.x = pk2(lo[0], lo[1]); lw.y = pk2(lo[2], lo[3]); lw.z = pk2(lo[4], lo[5]); lw.w = pk2(lo[6], lo[7]);
                    *(LAS u32x4*)(hrow + j * 1024) = h; *(LAS u32x4*)(hrow + 16 * P6_HSTR + j * 1024) = lw; }
            }
            if (ra + 16 < R1) { LD_ROW6(raw[0], ra + 16); LD_ROW6(raw[1], ra + 17); }
        }
        __syncthreads();
        {
            f32x4 acc = (f32x4){0.f, 0.f, 0.f, 0.f};
            const int r16 = lane & 15, q = lane >> 4;
#pragma unroll
            for (int k4 = 0; k4 < 4; ++k4) { const int kk = 4 * wave + k4;
                const bf16x8 ah = *(const LAS bf16x8*)(lds + P6_HT + r16 * P6_HSTR + kk * 64 + q * 16), al = *(const LAS bf16x8*)(lds + P6_HT + 16 * P6_HSTR + r16 * P6_HSTR + kk * 64 + q * 16);
                const bf16x8 bh = *(const LAS bf16x8*)(lds + P6_WB + (kk * 64 + lane) * 16), bl = *(const LAS bf16x8*)(lds + P6_WB + 32768 + (kk * 64 + lane) * 16);
                acc = __builtin_amdgcn_mfma_f32_16x16x32_bf16(ah, bh, acc, 0, 0, 0);
                acc = __builtin_amdgcn_mfma_f32_16x16x32_bf16(al, bh, acc, 0, 0, 0);
                acc = __builtin_amdgcn_mfma_f32_16x16x32_bf16(ah, bl, acc, 0, 0, 0); }
            LAS float* red = (LAS float*)(lds + P6_RED) + wave * 256;
#pragma unroll
            for (int jj = 0; jj < 4; ++jj) red[(4 * q + jj) * 16 + r16] = acc[jj];
        }
        __syncthreads();
        if (act) {
            const int rr = 2 * wave + (lane >> 5), e = lane & 15, rw = g0 + rr;
            const LAS float* red = (const LAS float*)(lds + P6_RED) + rr * 16 + e;
            float lg = 0.f;
#pragma unroll
            for (int w8 = 0; w8 < 8; ++w8) lg += red[w8 * 256];
            float mx = lg; mx = fmaxf(mx, dppx<0xB1>(mx)); mx = fmaxf(mx, dppx<0x4E>(mx)); mx = fmaxf(mx, xor4f(mx)); mx = fmaxf(mx, xor8f(mx));
            const float ex = __expf(lg - mx); float se = ex; se += dppx<0xB1>(se); se += dppx<0x4E>(se); se += xor4f(se); se += xor8f(se);
            if ((lane & 16) == 0) {
                const float av = ex * __builtin_amdgcn_rcpf(se);
                if (rw < MX) aff[((size_t)((rw >> 13) * 16 + e)) * T + (rw & (T - 1))] = av;
                else { const int rc = rw - MX, b = rc >> 8, p = rc & 255; affc[((size_t)(e * 8 + b)) * LC + p] = av; }
            }
        }
    }
#undef LD_ROW6
#undef BI_OF
}

__device__ __forceinline__ int block_sum_i(int v, LAS int* red, int wave, int lane) {
#pragma unroll
    for (int o = 1; o < 64; o <<= 1) v += __shfl_xor(v, o);
    __syncthreads();
    if (lane == 0) red[wave] = v;
    __syncthreads();
    int s = 0;
#pragma unroll
    for (int w = 0; w < 8; ++w) s += red[w];
    return s;
}
__device__ __forceinline__ void p7_topk(Frame& F, bool with_ctx) {
    LAS int* red = (LAS int*)F.lds;
    LAS int* wtot = (LAS int*)(F.lds + 64);
    const float* aff = (const float*)(F.ws + WS_AFF); const float* affc = (const float*)(F.ws + WS_AFFC);
    int* seli = (int*)(F.ws + WS_SELI); float* selg = (float*)(F.ws + WS_SELG); int* inv = (int*)(F.ws + WS_INV);
    const int nprob = with_ctx ? 256 : 128;
    for (int q = F.vcu; q < nprob; q += F.G) {
        const float* src; int n, cap, pbase, rbase, e;
        if (q < 128) { src = aff + (size_t)q * T; n = T; cap = CAPX; pbase = q * CAPX; rbase = (q >> 4) * T; e = q & 15; }
        else { const int qq = q - 128; src = affc + (size_t)qq * LC; n = LC; cap = CAPC; pbase = PX + qq * CAPC; rbase = MX + (qq & 7) * LC; e = qq >> 3; }
        const int t0 = F.tid * 16;
        unsigned key[16]; const bool valid = t0 < n;
#pragma unroll
        for (int i = 0; i < 16; ++i) key[i] = 0u;
        if (valid) {
#pragma unroll
            for (int i4 = 0; i4 < 4; ++i4) { const f32x4 v = *(const f32x4*)(src + t0 + 4 * i4);
#pragma unroll
                for (int j = 0; j < 4; ++j) key[i4 * 4 + j] = __float_as_uint(v[j]); }
        }
        unsigned cur = 0u;
        for (int bit = 31; bit >= 0; --bit) {
            const unsigned cand = cur | (1u << bit); int c = 0;
#pragma unroll
            for (int i = 0; i < 16; ++i) c += (key[i] >= cand) ? 1 : 0;
            const int tot = block_sum_i(c, red, F.wave, F.lane);
            if (tot >= cap) cur = cand;
        }
        int cg = 0, ce = 0;
#pragma unroll
        for (int i = 0; i < 16; ++i) { cg += (key[i] > cur) ? 1 : 0; ce += (valid && key[i] == cur) ? 1 : 0; }
        const int ngt = block_sum_i(cg, red, F.wave, F.lane);
        const int need = cap - ngt;
        int x = cg | (ce << 16);
        int incl = x;
#pragma unroll
        for (int o = 1; o < 64; o <<= 1) { const int y = __shfl_up(incl, o); if (F.lane >= o) incl += y; }
        __syncthreads();
        if (F.lane == 63) wtot[F.wave] = incl;
        __syncthreads();
        int wpre = 0;
#pragma unroll
        for (int w = 0; w < 8; ++w) wpre += (w < F.wave) ? wtot[w] : 0;
        const int excl = wpre + incl - x;
        int pg = excl & 0xffff, pe = excl >> 16;
        if (valid) {
#pragma unroll
            for (int i = 0; i < 16; ++i) {
                const bool gt = key[i] > cur, eq = key[i] == cur;
                const bool sel = gt || (eq && pe < need);
                const int slot = pg + min(pe, need);
                const int trow = rbase + t0 + i;
                if (sel) { seli[pbase + slot] = trow; selg[pbase + slot] = __uint_as_float(key[i]); inv[(size_t)trow * 16 + e] = pbase + slot; }
                else inv[(size_t)trow * 16 + e] = -1;
                pg += gt ? 1 : 0; pe += eq ? 1 : 0;
            }
        }
        __syncthreads();
    }
}

__device__ __forceinline__ void p8a_gather(Frame& F, bool with_ctx) {
    const int gw = F.vcu * 8 + F.wave, NGW = F.G * 8, lane = F.lane;
    const int* seli = (const int*)(F.ws + WS_SELI);
    const bf16_t* hx2 = (const bf16_t*)(F.ws + WS_HX); bf16_t* Xg = (bf16_t*)(F.ws + WS_R2);
    const int np = with_ctx ? PT : PX;
    for (int pr = gw; pr < np; pr += NGW) {
        const int tr = seli[pr];
        const u32x4* s = (const u32x4*)(hx2 + (size_t)tr * D); u32x4* d = (u32x4*)(Xg + (size_t)pr * D);
        const u32x4 a = s[lane], b = s[lane + 64]; d[lane] = a; d[lane + 64] = b;
    }
}

__device__ __forceinline__ void p10_combine(Frame& F, const Args& A, int l, float* xout, float* cio, bool with_ctx) {
    bf16_t* XB = (bf16_t*)(F.ws + WS_XB);
#define LD_ROW10(dstv, rr) do { const int _r = (rr); if (_r < MX) ld_row_raw(dstv, XB + (size_t)_r * D, true, lane); else ld_row_raw(dstv, cio + (size_t)(_r - MX) * D, false, lane); } while (0)
    const int gw = F.vcu * 8 + F.wave, NGW = F.G * 8, lane = F.lane;
    const int* inv = (const int*)(F.ws + WS_INV); const unsigned char* Yd = (const unsigned char*)(F.ws + WS_R2); const float* selg = (const float*)(F.ws + WS_SELG);
    const float* gpost = A.in[I_GFPOST] + l * D; const float* mod = (const float*)(F.ws + WS_MOD) + (size_t)l * 9 * NMOD;
    const float* gpre1 = A.in[I_GMPRE] + D;
    bf16_t* hx = (bf16_t*)(F.ws + WS_HX);
    const int nrows = with_ctx ? MT : MX;
    const int rpw = (nrows + NGW - 1) / NGW, r0 = gw * rpw, r1 = min(r0 + rpw, nrows);
    if (r0 >= r1) return;
    float PA3[16], PA4[16], PS4[16]; int cur_bi = -1;
    RowRaw cur, nxt; int cinv, ninv = -1;
    LD_ROW10(cur, r0);
    cinv = (lane < 16) ? inv[(size_t)r0 * 16 + lane] : -1;
    for (int row = r0; row < r1; ++row) {
        if (row + 1 < r1) { const int rn = row + 1; LD_ROW10(nxt, rn); ninv = (lane < 16) ? inv[(size_t)rn * 16 + lane] : -1; }
        const bool isx = row < MX;
        const int bi = isx ? (row >> 13) : 8;
        if (bi != cur_bi) { cur_bi = bi; const float* mb = mod + (size_t)bi * NMOD; float t0[16], t1[16];
            ld_vec16(t0, gpost, lane); ld_vec16(t1, mb + 5 * D, lane);
#pragma unroll
            for (int k = 0; k < 16; ++k) PA3[k] = t0[k] * t1[k];
            if (l == 0) { const float* mb1 = mb + (size_t)9 * NMOD; ld_vec16(t0, gpre1, lane); ld_vec16(t1, mb1 + D, lane); ld_vec16(PS4, mb1, lane);
#pragma unroll
                for (int k = 0; k < 16; ++k) PA4[k] = t0[k] * (1.0f + t1[k]); } }
        float acc[16];
#pragma unroll
        for (int k = 0; k < 16; ++k) acc[k] = 0.f;
        unsigned long long bm = __ballot(cinv >= 0);
        while (bm) {
            int pr[4]; float wgt[4];
#pragma unroll
            for (int k = 0; k < 4; ++k) { if (bm) { const int e = __builtin_ctzll(bm); bm &= bm - 1; pr[k] = __builtin_amdgcn_readlane(cinv, e); wgt[k] = selg[pr[k]] * (1.0f / pg8::YD_SCALE); } else { pr[k] = 0; wgt[k] = 0.f; } }
            u32x2 y[4][2];
#pragma unroll
            for (int k = 0; k < 4; ++k)
#pragma unroll
                for (int j = 0; j < 2; ++j) y[k][j] = *(const u32x2*)(Yd + (size_t)pr[k] * D + 8 * lane + 512 * j);
#pragma unroll
            for (int k = 0; k < 4; ++k)
#pragma unroll
                for (int j = 0; j < 2; ++j) { const f32x2 v0 = __builtin_amdgcn_cvt_pk_f32_fp8((int)y[k][j].x, false), v1 = __builtin_amdgcn_cvt_pk_f32_fp8((int)y[k][j].x, true),
                                                          v2 = __builtin_amdgcn_cvt_pk_f32_fp8((int)y[k][j].y, false), v3 = __builtin_amdgcn_cvt_pk_f32_fp8((int)y[k][j].y, true);
                    acc[8 * j] += wgt[k] * v0.x; acc[8 * j + 1] += wgt[k] * v0.y; acc[8 * j + 2] += wgt[k] * v1.x; acc[8 * j + 3] += wgt[k] * v1.y;
                    acc[8 * j + 4] += wgt[k] * v2.x; acc[8 * j + 5] += wgt[k] * v2.y; acc[8 * j + 6] += wgt[k] * v3.x; acc[8 * j + 7] += wgt[k] * v3.y; }
        }
        float ss = 0.f;
#pragma unroll
        for (int k = 0; k < 16; ++k) ss += acc[k] * acc[k];
        const float rstd = rsqrtf(wave_sum(ss) * (1.0f / D) + RMS_EPS);
        float s3 = 0.f, x1[16];
        row_to_f32(cur, isx, x1);
#pragma unroll
        for (int k = 0; k < 16; ++k) { const float v = x1[k] + acc[k] * rstd * PA3[k]; acc[k] = v; s3 += v * v; }
        if (!isx) st_row_f32(cio + (size_t)(row - MX) * D, acc, lane);
        else if (l == 0) st_row_bf16(XB + (size_t)row * D, acc, lane);
        else st_row_f32(xout + (size_t)row * D, acc, lane);
        if (l == 0) {
            const float rstd3 = rsqrtf(wave_sum(s3) * (1.0f / D) + RMS_EPS);
#pragma unroll
            for (int k = 0; k < 16; ++k) acc[k] = acc[k] * rstd3 * PA4[k] + PS4[k];
            st_row_bf16(hx + (size_t)row * D, acc, lane);
        }
        cur = nxt; cinv = ninv;
    }
#undef LD_ROW10
}

constexpr int NPL = 11, NPHASE = 1 + 2 * NPL;
#ifndef LB2
#define LB2 2
#endif
__global__ void __launch_bounds__(512, LB2) fwd(Args args) {
    extern __shared__ __attribute__((aligned(16))) unsigned char lds_raw[];
    Frame F;
    F.lds = (LAS unsigned char*)lds_raw;
    F.tid = threadIdx.x; F.lane = F.tid & 63; F.wave = __builtin_amdgcn_readfirstlane(F.tid >> 6);
    F.G = gridDim.x; { const int bx = blockIdx.x; F.vcu = (F.G % 8 == 0) ? (bx % 8) * (F.G / 8) + bx / 8 : bx; }
    F.out = args.out; F.ws = args.ws;
    volatile LAS unsigned* MISC = (volatile LAS unsigned*)(F.lds + MISC_OFF);
    for (int u = F.tid; u < 64; u += 512) ((LAS unsigned*)(F.lds + MISC_OFF))[u] = 0u;
    __syncthreads();
    const int lo = args.ph_lo, hi = args.ph_hi;
    const bool multi = (hi - lo) > 1;
    XcdBarrier bar; bar.bar = (unsigned*)(F.ws + WS_CTL) + 4096; bar.x = 0; bar.st = MISC + 8;
    if (multi) bar = xcd_barrier_post((unsigned*)(F.ws + WS_CTL) + 4096, MISC + 8);
#ifndef PH_MASK
#define PH_MASK 0xFFFFFFFFu
#endif
#define IN(k) (lo <= (k) && (k) < hi)
#define EN(j) ((PH_MASK >> (j)) & 1u)
#ifndef DUP_MASK
#define DUP_MASK 0u
#endif
#define REPS(j) ((((unsigned)DUP_MASK >> (j)) & 1u) ? 2 : 1)
#define FRESH() do { F.tid = launder((int)threadIdx.x); F.lane = F.tid & 63; } while (0)
#define SEAM(k) do { if (multi && IN((k) + 1)) xcd_barrier(bar); } while (0)

    if (EN(0) && IN(0)) { FRESH();
#pragma nounroll
        for (int rep = 0; rep < REPS(0); ++rep) p0_prologue(F, args);
        SEAM(0);
#ifdef XBAR
        if (multi) for (int q = 0; q < XBAR; ++q) xcd_barrier(bar);
#endif
        }

    bf16_t* HX = (bf16_t*)(F.ws + WS_HX);
    float* CTXS = (float*)(F.ws + WS_CTXS);
#pragma nounroll
    for (int l = 0; l < 2; ++l) {
        const int pb = 1 + l * NPL;
        const bool wctx = (l == 0);
        const float* xsrc = args.in[I_X];
        const float* csrc = (l == 0) ? args.in[I_CTX] : CTXS;
        if (EN(1) && IN(pb + 0)) { FRESH();
#pragma nounroll
            for (int rep = 0; rep < REPS(1); ++rep) if (l == 0) p1_norm(F, args, l, xsrc, csrc);
            if (l == 0) SEAM(pb + 0); }
        if (EN(2) && IN(pb + 1)) { FRESH();
            pg8::AddrPlain g{HX, (const bf16_t*)(F.ws + WS_WIN) + (size_t)l * D * D, D};
            pg8::LinOrder S{(MT / 256) * 4, 4, F.G, F.vcu};
            pg8::EpiWin E{(bf16_t*)(F.ws + WS_R1 + R1_US5), (bf16_t*)(F.ws + WS_R1 + R1_VP)};

#pragma nounroll
            for (int rep = 0; rep < REPS(2); ++rep) pg8::gemm_phase(F.lds + STAGE_OFF, g, S, E);
            SEAM(pb + 1);
        }
        if (EN(3) && IN(pb + 2)) { FRESH();
#pragma nounroll
            for (int rep = 0; rep < REPS(3); ++rep) { s5_mfma(F, l, wctx); pool_v(F); }
            SEAM(pb + 2); }
        if (EN(4) && IN(pb + 3)) { FRESH();
#pragma nounroll
            for (int rep = 0; rep < REPS(4); ++rep) pool_h(F, wctx);
            SEAM(pb + 3); }
        if (EN(5) && IN(pb + 4)) { FRESH();
            const int mrows = wctx ? MT : MX;
            { pg8::AddrMid g{(const bf16_t*)(F.ws + WS_R1 + R1_YG), (const bf16_t*)(F.ws + WS_R1 + R1_Z), (const bf16_t*)(F.ws + WS_WGLU) + (size_t)l * DS5 * DS5, (const bf16_t*)(F.ws + WS_WPOOL) + (size_t)l * 512 * 512, 512};
              pg8::MidOrder S{(mrows / 256) * 4, F.G, F.vcu};
              pg8::EpiMid E{(const bf16_t*)(F.ws + WS_R1 + R1_YG), args.in[I_POOLS] + l * 512, HX};
#pragma nounroll
              for (int rep = 0; rep < REPS(5); ++rep) pg8::gemm_phase(F.lds + STAGE_OFF, g, S, E); }
            SEAM(pb + 4);
        }
        if (EN(6) && IN(pb + 5)) { FRESH();
            const int mrows = wctx ? MT : MX;
            pg8::AddrPlain g{HX, (const bf16_t*)(F.ws + WS_WOUT) + (size_t)l * D * D, D};
            pg8::LinOrder S{(mrows / 256) * 4, 4, F.G, F.vcu};
            pg8::EpiPlain E{(bf16_t*)(F.ws + WS_R1), D};

#pragma nounroll
            for (int rep = 0; rep < REPS(6); ++rep) pg8::gemm_phase(F.lds + STAGE_OFF, g, S, E);
            SEAM(pb + 5);
        }
        if (EN(7) && IN(pb + 6)) { FRESH();
#pragma nounroll
            for (int rep = 0; rep < ((l == 0) ? REPS(7) : 1); ++rep) p6_rows(F, args, l, xsrc, csrc, CTXS, wctx);
            SEAM(pb + 6); }
        if (EN(8) && IN(pb + 7)) { FRESH();
#pragma nounroll
            for (int rep = 0; rep < REPS(8); ++rep) p7_topk(F, wctx);
            SEAM(pb + 7); }
        if (EN(9) && IN(pb + 8)) { FRESH();
            const int ptiles = (wctx ? PT : PX) / 256;
            pg8::AddrMoEGather g{(const unsigned char*)(F.ws + WS_HX), (const int*)(F.ws + WS_SELI), (const unsigned char*)(F.ws + WS_WGU) + (size_t)l * 16 * 2048 * D, (size_t)2048 * D, D / 2};
            pg8::LinOrder S{ptiles * 8, 8, F.G, F.vcu};
            pg8::EpiSwiglu E{(unsigned char*)(F.ws + WS_R1)};

#pragma nounroll
            for (int rep = 0; rep < REPS(9); ++rep) pg8::gemm_phase(F.lds + STAGE_OFF, g, S, E);
            SEAM(pb + 8);
        }
        if (EN(10) && IN(pb + 9)) { FRESH();
            const int ptiles = (wctx ? PT : PX) / 256;
            pg8::AddrMoEGatherH g{(const unsigned char*)(F.ws + WS_R1), (const int*)(F.ws + WS_IDENT), (const unsigned char*)(F.ws + WS_WD) + (size_t)l * 16 * D * D, (size_t)D * D, D / 2};
            pg8::LinOrder S{ptiles * 4, 4, F.G, F.vcu};
            pg8::EpiYd8 E{(unsigned char*)(F.ws + WS_R2)};

#pragma nounroll
            for (int rep = 0; rep < REPS(10); ++rep) pg8::gemm_phase(F.lds + STAGE_OFF, g, S, E);
            SEAM(pb + 9);
        }
        if (EN(11) && IN(pb + 10)) { FRESH();
#pragma nounroll
            for (int rep = 0; rep < ((l == 1) ? REPS(11) : 1); ++rep) p10_combine(F, args, l, F.out, CTXS, wctx);
            SEAM(pb + 10); }
    }
#undef IN
#undef SEAM
}

#ifndef MK_ONE_LAUNCH
#define MK_ONE_LAUNCH 1
#endif
extern "C" void kernel_launch(void* const* d_in, const int* in_sizes, int n_in, void* d_out, int out_size, void* d_ws, size_t ws_size, hipStream_t stream) {
    static int grid = 0;
    if (grid == 0) {
        if (n_in != 27 || out_size != MX * D || ws_size < WS_END) { fprintf(stderr, "kernel_launch: unexpected shapes (n_in %d out %d ws %zu)\n", n_in, out_size, ws_size); grid = -1; return; }
        int dev = 0, cus = 0, per_cu = 0;
        if (hipGetDevice(&dev) != hipSuccess || hipDeviceGetAttribute(&cus, hipDeviceAttributeMultiprocessorCount, dev) != hipSuccess) { grid = -1; return; }
        if (hipFuncSetAttribute((const void*)fwd, hipFuncAttributeMaxDynamicSharedMemorySize, LDS_BYTES) != hipSuccess) { fprintf(stderr, "kernel_launch: hipFuncSetAttribute failed\n"); grid = -1; return; }
        if (hipOccupancyMaxActiveBlocksPerMultiprocessor(&per_cu, (const void*)fwd, 512, LDS_BYTES) != hipSuccess || per_cu < 1) fprintf(stderr, "kernel_launch: occupancy query says %d\n", per_cu);
        (void)hipGetLastError();
        grid = cus;
    }
    if (grid < 0) return;
    (void)hipMemsetAsync((char*)d_ws + WS_CTL, 0, CTL_ZERO_BYTES, stream);
    Args a{};
    for (int i = 0; i < 27; ++i) a.in[i] = (const float*)d_in[i];
    a.out = (float*)d_out; a.ws = (unsigned char*)d_ws;
#if MK_ONE_LAUNCH
    a.ph_lo = 0; a.ph_hi = NPHASE;
    hipLaunchKernelGGL(fwd, dim3(grid), dim3(512), LDS_BYTES, stream, a);
#else
    for (int p = 0; p < NPHASE; ++p) { a.ph_lo = p; a.ph_hi = p + 1; hipLaunchKernelGGL(fwd, dim3(grid), dim3(512), LDS_BYTES, stream, a); }
#endif
}
```

```cpp
#include <hip/hip_runtime.h>
#include <cstdio>
#include <cstdint>

#define GAS __attribute__((address_space(1)))
#define LAS __attribute__((address_space(3)))
typedef unsigned short bf16_t;
typedef short bf16x8 __attribute__((ext_vector_type(8)));
typedef float f32x4 __attribute__((ext_vector_type(4)));
typedef float f32x2 __attribute__((ext_vector_type(2)));
typedef unsigned u32x4 __attribute__((ext_vector_type(4)));
typedef unsigned u32x2 __attribute__((ext_vector_type(2)));
typedef int i32x4 __attribute__((ext_vector_type(4)));
typedef int i32x8 __attribute__((ext_vector_type(8)));

constexpr int D = 1024, NB = 8, T = 8192, LC = 256;
constexpr int MX = NB * T, MC = NB * LC, MT = MX + MC;
constexpr int NE = 16, CAPX = 1024, CAPC = 32;
constexpr int PX = NB * NE * CAPX, PC = NE * NB * CAPC, PT = PX + PC;
constexpr int NSEQ = LC + T;
constexpr int DS5 = 512, NG = 32, SH = 16, SP = 64;
constexpr float RMS_EPS = 1e-6f;
constexpr int NMOD = 6 * D;

constexpr size_t MiB = 1u << 20;
constexpr size_t WS_CTL = 0, CTL_ZERO_BYTES = 1 * MiB;
constexpr size_t WS_MOD = 1 * MiB;
constexpr size_t WS_AFF = 2 * MiB;
constexpr size_t WS_AFFC = 6 * MiB;
constexpr size_t WS_SELI = 7 * MiB;
constexpr size_t WS_SELG = 8 * MiB;
constexpr size_t WS_INV = 9 * MiB;
constexpr size_t WS_WRT = 14 * MiB;
constexpr size_t WS_IDENT = 15 * MiB;
constexpr size_t WS_CTXS = 16 * MiB;
constexpr size_t WS_WIN = 24 * MiB;
constexpr size_t WS_WOUT = 28 * MiB;
constexpr size_t WS_WGLU = 32 * MiB;
constexpr size_t WS_WPOOL = 33 * MiB;
constexpr size_t WS_WGU = 34 * MiB;
constexpr size_t WS_WD = 98 * MiB;
constexpr size_t WS_XB = 130 * MiB;
constexpr size_t WS_HX = 262 * MiB;
constexpr size_t WS_R1 = 394 * MiB;
constexpr size_t WS_R2 = 658 * MiB;
constexpr size_t WS_S5W = 922 * MiB;
constexpr size_t S5W_STRIDE = 288 * 1024;
constexpr int S5_OFF_WSF = 0, S5_OFF_WSR = 65536, S5_OFF_WOF = 131072, S5_OFF_WOR = 196608, S5_OFF_TT = 262144, S5_OFF_A16 = 262144 + 16384;
constexpr size_t WS_END = 940 * MiB;
constexpr size_t R1_US5 = 0, R1_VP = 66 * MiB, R1_YG = 132 * MiB, R1_Z = 198 * MiB;

constexpr int LDS_BYTES = 147456;
constexpr int STAGE_OFF = 0, LDSCTL_OFF = 131072, MISC_OFF = LDS_BYTES - 256;

__device__ __forceinline__ unsigned f2bf(float f) { unsigned u = __float_as_uint(f); return (u + 0x7fffu + ((u >> 16) & 1u)) >> 16; }
__device__ __forceinline__ unsigned pk2(float lo, float hi) { unsigned r; asm("v_cvt_pk_bf16_f32 %0, %1, %2" : "=v"(r) : "v"(lo), "v"(hi)); return r; }
__device__ __forceinline__ float bflo(unsigned w) { return __uint_as_float(w << 16); }
__device__ __forceinline__ float bfhi(unsigned w) { return __uint_as_float(w & 0xffff0000u); }
template <int CTRL> __device__ __forceinline__ float dppx(float v) { return __int_as_float(__builtin_amdgcn_update_dpp(0, __float_as_int(v), CTRL, 0xF, 0xF, false)); }
__device__ __forceinline__ float wave_sum(float v) {
    v += dppx<0xB1>(v); v += dppx<0x4E>(v); v += dppx<0x141>(v); v += dppx<0x140>(v);
    const int vi = __float_as_int(v);
    return (__int_as_float(__builtin_amdgcn_readlane(vi, 0)) + __int_as_float(__builtin_amdgcn_readlane(vi, 16))) + (__int_as_float(__builtin_amdgcn_readlane(vi, 32)) + __int_as_float(__builtin_amdgcn_readlane(vi, 48)));
}
__device__ __forceinline__ unsigned pk4_fp8(float a, float b, float c, float d) {
    a = __builtin_amdgcn_fmed3f(a, -448.f, 448.f); b = __builtin_amdgcn_fmed3f(b, -448.f, 448.f); c = __builtin_amdgcn_fmed3f(c, -448.f, 448.f); d = __builtin_amdgcn_fmed3f(d, -448.f, 448.f);
    int w = 0; w = __builtin_amdgcn_cvt_pk_fp8_f32(a, b, w, false); w = __builtin_amdgcn_cvt_pk_fp8_f32(c, d, w, true); return (unsigned)w; }
constexpr float W8_SCALE = 256.f, H8_SCALE = 4.f;
constexpr int SC_ONE = 0x7f7f7f7f, SC_W8 = 0x77777777, SC_H8 = 0x7d7d7d7d;
__device__ __forceinline__ float sigmoidf_(float x) { return __builtin_amdgcn_rcpf(1.0f + __builtin_amdgcn_exp2f(-1.4426950408889634f * x)); }
__device__ __forceinline__ float gelu_tanh(float x) { const float u2 = 1.5957691216057308f * (x + 0.044715f * x * x * x); return x * __builtin_amdgcn_rcpf(1.0f + __builtin_amdgcn_exp2f(-1.4426950408889634f * u2)); }

__device__ __forceinline__ int launder(int v) { asm volatile("" : "+v"(v)); return v; }
__device__ __forceinline__ int launder_s(int v) { asm volatile("" : "+s"(v)); return v; }

#define XB_TMO      128
#define XB_XCNT(j)  (256  + 64 * (j))
#define XB_XSUB(j)  (1280 + 64 * (j))
#define XB_XGEN(j)  (2304 + 64 * (j))
#define XB_TOP      3328
#define XB_TOPGEN   3392
#define XCD_BAR_WORDS 3456
#define XB_SPIN_CAP (1u << 18)

__device__ __forceinline__ unsigned xb_ld(unsigned* p)              { return __hip_atomic_load(p, __ATOMIC_RELAXED, __HIP_MEMORY_SCOPE_AGENT); }
__device__ __forceinline__ unsigned xb_add(unsigned* p, unsigned v) { return __hip_atomic_fetch_add(p, v, __ATOMIC_RELAXED, __HIP_MEMORY_SCOPE_AGENT); }
__device__ __forceinline__ unsigned xb_xcc_id() { return (unsigned)__builtin_amdgcn_s_getreg((3 << 11) | 20) & 0xFu; }
#define XB_SPIN(cond, bar) do { unsigned _sp = 0; while (cond) { __builtin_amdgcn_s_sleep(1); \
    if ((++_sp & 255u) == 0u) { if (xb_ld(&(bar)[XB_TMO])) break; if (_sp > XB_SPIN_CAP) { atomicAdd(&(bar)[XB_TMO], 1u); break; } } } } while (0)

struct XcdBarrier { unsigned* bar; unsigned x; volatile LAS unsigned* st; };

__device__ __forceinline__ XcdBarrier xcd_barrier_post(unsigned* bar, volatile LAS unsigned* st) {
    XcdBarrier b; b.bar = bar; b.x = xb_xcc_id(); b.st = st;
    if (threadIdx.x == 0) (void)xb_add(&bar[XB_XCNT(b.x)], 1u);
    return b;
}
__device__ __forceinline__ void xcd_barrier_complete(unsigned* bar, unsigned x, unsigned& nloc, unsigned& nx) {
    const unsigned G = gridDim.x * gridDim.y * gridDim.z;
    unsigned sum, cnt, mine, sp = 0u;
    for (;;) {
        sum = 0u; cnt = 0u; mine = 0u;
#pragma unroll
        for (unsigned j = 0; j < 16; ++j) { const unsigned c = xb_ld(&bar[XB_XCNT(j)]); sum += c; cnt += (c > 0u) ? 1u : 0u; mine = (j == x) ? c : mine; }
        if (sum == G) break;
        __builtin_amdgcn_s_sleep(1);
        if ((++sp & 255u) == 0u) { if (xb_ld(&bar[XB_TMO])) break; if (sp > XB_SPIN_CAP) { atomicAdd(&bar[XB_TMO], 1u); break; } }
    }
    nloc = mine > 0u ? mine : 1u; nx = cnt > 0u ? cnt : 1u;
}
__device__ __forceinline__ void xcd_barrier(const XcdBarrier& b) {
    asm volatile("s_waitcnt vmcnt(0)" ::: "memory");
    __syncthreads();
    if (threadIdx.x == 0) {
        unsigned* bar = b.bar;
        __builtin_amdgcn_s_waitcnt(0);
        unsigned nloc = b.st[0], nx = b.st[1];
        if (nloc == 0u) { xcd_barrier_complete(bar, b.x, nloc, nx); b.st[0] = nloc; b.st[1] = nx; }
        const unsigned old = xb_add(&bar[XB_XSUB(b.x)], 1u);
        const unsigned gen = old / nloc;
        if (old + 1u == (gen + 1u) * nloc) {
            __builtin_amdgcn_fence(__ATOMIC_RELEASE, "agent");
            asm volatile("s_waitcnt vmcnt(0)" ::: "memory");
            const unsigned og = xb_add(&bar[XB_TOP], 1u);
            const unsigned tg = og / nx;
            if (og + 1u == (tg + 1u) * nx) xb_add(&bar[XB_TOPGEN], 1u);
            else XB_SPIN(xb_ld(&bar[XB_TOPGEN]) == tg, bar);
            __builtin_amdgcn_fence(__ATOMIC_ACQUIRE, "agent");
            xb_add(&bar[XB_XGEN(b.x)], 1u);
            asm volatile("s_waitcnt vmcnt(0)" ::: "memory");
        } else {
            XB_SPIN(xb_ld(&bar[XB_XGEN(b.x)]) == gen, bar);
            __builtin_amdgcn_fence(__ATOMIC_ACQUIRE, "agent");
            asm volatile("s_waitcnt vmcnt(0)" ::: "memory");
        }
    }
    __syncthreads();
}

namespace pg8 {
constexpr int BM = 256, BK = 64, HALF = 128, HTB = HALF * BK * 2, STAGE_BYTES = 8 * HTB;
__device__ __forceinline__ int lds_byte(int r, int c) { const int st = (r >> 4) * 2 + (c >> 5), rr = r & 15, cc = c & 31, ob = rr * 64 + cc * 2; return st * 1024 + (ob ^ (((ob >> 9) & 1) << 5)); }
__device__ __forceinline__ void stage_rc(int b, int& R, int& C) { const int st = b / 1024, sb = b % 1024, swz = sb ^ (((sb >> 9) & 1) << 5); R = (st >> 1) * 16 + swz / 64; C = (st & 1) * 32 + (swz % 64) / 2; }
__device__ __forceinline__ int perm32(int rho) { const int n = rho >> 4, i = rho & 15; return 8 * (i >> 2) + 4 * n + (i & 3); }
struct Unit { int pm, pn; };
__device__ __forceinline__ unsigned cvt_pk_bf16(float lo, float hi) { unsigned r; asm volatile("v_cvt_pk_bf16_f32 %0, %1, %2" : "=v"(r) : "v"(lo), "v"(hi)); return r; }

struct LinOrder {
    int nunits, nN, G, c;
    __device__ __forceinline__ bool next(int i, Unit& u) const { const long L = (long)i * G + c; if (L >= nunits) return false; u.pn = (int)(L % nN); u.pm = (int)(L / nN); return true; }
    __device__ __forceinline__ void a_ready(const Unit&) const {}
    __device__ __forceinline__ void done(const Unit&) const {}
};
struct AddrPlain {
    static constexpr bool GATHER = false, FP8 = false; static constexpr int SCW = 0, SCW1 = 0, SCX = 0;
    const bf16_t* A; const bf16_t* Bt; int K;
    __device__ __forceinline__ int nt(const Unit&) const { return K / BK; }
    __device__ __forceinline__ const int* idx(const Unit&) const { return nullptr; }
    __device__ __forceinline__ const char* Aof(const Unit& u) const { return (const char*)A + (size_t)u.pm * BM * K * 2; }
    __device__ __forceinline__ const char* Bof(const Unit& u) const { return (const char*)Bt + (size_t)u.pn * BM * K * 2; }
};
struct AddrMoE {
    static constexpr bool GATHER = false, FP8 = true; static constexpr int SCW = SC_W8, SCW1 = SC_W8, SCX = SC_H8;
    const unsigned char* A; const unsigned char* W; size_t wstride; int K;
    __device__ __forceinline__ int nt(const Unit&) const { return K / BK; }
    __device__ __forceinline__ const int* idx(const Unit&) const { return nullptr; }
    __device__ __forceinline__ static int expert(int pm) { return pm < (PX / BM) ? ((pm >> 2) & 15) : (pm - PX / BM); }
    __device__ __forceinline__ const char* Aof(const Unit& u) const { return (const char*)A + (size_t)u.pm * BM * K * 2; }
    __device__ __forceinline__ const char* Bof(const Unit& u) const { return (const char*)(W + (size_t)expert(u.pm) * wstride) + (size_t)u.pn * BM * K * 2; }
};
struct AddrMoEGather {
    static constexpr bool GATHER = true, FP8 = true; static constexpr int SCW = SC_W8, SCW1 = 0x79797979  , SCX = SC_ONE;
    const unsigned char* A; const int* sel; const unsigned char* W; size_t wstride; int K;
    __device__ __forceinline__ int nt(const Unit&) const { return K / BK; }
    __device__ __forceinline__ const int* idx(const Unit& u) const { return sel + (size_t)u.pm * BM; }
    __device__ __forceinline__ const char* Aof(const Unit&) const { return (const char*)A; }
    __device__ __forceinline__ const char* Bof(const Unit& u) const { return (const char*)(W + (size_t)AddrMoE::expert(u.pm) * wstride) + (size_t)u.pn * BM * K * 2; }
};

struct AddrMoEGatherH {
    static constexpr bool GATHER = true, FP8 = true; static constexpr int SCW = SC_W8, SCW1 = SC_W8, SCX = 0x81818181  ;
    const unsigned char* A; const int* sel; const unsigned char* W; size_t wstride; int K;
    __device__ __forceinline__ int nt(const Unit&) const { return K / BK; }
    __device__ __forceinline__ const int* idx(const Unit& u) const { return sel + (size_t)u.pm * BM; }
    __device__ __forceinline__ const char* Aof(const Unit&) const { return (const char*)A; }
    __device__ __forceinline__ const char* Bof(const Unit& u) const { return (const char*)(W + (size_t)AddrMoE::expert(u.pm) * wstride) + (size_t)u.pn * BM * K * 2; }
};

struct MidOrder {
    int nunits, G, c;
    __device__ __forceinline__ bool next(int i, Unit& u) const { const long L = (long)i * G + c; if (L >= nunits) return false; u.pn = (int)((L + i) & 3); u.pm = (int)(L >> 2); return true; }
    __device__ __forceinline__ void a_ready(const Unit&) const {}
    __device__ __forceinline__ void done(const Unit&) const {}
};
struct AddrMid {
    static constexpr bool GATHER = false, FP8 = false; static constexpr int SCW = 0, SCW1 = 0, SCX = 0;
    const bf16_t* Yg; const bf16_t* Z; const bf16_t* Wg; const bf16_t* Wp; int K;
    __device__ __forceinline__ int nt(const Unit& u) const { return u.pn < 2 ? 8 : 4; }
    __device__ __forceinline__ const int* idx(const Unit&) const { return nullptr; }
    __device__ __forceinline__ const char* Aof(const Unit& u) const { return u.pn < 2 ? (const char*)(Yg + (size_t)u.pm * BM * 512) : (const char*)(Z + (size_t)u.pm * BM * 512 + 256 * (u.pn - 2)); }
    __device__ __forceinline__ const char* Bof(const Unit& u) const { return u.pn < 2 ? (const char*)(Wg + (size_t)u.pn * BM * 512) : (const char*)(Wp + (size_t)(u.pn - 2) * BM * 512 + 256 * (u.pn - 2)); }
};

template <class Epi, class Sched, class Addr>
__device__ __forceinline__ void gemm_phase(LAS unsigned char* lds, const Addr g, const Sched& S, const Epi& E) {
    const int tid = launder((int)threadIdx.x), wid = __builtin_amdgcn_readfirstlane(tid >> 6), lane = tid & 63, wr = wid >> 2, wc = wid & 3, fr = lane & 15, fq = lane >> 4;
    const int K = g.K;
    unsigned vA[2][2], voffB[2];
    const size_t kstep = (size_t)(BK * 2);
    const size_t hstep = (size_t)HALF * K * 2;
    LAS int* idxl = (LAS int*)(lds + 131072 + 1024);
#pragma unroll
    for (int i = 0; i < 2; ++i) { int R, C; stage_rc(tid * 16 + i * 8192, R, C); const int Rb = ((R & ~31) + perm32(R & 31));
        vA[0][i] = (unsigned)(R * K + C) * 2u; vA[1][i] = vA[0][i] + (unsigned)hstep; voffB[i] = (unsigned)(Rb * K + C) * 2u; }
    const unsigned ldsw = (unsigned)wid * 1024u;
    const int aoff = lds_byte(wr * 64 + fr, fq * 8), boff = lds_byte(wc * 32 + fr, fq * 8);
#define PG8_SA(b, h) (((b) * 2 + (h)) * HTB)
#define PG8_SB(b, h) ((4 + (b) * 2 + (h)) * HTB)
#define PG8_STAGE(bufoff, gbase, voff) do { _Pragma("unroll") for (int _i = 0; _i < 2; ++_i) \
        __builtin_amdgcn_global_load_lds((const unsigned*)((const char*)(gbase) + (voff)[_i]), (LAS unsigned*)(lds + (bufoff) + ldsw + _i * 8192), 16, 0, 0); } while (0)
#define PG8_LDA(dst, b, h) do { _Pragma("unroll") for (int m = 0; m < 4; ++m) _Pragma("unroll") for (int k = 0; k < 2; ++k) dst[m][k] = *(const LAS bf16x8*)(lds + PG8_SA(b, h) + aoff + m * 2048 + k * 1024); } while (0)
#define PG8_LDB(dst, b, h) do { _Pragma("unroll") for (int n = 0; n < 2; ++n) _Pragma("unroll") for (int k = 0; k < 2; ++k) dst[n][k] = *(const LAS bf16x8*)(lds + PG8_SB(b, h) + boff + n * 2048 + k * 1024); } while (0)
#define PG8_MMA(ai, bj, At, Bt) do { __builtin_amdgcn_s_setprio(1); _Pragma("unroll") for (int m = 0; m < 4; ++m) _Pragma("unroll") for (int n = 0; n < 2; ++n) { \
        if constexpr (Addr::FP8) { const i32x4 b0 = __builtin_bit_cast(i32x4, Bt[n][0]), b1 = __builtin_bit_cast(i32x4, Bt[n][1]), a0 = __builtin_bit_cast(i32x4, At[m][0]), a1 = __builtin_bit_cast(i32x4, At[m][1]); \
            acc[ai][bj][m][n] = __builtin_amdgcn_mfma_scale_f32_16x16x128_f8f6f4(__builtin_shufflevector(b0, b1, 0, 1, 2, 3, 4, 5, 6, 7), __builtin_shufflevector(a0, a1, 0, 1, 2, 3, 4, 5, 6, 7), acc[ai][bj][m][n], 0, 0, 0, (bj) ? Addr::SCW1 : Addr::SCW, 0, Addr::SCX); } \
        else { _Pragma("unroll") for (int k = 0; k < 2; ++k) acc[ai][bj][m][n] = __builtin_amdgcn_mfma_f32_16x16x32_bf16(Bt[n][k], At[m][k], acc[ai][bj][m][n], 0, 0, 0); } } \
        __builtin_amdgcn_s_setprio(0); } while (0)
#define PG8_WAIT_V(n) asm volatile("s_waitcnt vmcnt(" #n ")" ::: "memory")
#define PG8_WAIT_L(n) asm volatile("s_waitcnt lgkmcnt(" #n ")" ::: "memory")
#define PG8_BAR __builtin_amdgcn_s_barrier()
#define PG8_SCHED __builtin_amdgcn_sched_barrier(0)
    Unit cur, nxt; int ui = 0;
    if (!S.next(0, cur)) return;
    f32x4 acc[2][2][4][2];
#pragma unroll
    for (int a = 0; a < 2; ++a)
#pragma unroll
        for (int b = 0; b < 2; ++b)
#pragma unroll
            for (int m = 0; m < 4; ++m)
#pragma unroll
                for (int n = 0; n < 2; ++n) acc[a][b][m][n] = (f32x4){0.f, 0.f, 0.f, 0.f};
    bf16x8 At[4][2], B0[2][2], B1[2][2];
    const char* cA = g.Aof(cur); const char* cB = g.Bof(cur);
    int nt = g.nt(cur);
    S.a_ready(cur);
    if constexpr (Addr::GATHER) { const int* ip = g.idx(cur);
#pragma unroll
        for (int i = 0; i < 2; ++i) { int R, C; stage_rc(tid * 16 + i * 8192, R, C);
#pragma unroll
            for (int h = 0; h < 2; ++h) vA[h][i] = (unsigned)ip[h * HALF + R] * (unsigned)(K * 2) + (unsigned)(C * 2); }
        Unit n1; if (S.next(1, n1) && wid == 0) __builtin_amdgcn_global_load_lds((const unsigned*)(g.idx(n1) + lane * 4), (LAS unsigned*)idxl, 16, 0, 0); }
    PG8_STAGE(PG8_SB(0, 0), cB, voffB); PG8_STAGE(PG8_SA(0, 0), cA, vA[0]); PG8_STAGE(PG8_SB(0, 1), cB + hstep, voffB); PG8_STAGE(PG8_SA(0, 1), cA, vA[1]);
    if (wr == 1) PG8_BAR;
    PG8_WAIT_V(4); PG8_BAR;
    PG8_STAGE(PG8_SB(1, 0), cB + kstep, voffB); PG8_STAGE(PG8_SA(1, 0), cA + kstep, vA[0]); PG8_STAGE(PG8_SB(1, 1), cB + hstep + kstep, voffB);
    PG8_WAIT_V(6); PG8_BAR;
    for (;;) {
        const bool has_next = S.next(ui + 1, nxt);
        const char* nA = has_next ? g.Aof(nxt) : cA; const char* nB = has_next ? g.Bof(nxt) : cB;
        for (int t = 0; t < nt; t += 2) {
            const bool last = (t == nt - 2);
            const char* a1 = cA + (size_t)(t + 1) * kstep;
            const char* a2 = last ? nA : cA + (size_t)(t + 2) * kstep; const char* b2 = last ? nB : cB + (size_t)(t + 2) * kstep;
            const char* a3 = a2 + kstep; const char* b3 = b2 + kstep;
            if (last && has_next) S.a_ready(nxt);
            PG8_LDB(B0, 0, 0); PG8_SCHED; PG8_LDA(At, 0, 0); PG8_STAGE(PG8_SA(1, 1), a1, vA[1]);
            if constexpr (Addr::GATHER) {
                if (last && has_next) {
#pragma unroll
                    for (int i = 0; i < 2; ++i) { int R, C; stage_rc(tid * 16 + i * 8192, R, C);
#pragma unroll
                        for (int h = 0; h < 2; ++h) vA[h][i] = (unsigned)idxl[h * HALF + R] * (unsigned)(K * 2) + (unsigned)(C * 2); } }
            }
            PG8_WAIT_L(8); PG8_BAR; PG8_WAIT_L(0); PG8_MMA(0, 0, At, B0); PG8_BAR; PG8_SCHED;
            PG8_LDB(B1, 0, 1); PG8_STAGE(PG8_SB(0, 0), b2, voffB);
            PG8_BAR; PG8_WAIT_L(0); PG8_MMA(0, 1, At, B1); PG8_BAR;
            PG8_LDA(At, 0, 1); PG8_STAGE(PG8_SA(0, 0), a2, vA[0]);
            PG8_BAR; PG8_WAIT_L(0); PG8_MMA(1, 0, At, B0); PG8_BAR; PG8_SCHED;
            PG8_STAGE(PG8_SB(0, 1), b2 + hstep, voffB);
            PG8_WAIT_V(6); PG8_BAR; PG8_MMA(1, 1, At, B1); PG8_BAR;
            PG8_LDB(B0, 1, 0); PG8_SCHED; PG8_LDA(At, 1, 0); PG8_STAGE(PG8_SA(0, 1), a2, vA[1]);
            PG8_WAIT_L(8); PG8_BAR; PG8_WAIT_L(0); PG8_MMA(0, 0, At, B0); PG8_BAR; PG8_SCHED;
            PG8_LDB(B1, 1, 1); PG8_STAGE(PG8_SB(1, 0), b3, voffB);
            PG8_BAR; PG8_WAIT_L(0); PG8_MMA(0, 1, At, B1); PG8_BAR;
            PG8_LDA(At, 1, 1); PG8_STAGE(PG8_SA(1, 0), a3, vA[0]);
            PG8_BAR; PG8_WAIT_L(0); PG8_MMA(1, 0, At, B0); PG8_BAR; PG8_SCHED;
            PG8_STAGE(PG8_SB(1, 1), b3 + hstep, voffB);
            PG8_WAIT_V(6); PG8_BAR; PG8_MMA(1, 1, At, B1); PG8_BAR;
        }
        E(acc, cur, wr, wc, fr, fq); S.done(cur);
        if (!has_next) break;
        if constexpr (Addr::GATHER) { Unit n2; if (S.next(ui + 2, n2) && wid == 0) __builtin_amdgcn_global_load_lds((const unsigned*)(g.idx(n2) + lane * 4), (LAS unsigned*)idxl, 16, 0, 0); }
#pragma unroll
        for (int a = 0; a < 2; ++a)
#pragma unroll
            for (int b = 0; b < 2; ++b)
#pragma unroll
                for (int m = 0; m < 4; ++m)
#pragma unroll
                    for (int n = 0; n < 2; ++n) acc[a][b][m][n] = (f32x4){0.f, 0.f, 0.f, 0.f};
        cur = nxt; cA = nA; cB = nB; ++ui; nt = g.nt(cur);
    }
    PG8_WAIT_V(0);
    if (wr == 0) PG8_BAR;
    PG8_BAR;
#undef PG8_SA
#undef PG8_SB
#undef PG8_STAGE
#undef PG8_LDA
#undef PG8_LDB
#undef PG8_MMA
#undef PG8_WAIT_V
#undef PG8_WAIT_L
#undef PG8_BAR
#undef PG8_SCHED
}

typedef f32x4 Acc[2][2][4][2];
__device__ __forceinline__ u32x4 pack8(const f32x4& v0, const f32x4& v1) { u32x4 w; w.x = cvt_pk_bf16(v0[0], v0[1]); w.y = cvt_pk_bf16(v0[2], v0[3]); w.z = cvt_pk_bf16(v1[0], v1[1]); w.w = cvt_pk_bf16(v1[2], v1[3]); return w; }

struct EpiPlain {
    bf16_t* O; int ldc;
    __device__ __forceinline__ void operator()(const Acc& acc, const Unit& u, int wr, int wc, int fr, int fq) const {
        const int row0 = u.pm * BM + wr * 64 + fr, col0 = u.pn * BM + wc * 32 + 8 * fq;
#pragma unroll
        for (int ai = 0; ai < 2; ++ai)
#pragma unroll
            for (int m = 0; m < 4; ++m) { bf16_t* rowp = O + (size_t)(row0 + ai * HALF + m * 16) * ldc + col0;
#pragma unroll
                for (int bj = 0; bj < 2; ++bj) *(u32x4*)(rowp + bj * HALF) = pack8(acc[ai][bj][m][0], acc[ai][bj][m][1]); }
    }
};
constexpr float YD_SCALE = 16.f;
struct EpiYd8 {
    unsigned char* O;
    __device__ __forceinline__ void operator()(const Acc& acc, const Unit& u, int wr, int wc, int fr, int fq) const {
        const int row0 = u.pm * BM + wr * 64 + fr, col0 = u.pn * BM + wc * 32 + 8 * fq;
#pragma unroll
        for (int ai = 0; ai < 2; ++ai)
#pragma unroll
            for (int m = 0; m < 4; ++m) { unsigned char* rowp = O + (size_t)(row0 + ai * HALF + m * 16) * 1024 + col0;
#pragma unroll
                for (int bj = 0; bj < 2; ++bj) { const f32x4 a = acc[ai][bj][m][0], b = acc[ai][bj][m][1];
                    u32x2 w; w.x = pk4_fp8(a[0], a[1], a[2], a[3]); w.y = pk4_fp8(b[0], b[1], b[2], b[3]);
                    *(u32x2*)(rowp + bj * HALF) = w; } }
    }
};
struct EpiWin {
    bf16_t* Us5; bf16_t* Vp;
    __device__ __forceinline__ void operator()(const Acc& acc, const Unit& u, int wr, int wc, int fr, int fq) const {
        const int rl = wr * 64 + fr, col0 = u.pn * BM + wc * 32 + 8 * fq;
        if (u.pn < 2) {
            const int b = u.pm < MX / BM ? (u.pm >> 5) : (u.pm - MX / BM), n0 = u.pm < MX / BM ? LC + (u.pm & 31) * BM : 0;
            bf16_t* base = Us5 + ((size_t)b * NG * NSEQ + n0 + rl) * 16;
#pragma unroll
            for (int bj = 0; bj < 2; ++bj) { const int c = col0 + bj * HALF; bf16_t* pb = base + (size_t)(c >> 4) * NSEQ * 16 + (c & 8);
#pragma unroll
                for (int ai = 0; ai < 2; ++ai)
#pragma unroll
                    for (int m = 0; m < 4; ++m) *(u32x4*)(pb + (ai * HALF + m * 16) * 16) = pack8(acc[ai][bj][m][0], acc[ai][bj][m][1]); }
        } else {
            bf16_t* base = Vp + (size_t)(u.pm * BM + rl) * 512 + (col0 - 512);
#pragma unroll
            for (int ai = 0; ai < 2; ++ai)
#pragma unroll
                for (int m = 0; m < 4; ++m)
#pragma unroll
                    for (int bj = 0; bj < 2; ++bj) *(u32x4*)(base + (size_t)(ai * HALF + m * 16) * 512 + bj * HALF) = pack8(acc[ai][bj][m][0], acc[ai][bj][m][1]);
        }
    }
};
struct EpiGlu {
    const bf16_t* Yg; bf16_t* O;
    __device__ __forceinline__ void operator()(const Acc& acc, const Unit& u, int wr, int wc, int fr, int fq) const {
        const int row0 = u.pm * BM + wr * 64 + fr, col0 = u.pn * BM + wc * 32 + 8 * fq;
#pragma unroll
        for (int ai = 0; ai < 2; ++ai)
#pragma unroll
            for (int m = 0; m < 4; ++m) { const int r = row0 + ai * HALF + m * 16;
#pragma unroll
                for (int bj = 0; bj < 2; ++bj) { const int c = col0 + bj * HALF; const u32x4 y = *(const u32x4*)(Yg + (size_t)r * 512 + c);
                    f32x4 v0 = acc[ai][bj][m][0], v1 = acc[ai][bj][m][1];
                    v0[0] = bflo(y.x) * sigmoidf_(v0[0]); v0[1] = bfhi(y.x) * sigmoidf_(v0[1]); v0[2] = bflo(y.y) * sigmoidf_(v0[2]); v0[3] = bfhi(y.y) * sigmoidf_(v0[3]);
                    v1[0] = bflo(y.z) * sigmoidf_(v1[0]); v1[1] = bfhi(y.z) * sigmoidf_(v1[1]); v1[2] = bflo(y.w) * sigmoidf_(v1[2]); v1[3] = bfhi(y.w) * sigmoidf_(v1[3]);
                    *(u32x4*)(O + (size_t)r * 1024 + c) = pack8(v0, v1); } }
    }
};
struct EpiPoolS {
    const float* scale; bf16_t* O;
    __device__ __forceinline__ void operator()(const Acc& acc, const Unit& u, int wr, int wc, int fr, int fq) const {
        const int row0 = u.pm * BM + wr * 64 + fr, col0 = u.pn * BM + wc * 32 + 8 * fq;
        f32x4 s[2][2];
#pragma unroll
        for (int bj = 0; bj < 2; ++bj) { s[bj][0] = *(const f32x4*)(scale + col0 + bj * HALF); s[bj][1] = *(const f32x4*)(scale + col0 + bj * HALF + 4); }
#pragma unroll
        for (int ai = 0; ai < 2; ++ai)
#pragma unroll
            for (int m = 0; m < 4; ++m) { const int r = row0 + ai * HALF + m * 16;
#pragma unroll
                for (int bj = 0; bj < 2; ++bj) { const int c = col0 + bj * HALF;
                    *(u32x4*)(O + (size_t)r * 1024 + 512 + c) = pack8(acc[ai][bj][m][0] * s[bj][0], acc[ai][bj][m][1] * s[bj][1]); } }
    }
};
struct EpiMid {
    const bf16_t* Yg; const float* scale; bf16_t* O;
    __device__ __forceinline__ void operator()(const Acc& acc, const Unit& u, int wr, int wc, int fr, int fq) const {
        if (u.pn < 2) { EpiGlu E{Yg, O}; E(acc, u, wr, wc, fr, fq); }
        else { EpiPoolS E{scale, O}; Unit v = u; v.pn = u.pn - 2; E(acc, v, wr, wc, fr, fq); }
    }
};
struct EpiSwiglu {
    unsigned char* H;
    __device__ __forceinline__ void operator()(const Acc& acc, const Unit& u, int wr, int wc, int fr, int fq) const {
        const int row0 = u.pm * BM + wr * 64 + fr, col0 = u.pn * HALF + wc * 32 + 8 * fq;
#pragma unroll
        for (int ai = 0; ai < 2; ++ai)
#pragma unroll
            for (int m = 0; m < 4; ++m) { const int r = row0 + ai * HALF + m * 16; f32x4 o[2];
#pragma unroll
                for (int n = 0; n < 2; ++n)
#pragma unroll
                    for (int j = 0; j < 4; ++j) { const float a = acc[ai][0][m][n][j], gq = acc[ai][1][m][n][j]; o[n][j] = a * sigmoidf_(a) * gq; }
                u32x2 w; w.x = pk4_fp8(o[0][0], o[0][1], o[0][2], o[0][3]); w.y = pk4_fp8(o[1][0], o[1][1], o[1][2], o[1][3]);
                *(u32x2*)(H + (size_t)r * 1024 + col0) = w; }
    }
};
struct EpiDown {
    const float* gate; bf16_t* O;
    __device__ __forceinline__ void operator()(const Acc& acc, const Unit& u, int wr, int wc, int fr, int fq) const {
        const int row0 = u.pm * BM + wr * 64 + fr, col0 = u.pn * BM + wc * 32 + 8 * fq;
#pragma unroll
        for (int ai = 0; ai < 2; ++ai)
#pragma unroll
            for (int m = 0; m < 4; ++m) { const int r = row0 + ai * HALF + m * 16; const float gt = gate[r];
#pragma unroll
                for (int bj = 0; bj < 2; ++bj) *(u32x4*)(O + (size_t)r * 1024 + col0 + bj * HALF) = pack8(acc[ai][bj][m][0] * gt, acc[ai][bj][m][1] * gt);
                asm volatile("" ::: "memory"); }
    }
};
}

struct Frame {
    LAS unsigned char* lds;
    int tid, lane, wave, vcu, G;
    float* out; unsigned char* ws;
};
struct Args { const float* in[27]; float* out; unsigned char* ws; int ph_lo, ph_hi; };

enum { I_X = 0, I_C, I_CTX, I_CCTX, I_WMOD, I_BMOD, I_GMPRE, I_GMPOST, I_GFPRE, I_GFPOST, I_WIN, I_LRE, I_LIM, I_LDT, I_BRE, I_BIM, I_CRE, I_CIM, I_S5D, I_WGLU, I_POOLW, I_POOLS, I_WOUT, I_WROUTER, I_WGATE, I_WUP, I_WDOWN };

__device__ __forceinline__ void tr_item(const float* W, int ldw, bf16_t* WT, int ldt, int k0, int n0, int drow0, int dk0, LAS float* scr, int lane) {
#pragma unroll 8
    for (int i = 0; i < 32; ++i) { const int kk = 2 * i + (lane >> 5); scr[kk * 33 + (lane & 31)] = W[(size_t)(k0 + kk) * ldw + n0 + (lane & 31)]; }
    asm volatile("s_waitcnt lgkmcnt(0)" ::: "memory");
    const int c = lane & 7;
#pragma unroll
    for (int j = 0; j < 4; ++j) { const int n = (lane >> 3) + 8 * j; const LAS float* s = scr + (8 * c) * 33 + n;
        u32x4 o; o.x = pk2(s[0 * 33], s[1 * 33]); o.y = pk2(s[2 * 33], s[3 * 33]); o.z = pk2(s[4 * 33], s[5 * 33]); o.w = pk2(s[6 * 33], s[7 * 33]);
        *(u32x4*)(WT + (size_t)(drow0 + n) * ldt + dk0 + k0 + 8 * c) = o; }
    asm volatile("s_waitcnt lgkmcnt(0)" ::: "memory");
}

__device__ __forceinline__ void tr_item8(const float* W, int ldw, unsigned char* WT, int ldt, int k0, int n0, int drow0, LAS float* scr, int lane) {
#pragma unroll 8
    for (int i = 0; i < 32; ++i) { const int kk = 2 * i + (lane >> 5); scr[kk * 33 + (lane & 31)] = W[(size_t)(k0 + kk) * ldw + n0 + (lane & 31)]; }
    asm volatile("s_waitcnt lgkmcnt(0)" ::: "memory");
    const int c = lane & 3;
#pragma unroll
    for (int j = 0; j < 2; ++j) { const int n = (lane >> 2) + 16 * j; const LAS float* sp = scr + (16 * c) * 33 + n;
        u32x4 o; o.x = pk4_fp8(sp[0 * 33] * W8_SCALE, sp[1 * 33] * W8_SCALE, sp[2 * 33] * W8_SCALE, sp[3 * 33] * W8_SCALE);
        o.y = pk4_fp8(sp[4 * 33] * W8_SCALE, sp[5 * 33] * W8_SCALE, sp[6 * 33] * W8_SCALE, sp[7 * 33] * W8_SCALE);
        o.z = pk4_fp8(sp[8 * 33] * W8_SCALE, sp[9 * 33] * W8_SCALE, sp[10 * 33] * W8_SCALE, sp[11 * 33] * W8_SCALE);
        o.w = pk4_fp8(sp[12 * 33] * W8_SCALE, sp[13 * 33] * W8_SCALE, sp[14 * 33] * W8_SCALE, sp[15 * 33] * W8_SCALE);
        *(u32x4*)(WT + (size_t)(drow0 + n) * ldt + k0 + 16 * c) = o; }
    asm volatile("s_waitcnt lgkmcnt(0)" ::: "memory");
}

__device__ __forceinline__ void s5_prep(Frame& F, const Args& A, int lg) {
    const int l = lg >> 5, g = lg & 31, tid = F.tid;
    LAS f32x2* apow = (LAS f32x2*)(F.lds + 40960);
    LAS f32x2* Bb = apow + 2 * 17 * 65;
    LAS f32x2* Cc = Bb + 2 * 64 * 16;
    for (int i = tid; i < 2 * 17 * 64; i += 512) { const int d = i / (17 * 64), k = (i / 64) % 17, p = i % 64; const size_t pg = (size_t)(l * 2 + d) * NG + g;
        const float lre = A.in[I_LRE][pg * SP + p], lim = A.in[I_LIM][pg * SP + p], dt = __expf(A.in[I_LDT][pg]);
        const float mag = __expf((float)k * lre * dt); float sn, cs; sincosf((float)k * lim * dt, &sn, &cs);
        apow[(d * 17 + k) * 65 + p] = (f32x2){mag * cs, mag * sn}; }
    for (int i = tid; i < 2 * 64 * 16; i += 512) { const int d = i >> 10, p = (i >> 4) & 63, h = i & 15; const size_t pg = (size_t)(l * 2 + d) * NG + g;
        const float lre = A.in[I_LRE][pg * SP + p], lim = A.in[I_LIM][pg * SP + p], dt = __expf(A.in[I_LDT][pg]);
        const float mag = __expf(lre * dt); float sn, cs; sincosf(lim * dt, &sn, &cs);
        const float nre = mag * cs - 1.0f, nim = mag * sn, den = lre * lre + lim * lim;
        const float cr = (nre * lre + nim * lim) / den, ci = (nim * lre - nre * lim) / den;
        const float br = A.in[I_BRE][(pg * SP + p) * SH + h], bi = A.in[I_BIM][(pg * SP + p) * SH + h];
        Bb[i] = (f32x2){cr * br - ci * bi, cr * bi + ci * br};
        Cc[(d * 16 + h) * 65 + p] = (f32x2){A.in[I_CRE][(pg * SH + h) * SP + p], A.in[I_CIM][(pg * SH + h) * SP + p]}; }
    __syncthreads();
    unsigned char* W = F.ws + WS_S5W + (size_t)lg * S5W_STRIDE;
    for (int i = tid; i < 8192; i += 512) {
        const int r = i >> 12, x = i & 4095, nt = x >> 9, kk = (x >> 6) & 7, ln = x & 63, c = ln & 15, q = ln >> 4;
        const int n = 16 * nt + c, p = n >> 1, ri = n & 1, j = 2 * kk + (q >> 1), h0 = 8 * (q & 1), pw = r ? j : 15 - j;
        const f32x2 ap = apow[(r * 17 + pw) * 65 + p]; float v[8];
#pragma unroll
        for (int jj = 0; jj < 8; ++jj) { const f32x2 bb = Bb[(r * 64 + p) * 16 + h0 + jj]; v[jj] = ri ? (ap.x * bb.y + ap.y * bb.x) : (ap.x * bb.x - ap.y * bb.y); }
        u32x4 o; o.x = pk2(v[0], v[1]); o.y = pk2(v[2], v[3]); o.z = pk2(v[4], v[5]); o.w = pk2(v[6], v[7]);
        *(u32x4*)(W + (r ? S5_OFF_WSR : S5_OFF_WSF) + (size_t)x * 16) = o; }
    for (int i = tid; i < 8192; i += 512) {
        const int r = i >> 12, x = i & 4095, nt = x >> 8, kk = (x >> 6) & 3, ln = x & 63, h = ln & 15, q = ln >> 4;
        const int pw = r ? 16 - nt : nt + 1; float v[8];
#pragma unroll
        for (int jj = 0; jj < 8; ++jj) { const int p = 16 * kk + 4 * q + (jj >> 1); const f32x2 ap = apow[(r * 17 + pw) * 65 + p], cc = Cc[(r * 16 + h) * 65 + p];
            v[jj] = (jj & 1) ? -(cc.x * ap.y + cc.y * ap.x) : (cc.x * ap.x - cc.y * ap.y); }
        u32x4 o; o.x = pk2(v[0], v[1]); o.y = pk2(v[2], v[3]); o.z = pk2(v[4], v[5]); o.w = pk2(v[6], v[7]);
        *(u32x4*)(W + (r ? S5_OFF_WOR : S5_OFF_WOF) + (size_t)x * 16) = o; }
    if (tid < 31 * 16) {
        const int di = tid >> 4, h = tid & 15, dl = di - 15; float acc[16];
#pragma unroll
        for (int k = 0; k < 16; ++k) acc[k] = 0.f;
#pragma unroll
        for (int d = 0; d < 2; ++d) {
            if ((d == 0 && dl >= 0) || (d == 1 && dl <= 0)) { const int tau = d ? -dl : dl;
                for (int p = 0; p < 64; ++p) { const f32x2 cc = Cc[(d * 16 + h) * 65 + p], ap = apow[(d * 17 + tau) * 65 + p];
                    const float zr = cc.x * ap.x - cc.y * ap.y, zi = cc.x * ap.y + cc.y * ap.x;
#pragma unroll
                    for (int k = 0; k < 16; ++k) { const f32x2 bb = Bb[(d * 64 + p) * 16 + k]; acc[k] += zr * bb.x - zi * bb.y; } } } }
        { const float dsk = (dl == 0) ? A.in[I_S5D][l * DS5 + g * 16 + h] : 0.f;
#pragma unroll
          for (int k = 0; k < 16; ++k) acc[k] += (k == h) ? dsk : 0.f; }
        u32x4 o0, o1; o0.x = pk2(acc[0], acc[1]); o0.y = pk2(acc[2], acc[3]); o0.z = pk2(acc[4], acc[5]); o0.w = pk2(acc[6], acc[7]);
        o1.x = pk2(acc[8], acc[9]); o1.y = pk2(acc[10], acc[11]); o1.z = pk2(acc[12], acc[13]); o1.w = pk2(acc[14], acc[15]);
        *(u32x4*)(W + S5_OFF_TT + (size_t)tid * 32) = o0; *(u32x4*)(W + S5_OFF_TT + (size_t)tid * 32 + 16) = o1;
    }
    if (tid < 128) ((f32x2*)(W + S5_OFF_A16))[tid] = apow[((tid >> 6) * 17 + 16) * 65 + (tid & 63)];
    __syncthreads();
}
__device__ __forceinline__ void p0_prologue(Frame& F, const Args& A) {
    unsigned char* ws = F.ws;
    const int gw = F.vcu * 8 + F.wave, NGW = F.G * 8;
    LAS float* sil = (LAS float*)(F.lds);
    for (int i = F.tid; i < 9 * 1024; i += 512) { const float v = (i < 8192) ? A.in[I_C][i] : A.in[I_CCTX][i - 8192]; sil[i] = v * sigmoidf_(v); }
    __syncthreads();
    LAS float* scr = (LAS float*)(F.lds + 40960 + F.wave * 8448);
    float* mod = (float*)(ws + WS_MOD);
    if (F.vcu >= 64 || F.G < 256) {
        LAS float* part = (LAS float*)(F.lds + 40960);
        for (int it = (F.G < 256 ? F.vcu : F.vcu - 64); it < 2 * 96; it += (F.G < 256 ? F.G : F.G - 64)) {
            const int l = it / 96, n0 = (it % 96) * 64, n = n0 + F.lane;
            const float* W = A.in[I_WMOD] + (size_t)l * D * NMOD + n + (size_t)(F.wave * 128) * NMOD;
            float acc[9];
#pragma unroll
            for (int r = 0; r < 9; ++r) acc[r] = 0.f;
#pragma unroll 32
            for (int k = 0; k < 128; ++k) { const float w = W[(size_t)k * NMOD];
#pragma unroll
                for (int r = 0; r < 9; ++r) acc[r] += sil[r * 1024 + F.wave * 128 + k] * w; }
#pragma unroll
            for (int r = 0; r < 9; ++r) part[(F.wave * 9 + r) * 64 + F.lane] = acc[r];
            __syncthreads();
            for (int o = F.tid; o < 9 * 64; o += 512) { float sm = 0.f;
#pragma unroll
                for (int w = 0; w < 8; ++w) sm += part[w * 576 + o];
                const int r = o >> 6, nn = n0 + (o & 63);
                mod[((size_t)l * 9 + r) * NMOD + nn] = sm + A.in[I_BMOD][l * NMOD + nn]; }
            __syncthreads();
        }
    }
    for (int lg = F.vcu; lg < 64; lg += F.G) s5_prep(F, A, lg);
    constexpr int IT_SQ = 16 * 32;
    constexpr int IT_GLU = 8 * 16, IT_POOL = 4 * 2 * 4;
    constexpr int PER_L = 2 * IT_SQ + IT_GLU + IT_POOL;
    constexpr int N_SMALL = 2 * PER_L;
    constexpr int N_GU = 2 * 16 * 2 * IT_SQ, N_D = 2 * 16 * IT_SQ;
    for (int it = gw; it < N_SMALL + N_GU + N_D; it += NGW) {
        int r = it;
        if (r < N_SMALL) {
            const int l = r / PER_L; r -= l * PER_L;
            if (r < IT_SQ) { const int kb = r / 32, nb = r % 32; tr_item(A.in[I_WIN] + (size_t)l * D * D, D, (bf16_t*)(ws + WS_WIN) + (size_t)l * D * D, D, kb * 64, nb * 32, nb * 32, 0, scr, F.lane); continue; }
            r -= IT_SQ;
            if (r < IT_SQ) { const int kb = r / 32, nb = r % 32; tr_item(A.in[I_WOUT] + (size_t)l * D * D, D, (bf16_t*)(ws + WS_WOUT) + (size_t)l * D * D, D, kb * 64, nb * 32, nb * 32, 0, scr, F.lane); continue; }
            r -= IT_SQ;
            if (r < IT_GLU) { const int kb = r / 16, nb = r % 16; tr_item(A.in[I_WGLU] + (size_t)l * DS5 * DS5, DS5, (bf16_t*)(ws + WS_WGLU) + (size_t)l * DS5 * DS5, DS5, kb * 64, nb * 32, nb * 32, 0, scr, F.lane); continue; }
            r -= IT_GLU;
            { const int gi = r / 8, q = r % 8, kb = q / 4, nb = q % 4;
              tr_item(A.in[I_POOLW] + ((size_t)l * 4 + gi) * 128 * 128, 128, (bf16_t*)(ws + WS_WPOOL) + (size_t)l * 512 * 512, 512, kb * 64, nb * 32, gi * 128 + nb * 32, gi * 128, scr, F.lane); continue; }
        }
        r -= N_SMALL;
        if (r < N_GU) {
            const int le = r / (2 * IT_SQ); int q = r % (2 * IT_SQ); const int up = q / IT_SQ; q %= IT_SQ; const int kb = q / 32, nb = q % 32, n0 = nb * 32;
            const float* W = (up ? A.in[I_WUP] : A.in[I_WGATE]) + (size_t)le * D * D;
            tr_item8(W, D, (unsigned char*)(ws + WS_WGU) + (size_t)le * 2048 * D, D, kb * 64, n0, 256 * (n0 / 128) + (n0 % 128) + up * 128, scr, F.lane); continue;
        }
        r -= N_GU;
        { const int le = r / IT_SQ, q = r % IT_SQ, kb = q / 32, nb = q % 32;
          tr_item8(A.in[I_WDOWN] + (size_t)le * D * D, D, (unsigned char*)(ws + WS_WD) + (size_t)le * D * D, D, kb * 64, nb * 32, nb * 32, scr, F.lane); }
    }
    const int gt = F.vcu * 512 + F.tid, NGT = F.G * 512;
    for (int i = gt; i < 2 * 512 * 64; i += NGT) { const int row = (i / 64) % 512, c8 = i % 64; if ((row >> 7) != (c8 >> 4)) *(u32x4*)((bf16_t*)(ws + WS_WPOOL) + (size_t)i * 8) = (u32x4){0u, 0u, 0u, 0u}; }
    for (int i = gt; i < PT; i += NGT) ((int*)(ws + WS_IDENT))[i] = i;
    for (int i = gt; i < 2 * 16 * 1024; i += NGT) { const int l = i / 16384, e = (i / 1024) % 16, k = i % 1024; ((float*)(ws + WS_WRT))[i] = A.in[I_WROUTER][((size_t)l * D + k) * NE + e]; }
}

struct RowF32 { f32x4 v[4]; };
__device__ __forceinline__ void ld_row_f32(RowF32& r, const float* p, int lane) {
#pragma unroll
    for (int j = 0; j < 2; ++j) { r.v[2 * j] = *(const f32x4*)(p + 8 * lane + 512 * j); r.v[2 * j + 1] = *(const f32x4*)(p + 8 * lane + 512 * j + 4); }
}
__device__ __forceinline__ void ld_vec16(float (&o)[16], const float* p, int lane) {
#pragma unroll
    for (int j = 0; j < 2; ++j) { const f32x4 a = *(const f32x4*)(p + 8 * lane + 512 * j), b = *(const f32x4*)(p + 8 * lane + 512 * j + 4);
#pragma unroll
        for (int q = 0; q < 4; ++q) { o[8 * j + q] = a[q]; o[8 * j + 4 + q] = b[q]; } }
}
__device__ __forceinline__ void st_row_bf16(bf16_t* p, const float (&h)[16], int lane) {
#pragma unroll
    for (int j = 0; j < 2; ++j) { u32x4 w; w.x = pk2(h[8 * j], h[8 * j + 1]); w.y = pk2(h[8 * j + 2], h[8 * j + 3]); w.z = pk2(h[8 * j + 4], h[8 * j + 5]); w.w = pk2(h[8 * j + 6], h[8 * j + 7]);
        *(u32x4*)(p + 8 * lane + 512 * j) = w; }
}
struct RowRaw { u32x4 v[4]; };
__device__ __forceinline__ void ld_row_raw(RowRaw& r, const void* p, bool bf, int lane) {
    if (bf) { const bf16_t* q = (const bf16_t*)p; r.v[0] = *(const u32x4*)(q + 8 * lane); r.v[1] = *(const u32x4*)(q + 8 * lane + 512); }
    else { const float* q = (const float*)p; r.v[0] = *(const u32x4*)(q + 8 * lane); r.v[1] = *(const u32x4*)(q + 8 * lane + 4); r.v[2] = *(const u32x4*)(q + 8 * lane + 512); r.v[3] = *(const u32x4*)(q + 8 * lane + 516); }
}
__device__ __forceinline__ void row_to_f32(const RowRaw& r, bool bf, float (&x)[16]) {
    if (bf) {
#pragma unroll
        for (int j = 0; j < 2; ++j) { x[8 * j] = bflo(r.v[j].x); x[8 * j + 1] = bfhi(r.v[j].x); x[8 * j + 2] = bflo(r.v[j].y); x[8 * j + 3] = bfhi(r.v[j].y);
            x[8 * j + 4] = bflo(r.v[j].z); x[8 * j + 5] = bfhi(r.v[j].z); x[8 * j + 6] = bflo(r.v[j].w); x[8 * j + 7] = bfhi(r.v[j].w); }
    } else {
#pragma unroll
        for (int k = 0; k < 4; ++k) { x[4 * k] = __uint_as_float(r.v[k].x); x[4 * k + 1] = __uint_as_float(r.v[k].y); x[4 * k + 2] = __uint_as_float(r.v[k].z); x[4 * k + 3] = __uint_as_float(r.v[k].w); }
    }
}
__device__ __forceinline__ void st_row_f32(float* p, const float (&x)[16], int lane) {
#pragma unroll
    for (int j = 0; j < 2; ++j) { *(f32x4*)(p + 8 * lane + 512 * j) = (f32x4){x[8 * j], x[8 * j + 1], x[8 * j + 2], x[8 * j + 3]};
                                  *(f32x4*)(p + 8 * lane + 512 * j + 4) = (f32x4){x[8 * j + 4], x[8 * j + 5], x[8 * j + 6], x[8 * j + 7]}; }
}
__device__ __forceinline__ void p1_norm(Frame& F, const Args& A, int l, const float* xsrc, const float* csrc) {
    const int gw = F.vcu * 8 + F.wave, NGW = F.G * 8, lane = F.lane;
    const float* gpre = A.in[I_GMPRE] + l * D; const float* mod = (const float*)(F.ws + WS_MOD) + (size_t)l * 9 * NMOD;
    bf16_t* hx = (bf16_t*)(F.ws + WS_HX);
    const int rpw = (MT + NGW - 1) / NGW, r0 = gw * rpw, r1 = min(r0 + rpw, MT);
    if (r0 >= r1) return;
    float PA[16], PS[16]; int cur_bi = -1;
    RowF32 cur, nxt;
    ld_row_f32(cur, r0 < MX ? xsrc + (size_t)r0 * D : csrc + (size_t)(r0 - MX) * D, lane);
    for (int row = r0; row < r1; ++row) {
        if (row + 1 < r1) { const int rn = row + 1; ld_row_f32(nxt, rn < MX ? xsrc + (size_t)rn * D : csrc + (size_t)(rn - MX) * D, lane); }
        const int bi = row < MX ? (row >> 13) : 8;
        if (bi != cur_bi) { cur_bi = bi; const float* mb = mod + (size_t)bi * NMOD; float g_[16], sc[16]; ld_vec16(g_, gpre, lane); ld_vec16(sc, mb + D, lane); ld_vec16(PS, mb, lane);
#pragma unroll
            for (int k = 0; k < 16; ++k) PA[k] = g_[k] * (1.0f + sc[k]); }
        float ss = 0.f;
#pragma unroll
        for (int k = 0; k < 4; ++k) ss += cur.v[k][0] * cur.v[k][0] + cur.v[k][1] * cur.v[k][1] + cur.v[k][2] * cur.v[k][2] + cur.v[k][3] * cur.v[k][3];
        const float rstd = rsqrtf(wave_sum(ss) * (1.0f / D) + RMS_EPS);
        float h[16];
#pragma unroll
        for (int k = 0; k < 4; ++k)
#pragma unroll
            for (int q = 0; q < 4; ++q) h[4 * k + q] = cur.v[k][q] * rstd * PA[4 * k + q] + PS[4 * k + q];
        st_row_bf16(hx + (size_t)row * D, h, lane);
        cur = nxt;
    }
}

constexpr int L_U = 0, L_X = 33792, L_SF = 67072, L_SR = 84480, L_TT = 101888;
__device__ __forceinline__ void s5_mfma(Frame& F, int l, bool wctx) {
    const int tid = F.tid, lane = F.lane, wave = F.wave, c = lane & 15, q = lane >> 4;
    LAS unsigned char* lds = F.lds;
    LAS float* Xs = (LAS float*)(lds + L_X);
    const bf16_t* Us5 = (const bf16_t*)(F.ws + WS_R1 + R1_US5);
    bf16_t* Yg = (bf16_t*)(F.ws + WS_R1 + R1_YG);
    for (int bg = F.vcu; bg < NB * NG; bg += F.G) {
        const int b = bg / NG, g = bg % NG;
        const unsigned char* W = F.ws + WS_S5W + (size_t)(l * NG + g) * S5W_STRIDE;
        const unsigned char* useq = (const unsigned char*)(Us5 + (size_t)bg * NSEQ * 16);
        unsigned char* srs = F.ws + WS_R2 + (size_t)bg * (528 * 256);
        for (int x = tid; x < 31 * 16 * 2; x += 512) { const int row = x >> 1, half = x & 1; *(LAS u32x4*)(lds + L_TT + row * 48 + half * 16) = *(const u32x4*)(W + S5_OFF_TT + row * 32 + half * 16); }
        bf16x8 Bw[8];
#pragma unroll
        for (int kk = 0; kk < 8; ++kk) Bw[kk] = *(const bf16x8*)(W + (S5_OFF_WSR + (wave * 8 + kk) * 1024) + (unsigned)lane * 16u);
        f32x2 a16 = ((const f32x2*)(W + S5_OFF_A16))[64 + lane];
        float sre = 0.f, sim = 0.f;
        u32x4 pu[4];
#pragma unroll
        for (int k = 0; k < 4; ++k) { const int x = tid + 512 * k; if (x < 16 * 32) pu[k] = *(const u32x4*)(useq + 8192 * k + (unsigned)tid * 16u); }
#pragma nounroll
        for (int mbi = 0; mbi < 9; ++mbi) {
            const int mb = (mbi == 0) ? 0 : 9 - mbi;
            const int c0 = (mb == 0) ? 0 : 16 + 64 * (mb - 1), nch = (mb == 0) ? 16 : 64, nmt = nch >> 4;
#pragma unroll
            for (int k = 0; k < 4; ++k) { const int x = tid + 512 * k; if (x < nch * 32) *(LAS u32x4*)(lds + L_U + (x >> 5) * 528 + (x & 31) * 16) = pu[k]; }
            if (mbi < 8) { const int c0n = 16 + 64 * (7 - mbi);
#pragma unroll
                for (int k = 0; k < 4; ++k) pu[k] = *(const u32x4*)(useq + (c0n * 512 + 8192 * k) + (unsigned)tid * 16u); }
            __syncthreads();
#pragma nounroll
            for (int mt = 0; mt < nmt; ++mt) {
                f32x4 acc = (f32x4){0.f, 0.f, 0.f, 0.f};
#pragma unroll
                for (int kk = 0; kk < 8; ++kk) { const bf16x8 Af = *(const LAS bf16x8*)(lds + L_U + (16 * mt + c) * 528 + kk * 64 + q * 16); acc = __builtin_amdgcn_mfma_f32_16x16x32_bf16(Af, Bw[kk], acc, 0, 0, 0);
                    if ((kk & 3) == 3) asm volatile("" ::: "memory"); }
#pragma unroll
                for (int jj = 0; jj < 4; ++jj) Xs[(16 * mt + 4 * q + jj) * 130 + 16 * wave + c] = acc[jj];
            }
            __syncthreads();
            if (wave == 0) {
                for (int cb = nch - 4; cb >= 0; cb -= 4) { f32x2 xv[4];
#pragma unroll
                    for (int k = 0; k < 4; ++k) xv[k] = *(const LAS f32x2*)(Xs + (cb + k) * 130 + 2 * lane);
#pragma unroll
                    for (int k = 3; k >= 0; --k) { *(LAS unsigned*)(lds + L_SR + (cb + k) * 272 + lane * 4) = pk2(sre, sim);
                        const float nr = a16.x * sre - a16.y * sim + xv[k].x, ni = a16.x * sim + a16.y * sre + xv[k].y; sre = nr; sim = ni; } }
            }
            __syncthreads();
            for (int x = tid; x < nch * 16; x += 512) *(u32x4*)(srs + c0 * 256 + (unsigned)x * 16u) = *(const LAS u32x4*)(lds + L_SR + (x >> 4) * 272 + (x & 15) * 16);
            __syncthreads();
        }
        __threadfence(); __syncthreads(); __builtin_amdgcn_fence(__ATOMIC_ACQUIRE, "agent");
        const int tidF = launder(tid), laneF = tidF & 63, cF = laneF & 15, qF = laneF >> 4;
#pragma unroll
        for (int kk = 0; kk < 8; ++kk) Bw[kk] = *(const bf16x8*)(W + (S5_OFF_WSF + (wave * 8 + kk) * 1024) + (unsigned)laneF * 16u);
        a16 = ((const f32x2*)(W + S5_OFF_A16))[laneF];
        sre = 0.f; sim = 0.f;
        u32x4 ps[2];
#pragma unroll
        for (int k = 0; k < 4; ++k) { const int x = tidF + 512 * k; if (x < 16 * 32) pu[k] = *(const u32x4*)(useq + 8192 * k + (unsigned)tidF * 16u); }
#pragma unroll
        for (int k = 0; k < 2; ++k) { const int x = tidF + 512 * k; if (x < 16 * 16) ps[k] = *(const u32x4*)(srs + 8192 * k + (unsigned)tidF * 16u); }
#pragma nounroll
        for (int mb = 0; mb < 9; ++mb) {
            const int c0 = (mb == 0) ? 0 : 16 + 64 * (mb - 1), nch = (mb == 0) ? 16 : 64, nmt = nch >> 4;
#pragma unroll
            for (int k = 0; k < 4; ++k) { const int x = tidF + 512 * k; if (x < nch * 32) *(LAS u32x4*)(lds + L_U + (x >> 5) * 528 + (x & 31) * 16) = pu[k]; }
#pragma unroll
            for (int k = 0; k < 2; ++k) { const int x = tidF + 512 * k; if (x < nch * 16) *(LAS u32x4*)(lds + L_SR + (x >> 4) * 272 + (x & 15) * 16) = ps[k]; }
            if (mb < 8) { const int c0n = 16 + 64 * mb;
#pragma unroll
                for (int k = 0; k < 4; ++k) pu[k] = *(const u32x4*)(useq + (c0n * 512 + 8192 * k) + (unsigned)tidF * 16u);
#pragma unroll
                for (int k = 0; k < 2; ++k) ps[k] = *(const u32x4*)(srs + (c0n * 256 + 8192 * k) + (unsigned)tidF * 16u); }
            __syncthreads();
#pragma nounroll
            for (int mt = 0; mt < nmt; ++mt) {
                f32x4 acc = (f32x4){0.f, 0.f, 0.f, 0.f};
#pragma unroll
                for (int kk = 0; kk < 8; ++kk) { const bf16x8 Af = *(const LAS bf16x8*)(lds + L_U + (16 * mt + cF) * 528 + kk * 64 + qF * 16); acc = __builtin_amdgcn_mfma_f32_16x16x32_bf16(Af, Bw[kk], acc, 0, 0, 0);
                    if ((kk & 3) == 3) asm volatile("" ::: "memory"); }
#pragma unroll
                for (int jj = 0; jj < 4; ++jj) Xs[(16 * mt + 4 * qF + jj) * 130 + 16 * wave + cF] = acc[jj];
            }
            __syncthreads();
            if (wave == 0) {
                for (int cb = 0; cb < nch; cb += 4) { f32x2 xv[4];
#pragma unroll
                    for (int k = 0; k < 4; ++k) xv[k] = *(const LAS f32x2*)(Xs + (cb + k) * 130 + 2 * laneF);
#pragma unroll
                    for (int k = 0; k < 4; ++k) { *(LAS unsigned*)(lds + L_SF + (cb + k) * 272 + laneF * 4) = pk2(sre, sim);
                        const float nr = a16.x * sre - a16.y * sim + xv[k].x, ni = a16.x * sim + a16.y * sre + xv[k].y; sre = nr; sim = ni; } }
            }
            __syncthreads();
            if (mb > 0 || wctx) {
                bf16x8 Bo[2][4], Br[2][4];
#pragma unroll
                for (int e = 0; e < 2; ++e)
#pragma unroll
                    for (int kk = 0; kk < 4; ++kk) { Bo[e][kk] = *(const bf16x8*)(W + (S5_OFF_WOF + ((2 * wave + e) * 4 + kk) * 1024) + (unsigned)laneF * 16u);
                                                     Br[e][kk] = *(const bf16x8*)(W + (S5_OFF_WOR + ((2 * wave + e) * 4 + kk) * 1024) + (unsigned)laneF * 16u); }
#pragma nounroll
                for (int mt = 0; mt < nmt; ++mt) {
                    f32x4 acc[2];
                    acc[0] = (f32x4){0.f, 0.f, 0.f, 0.f}; acc[1] = acc[0];
#pragma unroll
                    for (int kk = 0; kk < 8; ++kk) { const bf16x8 Af = *(const LAS bf16x8*)(lds + L_U + (16 * mt + cF) * 528 + kk * 64 + qF * 16);
#pragma unroll
                        for (int e = 0; e < 2; ++e) { const int dl = (2 * wave + e) - 2 * kk - (qF >> 1);
                            const bf16x8 Tf = *(const LAS bf16x8*)(lds + L_TT + ((dl + 15) * 16 + cF) * 48 + (qF & 1) * 16);
                            acc[e] = __builtin_amdgcn_mfma_f32_16x16x32_bf16(Tf, Af, acc[e], 0, 0, 0); }
                        if (kk & 1) asm volatile("" ::: "memory"); }
#pragma unroll
                    for (int kk = 0; kk < 4; ++kk) { const bf16x8 Sf = *(const LAS bf16x8*)(lds + L_SF + (16 * mt + cF) * 272 + kk * 64 + qF * 16), Sr = *(const LAS bf16x8*)(lds + L_SR + (16 * mt + cF) * 272 + kk * 64 + qF * 16);
#pragma unroll
                        for (int e = 0; e < 2; ++e) { acc[e] = __builtin_amdgcn_mfma_f32_16x16x32_bf16(Bo[e][kk], Sf, acc[e], 0, 0, 0); acc[e] = __builtin_amdgcn_mfma_f32_16x16x32_bf16(Br[e][kk], Sr, acc[e], 0, 0, 0); }
                        if (kk & 1) asm volatile("" ::: "memory"); }
#pragma unroll
                    for (int e = 0; e < 2; ++e) { const int n = (c0 + 16 * mt + cF) * 16 + 2 * wave + e;
                        const int row = (n < LC) ? (MX + b * LC + n) : (b * T + (n - LC));
                        u32x2 w; w.x = pk2(gelu_tanh(acc[e][0]), gelu_tanh(acc[e][1])); w.y = pk2(gelu_tanh(acc[e][2]), gelu_tanh(acc[e][3]));
                        *(u32x2*)(Yg + (size_t)row * 512 + g * 16 + 4 * qF) = w; }
                }
            }
            __syncthreads();
        }
    }
}
__device__ __forceinline__ void add8(float (&s)[8], const u32x4& x, float w) {
    s[0] += w * bflo(x.x); s[1] += w * bfhi(x.x); s[2] += w * bflo(x.y); s[3] += w * bfhi(x.y); s[4] += w * bflo(x.z); s[5] += w * bfhi(x.z); s[6] += w * bflo(x.w); s[7] += w * bfhi(x.w);
}
template <bool SUBV>
__device__ __forceinline__ void pool_line(const bf16_t* src, const bf16_t* vsub, bf16_t* dst, size_t stride, int n, int p0, int hw) {
    float s[8];
#pragma unroll
    for (int k = 0; k < 8; ++k) s[k] = 0.f;
    {
        u32x4 x[16];
#pragma unroll
        for (int k = 0; k < 16; ++k) { const int pos = p0 - 8 + k; x[k] = *(const u32x4*)(src + (size_t)min(max(pos, 0), n - 1) * stride); }
#pragma unroll
        for (int k = 0; k < 16; ++k) { const int pos = p0 - 8 + k; const bool in = pos >= max(p0 - hw, 0) && pos < min(p0 + hw, n); add8(s, x[k], in ? 1.0f : 0.0f); }
    }
#pragma nounroll
    for (int pb = p0; pb < p0 + 32; pb += 4) {
        u32x4 xa[4], xs[4], xv[4];
#pragma unroll
        for (int k = 0; k < 4; ++k) { const int p = pb + k; xa[k] = *(const u32x4*)(src + (size_t)min(p + hw, n - 1) * stride); xs[k] = *(const u32x4*)(src + (size_t)max(p - hw, 0) * stride);
            if (SUBV) xv[k] = *(const u32x4*)(vsub + (size_t)p * stride); }
#pragma unroll
        for (int k = 0; k < 4; ++k) { const int p = pb + k;
            const float inv = 1.0f / (float)(min(p + hw, n) - max(p - hw, 0));
            float o[8];
#pragma unroll
            for (int j = 0; j < 8; ++j) o[j] = s[j] * inv;
            if (SUBV) add8(o, xv[k], -1.0f);
            u32x4 w; w.x = pk2(o[0], o[1]); w.y = pk2(o[2], o[3]); w.z = pk2(o[4], o[5]); w.w = pk2(o[6], o[7]);
            *(u32x4*)(dst + (size_t)p * stride) = w;
            add8(s, xa[k], (p + hw < n) ? 1.0f : 0.0f); add8(s, xs[k], (p - hw >= 0) ? -1.0f : 0.0f); }
    }
}
constexpr size_t R2_HV = 64 * MiB;
__device__ __forceinline__ void pool_v(Frame& F) {
    const int gw = F.vcu * 8 + F.wave, NGW = F.G * 8, lane = F.lane, hw = 1 << (lane >> 4);
    const bf16_t* Vp = (const bf16_t*)(F.ws + WS_R1 + R1_VP);
    bf16_t* Hv = (bf16_t*)(F.ws + WS_R2 + R2_HV);
    for (int it = gw; it < NB * 64 * 4; it += NGW) {
        const int rq = it & 3, c = (it >> 2) & 63, b = it >> 8;
        const size_t base = ((size_t)(b * T + c)) * 512 + 8 * lane;
        pool_line<false>(Vp + base, nullptr, Hv + base, (size_t)64 * 512, 128, rq * 32, hw);
    }
}
__device__ __forceinline__ void pool_h(Frame& F, bool with_ctx) {
    const int gw = F.vcu * 8 + F.wave, NGW = F.G * 8, lane = F.lane, hw = 1 << (lane >> 4);
    const bf16_t* Vp = (const bf16_t*)(F.ws + WS_R1 + R1_VP);
    const bf16_t* Hv = (const bf16_t*)(F.ws + WS_R2 + R2_HV);
    bf16_t* Z = (bf16_t*)(F.ws + WS_R1 + R1_Z);
    const int nx = NB * 128 * 2, ntask = nx + (with_ctx ? NB * 8 : 0);
    for (int it = gw; it < ntask; it += NGW) {
        if (it < nx) { const int ch = it & 1, r = (it >> 1) & 127, b = it >> 8; const size_t base = ((size_t)(b * T + r * 64)) * 512 + 8 * lane;
            pool_line<true>(Hv + base, Vp + base, Z + base, 512, 64, ch * 32, hw); }
        else { const int j = it - nx, lq = j & 7, b = j >> 3; const size_t base = ((size_t)(MX + b * LC)) * 512 + 8 * lane;
            pool_line<true>(Vp + base, Vp + base, Z + base, 512, LC, lq * 32, hw); }
    }
}

__device__ __forceinline__ float xor4f(float x) { return dppx<0x1B>(dppx<0x141>(x)); }
__device__ __forceinline__ float xor8f(float x) { return dppx<0x128>(x); }
__device__ __forceinline__ void swap32(float& a, float& b) { const auto r = __builtin_amdgcn_permlane32_swap(__float_as_uint(a), __float_as_uint(b), false, false); a = __uint_as_float(r[0]); b = __uint_as_float(r[1]); }
__device__ __forceinline__ void swap16(float& a, float& b) { const auto r = __builtin_amdgcn_permlane16_swap(__float_as_uint(a), __float_as_uint(b), false, false); a = __uint_as_float(r[0]); b = __uint_as_float(r[1]); }
__device__ __forceinline__ float reduce16(float (&v)[16], int lane) {
#pragma unroll
    for (int i = 0; i < 8; ++i) { float a = v[i], b = v[i + 8]; swap32(a, b); v[i] = a + b; }
#pragma unroll
    for (int i = 0; i < 4; ++i) { float a = v[i], b = v[i + 4]; swap16(a, b); v[i] = a + b; }
#pragma unroll
    for (int i = 0; i < 2; ++i) { const float send = (lane & 8) ? v[i] : v[i + 2], keep = (lane & 8) ? v[i + 2] : v[i]; v[i] = keep + xor8f(send); }
    { const float send = (lane & 4) ? v[0] : v[1], keep = (lane & 4) ? v[1] : v[0]; v[0] = keep + xor4f(send); }
    v[0] += dppx<0x4E>(v[0]); v[0] += dppx<0xB1>(v[0]);
    return v[0];
}
__device__ __forceinline__ float max_idx16(float m) {
    m = fmaxf(m, xor4f(m)); m = fmaxf(m, xor8f(m));
    { float a = m, b = m; swap16(a, b); m = fmaxf(a, b); }
    { float a = m, b = m; swap32(a, b); m = fmaxf(a, b); }
    return m;
}
__device__ __forceinline__ float sum_idx16(float x) {
    x += xor4f(x); x += xor8f(x);
    { float a = x, b = x; swap16(a, b); x = a + b; }
    { float a = x, b = x; swap32(a, b); x = a + b; }
    return x;
}
struct Row6 { u32x4 m[2]; RowRaw x; };
constexpr int P6_WB = 0, P6_HT = 65536, P6_HSTR = 2064, P6_RED = P6_HT + 2 * 16 * P6_HSTR;
static_assert(P6_RED + 8192 <= MISC_OFF, "P6 LDS map");
__device__ __forceinline__ void p6_rows(Frame& F, const Args& A, int l, const float* xf32, const float* csrc, float* cdst, bool with_ctx) {
    bf16_t* XB = (bf16_t*)(F.ws + WS_XB); const bool xbf = (l != 0);
    const int lane = F.lane, wave = F.wave;
    LAS unsigned char* lds = F.lds;
    { const float* wrt = (const float*)(F.ws + WS_WRT) + (size_t)l * 16 * 1024;
      for (int i = F.tid; i < 32 * 64; i += 512) { const int kk = i >> 6, ln = i & 63, e = ln & 15, q = ln >> 4; const float* wp = wrt + e * 1024 + 32 * kk + 8 * q;
          const f32x4 w0 = *(const f32x4*)wp, w1 = *(const f32x4*)(wp + 4); float hi[8], lo[8];
#pragma unroll
          for (int j = 0; j < 4; ++j) { hi[j] = __uint_as_float(f2bf(w0[j]) << 16); lo[j] = w0[j] - hi[j]; hi[4 + j] = __uint_as_float(f2bf(w1[j]) << 16); lo[4 + j] = w1[j] - hi[4 + j]; }
          u32x4 h, lw; h.x = pk2(hi[0], hi[1]); h.y = pk2(hi[2], hi[3]); h.z = pk2(hi[4], hi[5]); h.w = pk2(hi[6], hi[7]);
          lw.x = pk2(lo[0], lo[1]); lw.y = pk2(lo[2], lo[3]); lw.z = pk2(lo[4], lo[5]); lw.w = pk2(lo[6], lo[7]);
          *(LAS u32x4*)(lds + P6_WB + i * 16) = h; *(LAS u32x4*)(lds + P6_WB + 32768 + i * 16) = lw; } }
    __syncthreads();
    const float* gpost = A.in[I_GMPOST] + l * D; const float* gpre = A.in[I_GFPRE] + l * D;
    const float* mod = (const float*)(F.ws + WS_MOD) + (size_t)l * 9 * NMOD;
    const bf16_t* mix = (const bf16_t*)(F.ws + WS_R1);
    unsigned char* hx8 = (unsigned char*)(F.ws + WS_HX);
    float* aff = (float*)(F.ws + WS_AFF); float* affc = (float*)(F.ws + WS_AFFC);
    const int nrows = with_ctx ? MT : MX;
    const int rpb = ((nrows + F.G - 1) / F.G + 1) & ~1;
    const int R0 = F.vcu * rpb, R1 = min(R0 + rpb, nrows);
#define LD_ROW6(dstv, rr) do { const int _r = (rr); _Pragma("unroll") for (int _j = 0; _j < 2; ++_j) (dstv).m[_j] = *(const u32x4*)(mix + (size_t)_r * D + 8 * lane + 512 * _j); \
        if (_r < MX) ld_row_raw((dstv).x, xbf ? (const void*)(XB + (size_t)_r * D) : (const void*)(xf32 + (size_t)_r * D), xbf, lane); else ld_row_raw((dstv).x, csrc + (size_t)(_r - MX) * D, false, lane); } while (0)
#define BI_OF(rr) (((rr) < MX) ? ((rr) >> 13) : 8)
    float PA1[16], PA2[16], PS2[16]; int cur_bi = -1;
    Row6 raw[2];
    if (R0 + 2 * wave < R1) { LD_ROW6(raw[0], R0 + 2 * wave); LD_ROW6(raw[1], R0 + 2 * wave + 1); }
#pragma nounroll
    for (int g0 = R0; g0 < R1; g0 += 16) {
        const int ra = g0 + 2 * wave; const bool act = ra < R1;
        if (act) {
            const int bi = BI_OF(ra); const bool isx = ra < MX;
            if (bi != cur_bi) { cur_bi = bi; const float* mb = mod + (size_t)bi * NMOD; float t0[16], t1[16];
                ld_vec16(t0, gpost, lane); ld_vec16(t1, mb + 2 * D, lane);
#pragma unroll
                for (int k = 0; k < 16; ++k) PA1[k] = t0[k] * t1[k];
                ld_vec16(t0, gpre, lane); ld_vec16(t1, mb + 4 * D, lane); ld_vec16(PS2, mb + 3 * D, lane);
#pragma unroll
                for (int k = 0; k < 16; ++k) PA2[k] = t0[k] * (1.0f + t1[k]); }
#pragma unroll
            for (int r = 0; r < 2; ++r) {
                const int rw = ra + r;
                float mv[16], xv[16];
#pragma unroll
                for (int j = 0; j < 2; ++j) { mv[8 * j] = bflo(raw[r].m[j].x); mv[8 * j + 1] = bfhi(raw[r].m[j].x); mv[8 * j + 2] = bflo(raw[r].m[j].y); mv[8 * j + 3] = bfhi(raw[r].m[j].y);
                    mv[8 * j + 4] = bflo(raw[r].m[j].z); mv[8 * j + 5] = bfhi(raw[r].m[j].z); mv[8 * j + 6] = bflo(raw[r].m[j].w); mv[8 * j + 7] = bfhi(raw[r].m[j].w); }
                float ss = 0.f;
#pragma unroll
                for (int k = 0; k < 16; ++k) ss += mv[k] * mv[k];
                const float rstd = rsqrtf(wave_sum(ss) * (1.0f / D) + RMS_EPS);
                float ss2 = 0.f;
                row_to_f32(raw[r].x, isx && xbf, xv);
#pragma unroll
                for (int k = 0; k < 16; ++k) { const float v = xv[k] + mv[k] * rstd * PA1[k]; xv[k] = v; ss2 += v * v; }
                if (isx) st_row_bf16(XB + (size_t)rw * D, xv, lane); else st_row_f32(cdst + (size_t)(rw - MX) * D, xv, lane);
                const float rstd2 = rsqrtf(wave_sum(ss2) * (1.0f / D) + RMS_EPS);
#pragma unroll
                for (int k = 0; k < 16; ++k) xv[k] = xv[k] * rstd2 * PA2[k] + PS2[k];
#pragma unroll
                for (int j = 0; j < 2; ++j) { u32x2 w; w.x = pk4_fp8(xv[8 * j], xv[8 * j + 1], xv[8 * j + 2], xv[8 * j + 3]); w.y = pk4_fp8(xv[8 * j + 4], xv[8 * j + 5], xv[8 * j + 6], xv[8 * j + 7]);
                    *(u32x2*)(hx8 + (size_t)rw * D + 8 * lane + 512 * j) = w; }
                LAS unsigned char* hrow = lds + P6_HT + (2 * wave + r) * P6_HSTR + lane * 16;
#pragma unroll
                for (int j = 0; j < 2; ++j) { u32x4 h, lw; float lo[8];
                    h.x = pk2(xv[8 * j], xv[8 * j + 1]); h.y = pk2(xv[8 * j + 2], xv[8 * j + 3]); h.z = pk2(xv[8 * j + 4], xv[8 * j + 5]); h.w = pk2(xv[8 * j + 6], xv[8 * j + 7]);
                    lo[0] = xv[8 * j] - bflo(h.x); lo[1] = xv[8 * j + 1] - bfhi(h.x); lo[2] = xv[8 * j + 2] - bflo(h.y); lo[3] = xv[8 * j + 3] - bfhi(h.y);
                    lo[4] = xv[8 * j + 4] - bflo(h.z); lo[5] = xv[8 * j + 5] - bfhi(h.z); lo[6] = xv[8 * j + 6] - bflo(h.w); lo[7] = xv[8 * j + 7] - bfhi(h.w);
                    lw.x = pk2(lo[0], lo[1]); lw.y = pk2(lo[2], lo[3]); lw.z = pk2(lo[4], lo[5]); lw.w = pk2(lo[6], lo[7]);
                    *(LAS u32x4*)(hrow + j * 1024) = h; *(LAS u32x4*)(hrow + 16 * P6_HSTR + j * 1024) = lw; }
            }
            if (ra + 16 < R1) { LD_ROW6(raw[0], ra + 16); LD_ROW6(raw[1], ra + 17); }
        }
        __syncthreads();
        {
            f32x4 acc = (f32x4){0.f, 0.f, 0.f, 0.f};
            const int r16 = lane & 15, q = lane >> 4;
#pragma unroll
            for (int k4 = 0; k4 < 4; ++k4) { const int kk = 4 * wave + k4;
                const bf16x8 ah = *(const LAS bf16x8*)(lds + P6_HT + r16 * P6_HSTR + kk * 64 + q * 16), al = *(const LAS bf16x8*)(lds + P6_HT + 16 * P6_HSTR + r16 * P6_HSTR + kk * 64 + q * 16);
                const bf16x8 bh = *(const LAS bf16x8*)(lds + P6_WB + (kk * 64 + lane) * 16), bl = *(const LAS bf16x8*)(lds + P6_WB + 32768 + (kk * 64 + lane) * 16);
                acc = __builtin_amdgcn_mfma_f32_16x16x32_bf16(ah, bh, acc, 0, 0, 0);
                acc = __builtin_amdgcn_mfma_f32_16x16x32_bf16(al, bh, acc, 0, 0, 0);
                acc = __builtin_amdgcn_mfma_f32_16x16x32_bf16(ah, bl, acc, 0, 0, 0); }
            LAS float* red = (LAS float*)(lds + P6_RED) + wave * 256;
#pragma unroll
            for (int jj = 0; jj < 4; ++jj) red[(4 * q + jj) * 16 + r16] = acc[jj];
        }
        __syncthreads();
        if (act) {
            const int rr = 2 * wave + (lane >> 5), e = lane & 15, rw = g0 + rr;
            const LAS float* red = (const LAS float*)(lds + P6_RED) + rr * 16 + e;
            float lg = 0.f;
#pragma unroll
            for (int w8 = 0; w8 < 8; ++w8) lg += red[w8 * 256];
            float mx = lg; mx = fmaxf(mx, dppx<0xB1>(mx)); mx = fmaxf(mx, dppx<0x4E>(mx)); mx = fmaxf(mx, xor4f(mx)); mx = fmaxf(mx, xor8f(mx));
            const float ex = __expf(lg - mx); float se = ex; se += dppx<0xB1>(se); se += dppx<0x4E>(se); se += xor4f(se); se += xor8f(se);
            if ((lane & 16) == 0) {
                const float av = ex * __builtin_amdgcn_rcpf(se);
                if (rw < MX) aff[((size_t)((rw >> 13) * 16 + e)) * T + (rw & (T - 1))] = av;
                else { const int rc = rw - MX, b = rc >> 8, p = rc & 255; affc[((size_t)(e * 8 + b)) * LC + p] = av; }
            }
        }
    }
#undef LD_ROW6
#undef BI_OF
}

template <int CTRL> __device__ __forceinline__ int dppi(int v) { return __builtin_amdgcn_update_dpp(0, v, CTRL, 0xF, 0xF, false); }
__device__ __forceinline__ int block_sum_i(int v, LAS int* red, int wave, int lane, int& parity) {
    v += dppi<0xB1>(v); v += dppi<0x4E>(v); v += dppi<0x141>(v); v += dppi<0x140>(v);
    v = (__builtin_amdgcn_readlane(v, 0) + __builtin_amdgcn_readlane(v, 16)) + (__builtin_amdgcn_readlane(v, 32) + __builtin_amdgcn_readlane(v, 48));
    LAS int* r = red + 8 * parity; parity ^= 1;
    if (lane == 0) r[wave] = v;
    __syncthreads();
    const i32x4 a = *(const LAS i32x4*)r, b = *(const LAS i32x4*)(r + 4);
    return (a[0] + a[1]) + (a[2] + a[3]) + (b[0] + b[1]) + (b[2] + b[3]);
}
__device__ __forceinline__ void p7_topk(Frame& F, bool with_ctx) {
    LAS int* red = (LAS int*)F.lds;
    LAS int* wtot = (LAS int*)(F.lds + 64);
    int par = 0;
    const float* aff = (const float*)(F.ws + WS_AFF); const float* affc = (const float*)(F.ws + WS_AFFC);
    int* seli = (int*)(F.ws + WS_SELI); float* selg = (float*)(F.ws + WS_SELG); int* inv = (int*)(F.ws + WS_INV);
    const int nprob = with_ctx ? 256 : 128;
    for (int q = F.vcu; q < nprob; q += F.G) {
        const float* src; int n, cap, pbase, rbase, e;
        if (q < 128) { src = aff + (size_t)q * T; n = T; cap = CAPX; pbase = q * CAPX; rbase = (q >> 4) * T; e = q & 15; }
        else { const int qq = q - 128; src = affc + (size_t)qq * LC; n = LC; cap = CAPC; pbase = PX + qq * CAPC; rbase = MX + (qq & 7) * LC; e = qq >> 3; }
        const int t0 = F.tid * 16;
        unsigned key[16]; const bool valid = t0 < n;
#pragma unroll
        for (int i = 0; i < 16; ++i) key[i] = 0u;
        if (valid) {
#pragma unroll
            for (int i4 = 0; i4 < 4; ++i4) { const f32x4 v = *(const f32x4*)(src + t0 + 4 * i4);
#pragma unroll
                for (int j = 0; j < 4; ++j) key[i4 * 4 + j] = __float_as_uint(v[j]); }
        }
        unsigned cur = 0u;
        for (int bit = 31; bit >= 0; --bit) {
            const unsigned cand = cur | (1u << bit); int c = 0;
#pragma unroll
            for (int i = 0; i < 16; ++i) c += (key[i] >= cand) ? 1 : 0;
            const int tot = block_sum_i(c, red, F.wave, F.lane, par);
            if (tot >= cap) cur = cand;
        }
        int cg = 0, ce = 0;
#pragma unroll
        for (int i = 0; i < 16; ++i) { cg += (key[i] > cur) ? 1 : 0; ce += (valid && key[i] == cur) ? 1 : 0; }
        const int ngt = block_sum_i(cg, red, F.wave, F.lane, par);
        const int need = cap - ngt;
        int x = cg | (ce << 16);
        int incl = x;
#pragma unroll
        for (int o = 1; o < 64; o <<= 1) { const int y = __shfl_up(incl, o); if (F.lane >= o) incl += y; }
        __syncthreads();
        if (F.lane == 63) wtot[F.wave] = incl;
        __syncthreads();
        int wpre = 0;
#pragma unroll
        for (int w = 0; w < 8; ++w) wpre += (w < F.wave) ? wtot[w] : 0;
        const int excl = wpre + incl - x;
        int pg = excl & 0xffff, pe = excl >> 16;
        if (valid) {
#pragma unroll
            for (int i = 0; i < 16; ++i) {
                const bool gt = key[i] > cur, eq = key[i] == cur;
                const bool sel = gt || (eq && pe < need);
                const int slot = pg + min(pe, need);
                const int trow = rbase + t0 + i;
                if (sel) { seli[pbase + slot] = trow; selg[pbase + slot] = __uint_as_float(key[i]); inv[(size_t)trow * 16 + e] = pbase + slot; }
                else inv[(size_t)trow * 16 + e] = -1;
                pg += gt ? 1 : 0; pe += eq ? 1 : 0;
            }
        }
        __syncthreads();
    }
}

__device__ __forceinline__ void p8a_gather(Frame& F, bool with_ctx) {
    const int gw = F.vcu * 8 + F.wave, NGW = F.G * 8, lane = F.lane;
    const int* seli = (const int*)(F.ws + WS_SELI);
    const bf16_t* hx2 = (const bf16_t*)(F.ws + WS_HX); bf16_t* Xg = (bf16_t*)(F.ws + WS_R2);
    const int np = with_ctx ? PT : PX;
    for (int pr = gw; pr < np; pr += NGW) {
        const int tr = seli[pr];
        const u32x4* s = (const u32x4*)(hx2 + (size_t)tr * D); u32x4* d = (u32x4*)(Xg + (size_t)pr * D);
        const u32x4 a = s[lane], b = s[lane + 64]; d[lane] = a; d[lane + 64] = b;
    }
}

__device__ __forceinline__ void p10_combine(Frame& F, const Args& A, int l, float* xout, float* cio, bool with_ctx) {
    bf16_t* XB = (bf16_t*)(F.ws + WS_XB);
#define LD_ROW10(dstv, rr) do { const int _r = (rr); if (_r < MX) ld_row_raw(dstv, XB + (size_t)_r * D, true, lane); else ld_row_raw(dstv, cio + (size_t)(_r - MX) * D, false, lane); } while (0)
    const int gw = F.vcu * 8 + F.wave, NGW = F.G * 8, lane = F.lane;
    const int* inv = (const int*)(F.ws + WS_INV); const unsigned char* Yd = (const unsigned char*)(F.ws + WS_R2); const float* selg = (const float*)(F.ws + WS_SELG);
    const float* gpost = A.in[I_GFPOST] + l * D; const float* mod = (const float*)(F.ws + WS_MOD) + (size_t)l * 9 * NMOD;
    const float* gpre1 = A.in[I_GMPRE] + D;
    bf16_t* hx = (bf16_t*)(F.ws + WS_HX);
    const int nrows = with_ctx ? MT : MX;
    const int rpw = (nrows + NGW - 1) / NGW, r0 = gw * rpw, r1 = min(r0 + rpw, nrows);
    if (r0 >= r1) return;
    float PA3[16], PA4[16], PS4[16]; int cur_bi = -1;
    RowRaw cur, nxt; int cinv, ninv = -1;
    LD_ROW10(cur, r0);
    cinv = (lane < 16) ? inv[(size_t)r0 * 16 + lane] : -1;
    for (int row = r0; row < r1; ++row) {
        if (row + 1 < r1) { const int rn = row + 1; LD_ROW10(nxt, rn); ninv = (lane < 16) ? inv[(size_t)rn * 16 + lane] : -1; }
        const bool isx = row < MX;
        const int bi = isx ? (row >> 13) : 8;
        if (bi != cur_bi) { cur_bi = bi; const float* mb = mod + (size_t)bi * NMOD; float t0[16], t1[16];
            ld_vec16(t0, gpost, lane); ld_vec16(t1, mb + 5 * D, lane);
#pragma unroll
            for (int k = 0; k < 16; ++k) PA3[k] = t0[k] * t1[k];
            if (l == 0) { const float* mb1 = mb + (size_t)9 * NMOD; ld_vec16(t0, gpre1, lane); ld_vec16(t1, mb1 + D, lane); ld_vec16(PS4, mb1, lane);
#pragma unroll
                for (int k = 0; k < 16; ++k) PA4[k] = t0[k] * (1.0f + t1[k]); } }
        float acc[16];
#pragma unroll
        for (int k = 0; k < 16; ++k) acc[k] = 0.f;
        unsigned long long bm = __ballot(cinv >= 0);
        while (bm) {
            int pr[4]; float wgt[4];
#pragma unroll
            for (int k = 0; k < 4; ++k) { if (bm) { const int e = __builtin_ctzll(bm); bm &= bm - 1; pr[k] = __builtin_amdgcn_readlane(cinv, e); wgt[k] = selg[pr[k]] * (1.0f / pg8::YD_SCALE); } else { pr[k] = 0; wgt[k] = 0.f; } }
            u32x2 y[4][2];
#pragma unroll
            for (int k = 0; k < 4; ++k)
#pragma unroll
                for (int j = 0; j < 2; ++j) y[k][j] = *(const u32x2*)(Yd + (size_t)pr[k] * D + 8 * lane + 512 * j);
#pragma unroll
            for (int k = 0; k < 4; ++k)
#pragma unroll
                for (int j = 0; j < 2; ++j) { const f32x2 v0 = __builtin_amdgcn_cvt_pk_f32_fp8((int)y[k][j].x, false), v1 = __builtin_amdgcn_cvt_pk_f32_fp8((int)y[k][j].x, true),
                                                          v2 = __builtin_amdgcn_cvt_pk_f32_fp8((int)y[k][j].y, false), v3 = __builtin_amdgcn_cvt_pk_f32_fp8((int)y[k][j].y, true);
                    acc[8 * j] += wgt[k] * v0.x; acc[8 * j + 1] += wgt[k] * v0.y; acc[8 * j + 2] += wgt[k] * v1.x; acc[8 * j + 3] += wgt[k] * v1.y;
                    acc[8 * j + 4] += wgt[k] * v2.x; acc[8 * j + 5] += wgt[k] * v2.y; acc[8 * j + 6] += wgt[k] * v3.x; acc[8 * j + 7] += wgt[k] * v3.y; }
        }
        float ss = 0.f;
#pragma unroll
        for (int k = 0; k < 16; ++k) ss += acc[k] * acc[k];
        const float rstd = rsqrtf(wave_sum(ss) * (1.0f / D) + RMS_EPS);
        float s3 = 0.f, x1[16];
        row_to_f32(cur, isx, x1);
#pragma unroll
        for (int k = 0; k < 16; ++k) { const float v = x1[k] + acc[k] * rstd * PA3[k]; acc[k] = v; s3 += v * v; }
        if (!isx) st_row_f32(cio + (size_t)(row - MX) * D, acc, lane);
        else if (l == 0) st_row_bf16(XB + (size_t)row * D, acc, lane);
        else st_row_f32(xout + (size_t)row * D, acc, lane);
        if (l == 0) {
            const float rstd3 = rsqrtf(wave_sum(s3) * (1.0f / D) + RMS_EPS);
#pragma unroll
            for (int k = 0; k < 16; ++k) acc[k] = acc[k] * rstd3 * PA4[k] + PS4[k];
            st_row_bf16(hx + (size_t)row * D, acc, lane);
        }
        cur = nxt; cinv = ninv;
    }
#undef LD_ROW10
}

constexpr int NPL = 11, NPHASE = 1 + 2 * NPL;
#ifndef LB2
#define LB2 2
#endif
__global__ void __launch_bounds__(512, LB2) fwd(Args args) {
    extern __shared__ __attribute__((aligned(16))) unsigned char lds_raw[];
    Frame F;
    F.lds = (LAS unsigned char*)lds_raw;
    F.tid = threadIdx.x; F.lane = F.tid & 63; F.wave = __builtin_amdgcn_readfirstlane(F.tid >> 6);
    F.G = gridDim.x; { const int bx = blockIdx.x; F.vcu = (F.G % 8 == 0) ? (bx % 8) * (F.G / 8) + bx / 8 : bx; }
    F.out = args.out; F.ws = args.ws;
    volatile LAS unsigned* MISC = (volatile LAS unsigned*)(F.lds + MISC_OFF);
    for (int u = F.tid; u < 64; u += 512) ((LAS unsigned*)(F.lds + MISC_OFF))[u] = 0u;
    __syncthreads();
    const int lo = args.ph_lo, hi = args.ph_hi;
    const bool multi = (hi - lo) > 1;
    XcdBarrier bar; bar.bar = (unsigned*)(F.ws + WS_CTL) + 4096; bar.x = 0; bar.st = MISC + 8;
    if (multi) bar = xcd_barrier_post((unsigned*)(F.ws + WS_CTL) + 4096, MISC + 8);
#ifndef PH_MASK
#define PH_MASK 0xFFFFFFFFu
#endif
#define IN(k) (lo <= (k) && (k) < hi)
#define EN(j) ((PH_MASK >> (j)) & 1u)
#ifndef DUP_MASK
#define DUP_MASK 0u
#endif
#define REPS(j) ((((unsigned)DUP_MASK >> (j)) & 1u) ? 2 : 1)
#define FRESH() do { F.tid = launder((int)threadIdx.x); F.lane = F.tid & 63; } while (0)
#define SEAM(k) do { if (multi && IN((k) + 1)) xcd_barrier(bar); } while (0)

    if (EN(0) && IN(0)) { FRESH();
#pragma nounroll
        for (int rep = 0; rep < REPS(0); ++rep) p0_prologue(F, args);
        SEAM(0);
#ifdef XBAR
        if (multi) for (int q = 0; q < XBAR; ++q) xcd_barrier(bar);
#endif
        }

    bf16_t* HX = (bf16_t*)(F.ws + WS_HX);
    float* CTXS = (float*)(F.ws + WS_CTXS);
#pragma nounroll
    for (int l = 0; l < 2; ++l) {
        const int pb = 1 + l * NPL;
        const bool wctx = (l == 0);
        const float* xsrc = args.in[I_X];
        const float* csrc = (l == 0) ? args.in[I_CTX] : CTXS;
        if (EN(1) && IN(pb + 0)) { FRESH();
#pragma nounroll
            for (int rep = 0; rep < REPS(1); ++rep) if (l == 0) p1_norm(F, args, l, xsrc, csrc);
            if (l == 0) SEAM(pb + 0); }
        if (EN(2) && IN(pb + 1)) { FRESH();
            pg8::AddrPlain g{HX, (const bf16_t*)(F.ws + WS_WIN) + (size_t)l * D * D, D};
            pg8::LinOrder S{(MT / 256) * 4, 4, F.G, F.vcu};
            pg8::EpiWin E{(bf16_t*)(F.ws + WS_R1 + R1_US5), (bf16_t*)(F.ws + WS_R1 + R1_VP)};

#pragma nounroll
            for (int rep = 0; rep < REPS(2); ++rep) pg8::gemm_phase(F.lds + STAGE_OFF, g, S, E);
            SEAM(pb + 1);
        }
        if (EN(3) && IN(pb + 2)) { FRESH();
#pragma nounroll
            for (int rep = 0; rep < REPS(3); ++rep) { s5_mfma(F, l, wctx); pool_v(F); }
            SEAM(pb + 2); }
        if (EN(4) && IN(pb + 3)) { FRESH();
#pragma nounroll
            for (int rep = 0; rep < REPS(4); ++rep) pool_h(F, wctx);
            SEAM(pb + 3); }
        if (EN(5) && IN(pb + 4)) { FRESH();
            const int mrows = wctx ? MT : MX;
            { pg8::AddrMid g{(const bf16_t*)(F.ws + WS_R1 + R1_YG), (const bf16_t*)(F.ws + WS_R1 + R1_Z), (const bf16_t*)(F.ws + WS_WGLU) + (size_t)l * DS5 * DS5, (const bf16_t*)(F.ws + WS_WPOOL) + (size_t)l * 512 * 512, 512};
              pg8::MidOrder S{(mrows / 256) * 4, F.G, F.vcu};
              pg8::EpiMid E{(const bf16_t*)(F.ws + WS_R1 + R1_YG), args.in[I_POOLS] + l * 512, HX};
#pragma nounroll
              for (int rep = 0; rep < REPS(5); ++rep) pg8::gemm_phase(F.lds + STAGE_OFF, g, S, E); }
            SEAM(pb + 4);
        }
        if (EN(6) && IN(pb + 5)) { FRESH();
            const int mrows = wctx ? MT : MX;
            pg8::AddrPlain g{HX, (const bf16_t*)(F.ws + WS_WOUT) + (size_t)l * D * D, D};
            pg8::LinOrder S{(mrows / 256) * 4, 4, F.G, F.vcu};
            pg8::EpiPlain E{(bf16_t*)(F.ws + WS_R1), D};

#pragma nounroll
            for (int rep = 0; rep < REPS(6); ++rep) pg8::gemm_phase(F.lds + STAGE_OFF, g, S, E);
            SEAM(pb + 5);
        }
        if (EN(7) && IN(pb + 6)) { FRESH();
#pragma nounroll
            for (int rep = 0; rep < ((l == 0) ? REPS(7) : 1); ++rep) p6_rows(F, args, l, xsrc, csrc, CTXS, wctx);
            SEAM(pb + 6); }
        if (EN(8) && IN(pb + 7)) { FRESH();
#pragma nounroll
            for (int rep = 0; rep < REPS(8); ++rep) p7_topk(F, wctx);
            SEAM(pb + 7); }
        if (EN(9) && IN(pb + 8)) { FRESH();
            const int ptiles = (wctx ? PT : PX) / 256;
            pg8::AddrMoEGather g{(const unsigned char*)(F.ws + WS_HX), (const int*)(F.ws + WS_SELI), (const unsigned char*)(F.ws + WS_WGU) + (size_t)l * 16 * 2048 * D, (size_t)2048 * D, D / 2};
            pg8::LinOrder S{ptiles * 8, 8, F.G, F.vcu};
            pg8::EpiSwiglu E{(unsigned char*)(F.ws + WS_R1)};

#pragma nounroll
            for (int rep = 0; rep < REPS(9); ++rep) pg8::gemm_phase(F.lds + STAGE_OFF, g, S, E);
            SEAM(pb + 8);
        }
        if (EN(10) && IN(pb + 9)) { FRESH();
            const int ptiles = (wctx ? PT : PX) / 256;
            pg8::AddrMoEGatherH g{(const unsigned char*)(F.ws + WS_R1), (const int*)(F.ws + WS_IDENT), (const unsigned char*)(F.ws + WS_WD) + (size_t)l * 16 * D * D, (size_t)D * D, D / 2};
            pg8::LinOrder S{ptiles * 4, 4, F.G, F.vcu};
            pg8::EpiYd8 E{(unsigned char*)(F.ws + WS_R2)};

#pragma nounroll
            for (int rep = 0; rep < REPS(10); ++rep) pg8::gemm_phase(F.lds + STAGE_OFF, g, S, E);
            SEAM(pb + 9);
        }
        if (EN(11) && IN(pb + 10)) { FRESH();
#pragma nounroll
            for (int rep = 0; rep < ((l == 1) ? REPS(11) : 1); ++rep) p10_combine(F, args, l, F.out, CTXS, wctx);
            SEAM(pb + 10); }
    }
#undef IN
#undef SEAM
}

#ifndef MK_ONE_LAUNCH
#define MK_ONE_LAUNCH 1
#endif
extern "C" void kernel_launch(void* const* d_in, const int* in_sizes, int n_in, void* d_out, int out_size, void* d_ws, size_t ws_size, hipStream_t stream) {
    static int grid = 0;
    if (grid == 0) {
        if (n_in != 27 || out_size != MX * D || ws_size < WS_END) { fprintf(stderr, "kernel_launch: unexpected shapes (n_in %d out %d ws %zu)\n", n_in, out_size, ws_size); grid = -1; return; }
        int dev = 0, cus = 0, per_cu = 0;
        if (hipGetDevice(&dev) != hipSuccess || hipDeviceGetAttribute(&cus, hipDeviceAttributeMultiprocessorCount, dev) != hipSuccess) { grid = -1; return; }
        if (hipFuncSetAttribute((const void*)fwd, hipFuncAttributeMaxDynamicSharedMemorySize, LDS_BYTES) != hipSuccess) { fprintf(stderr, "kernel_launch: hipFuncSetAttribute failed\n"); grid = -1; return; }
        if (hipOccupancyMaxActiveBlocksPerMultiprocessor(&per_cu, (const void*)fwd, 512, LDS_BYTES) != hipSuccess || per_cu < 1) fprintf(stderr, "kernel_launch: occupancy query says %d\n", per_cu);
        (void)hipGetLastError();
        grid = cus;
    }
    if (grid < 0) return;
    (void)hipMemsetAsync((char*)d_ws + WS_CTL, 0, CTL_ZERO_BYTES, stream);
    Args a{};
    for (int i = 0; i < 27; ++i) a.in[i] = (const float*)d_in[i];
    a.out = (float*)d_out; a.ws = (unsigned char*)d_ws;
#if MK_ONE_LAUNCH
    a.ph_lo = 0; a.ph_hi = NPHASE;
    hipLaunchKernelGGL(fwd, dim3(grid), dim3(512), LDS_BYTES, stream, a);
#else
    for (int p = 0; p < NPHASE; ++p) { a.ph_lo = p; a.ph_hi = p + 1; hipLaunchKernelGGL(fwd, dim3(grid), dim3(512), LDS_BYTES, stream, a); }
#endif
}
```

```cpp
#include <hip/hip_runtime.h>
#include <cstdio>
#include <cstdint>

#define GAS __attribute__((address_space(1)))
#define LAS __attribute__((address_space(3)))
typedef unsigned short bf16_t;
typedef short bf16x8 __attribute__((ext_vector_type(8)));
typedef float f32x4 __attribute__((ext_vector_type(4)));
typedef float f32x2 __attribute__((ext_vector_type(2)));
typedef unsigned u32x4 __attribute__((ext_vector_type(4)));
typedef unsigned u32x2 __attribute__((ext_vector_type(2)));
typedef int i32x4 __attribute__((ext_vector_type(4)));
typedef int i32x8 __attribute__((ext_vector_type(8)));

constexpr int D = 1024, NB = 8, T = 8192, LC = 256;
constexpr int MX = NB * T, MC = NB * LC, MT = MX + MC;
constexpr int NE = 16, CAPX = 1024, CAPC = 32;
constexpr int PX = NB * NE * CAPX, PC = NE * NB * CAPC, PT = PX + PC;
constexpr int NSEQ = LC + T;
constexpr int DS5 = 512, NG = 32, SH = 16, SP = 64;
constexpr float RMS_EPS = 1e-6f;
constexpr int NMOD = 6 * D;

constexpr size_t MiB = 1u << 20;
constexpr size_t WS_CTL = 0, CTL_ZERO_BYTES = 1 * MiB;
constexpr size_t WS_MOD = 1 * MiB;
constexpr size_t WS_AFF = 2 * MiB;
constexpr size_t WS_AFFC = 6 * MiB;
constexpr size_t WS_SELI = 7 * MiB;
constexpr size_t WS_SELG = 8 * MiB;
constexpr size_t WS_INV = 9 * MiB;
constexpr size_t WS_WRT = 14 * MiB;
constexpr size_t WS_IDENT = 15 * MiB;
constexpr size_t WS_CTXS = 16 * MiB;
constexpr size_t WS_WIN = 24 * MiB;
constexpr size_t WS_WOUT = 28 * MiB;
constexpr size_t WS_WGLU = 32 * MiB;
constexpr size_t WS_WPOOL = 33 * MiB;
constexpr size_t WS_WGU = 34 * MiB;
constexpr size_t WS_WD = 98 * MiB;
constexpr size_t WS_XB = 130 * MiB;
constexpr size_t WS_HX = 262 * MiB;
constexpr size_t WS_R1 = 394 * MiB;
constexpr size_t WS_R2 = 658 * MiB;
constexpr size_t WS_S5W = 922 * MiB;
constexpr size_t S5W_STRIDE = 288 * 1024;
constexpr int S5_OFF_WSF = 0, S5_OFF_WSR = 65536, S5_OFF_WOF = 131072, S5_OFF_WOR = 196608, S5_OFF_TT = 262144, S5_OFF_A16 = 262144 + 16384;
constexpr size_t WS_END = 940 * MiB;
constexpr size_t R1_US5 = 0, R1_VP = 66 * MiB, R1_YG = 132 * MiB, R1_Z = 198 * MiB;

constexpr int LDS_BYTES = 147456;
constexpr int STAGE_OFF = 0, LDSCTL_OFF = 131072, MISC_OFF = LDS_BYTES - 256;

__device__ __forceinline__ unsigned f2bf(float f) { unsigned u = __float_as_uint(f); return (u + 0x7fffu + ((u >> 16) & 1u)) >> 16; }
__device__ __forceinline__ unsigned pk2(float lo, float hi) { unsigned r; asm("v_cvt_pk_bf16_f32 %0, %1, %2" : "=v"(r) : "v"(lo), "v"(hi)); return r; }
__device__ __forceinline__ float bflo(unsigned w) { return __uint_as_float(w << 16); }
__device__ __forceinline__ float bfhi(unsigned w) { return __uint_as_float(w & 0xffff0000u); }
template <int CTRL> __device__ __forceinline__ float dppx(float v) { return __int_as_float(__builtin_amdgcn_update_dpp(0, __float_as_int(v), CTRL, 0xF, 0xF, false)); }
__device__ __forceinline__ float wave_sum(float v) {
    v += dppx<0xB1>(v); v += dppx<0x4E>(v); v += dppx<0x141>(v); v += dppx<0x140>(v);
    const int vi = __float_as_int(v);
    return (__int_as_float(__builtin_amdgcn_readlane(vi, 0)) + __int_as_float(__builtin_amdgcn_readlane(vi, 16))) + (__int_as_float(__builtin_amdgcn_readlane(vi, 32)) + __int_as_float(__builtin_amdgcn_readlane(vi, 48)));
}
__device__ __forceinline__ unsigned pk4_fp8(float a, float b, float c, float d) {
    a = __builtin_amdgcn_fmed3f(a, -448.f, 448.f); b = __builtin_amdgcn_fmed3f(b, -448.f, 448.f); c = __builtin_amdgcn_fmed3f(c, -448.f, 448.f); d = __builtin_amdgcn_fmed3f(d, -448.f, 448.f);
    int w = 0; w = __builtin_amdgcn_cvt_pk_fp8_f32(a, b, w, false); w = __builtin_amdgcn_cvt_pk_fp8_f32(c, d, w, true); return (unsigned)w; }
constexpr float W8_SCALE = 256.f, H8_SCALE = 4.f;
constexpr int SC_ONE = 0x7f7f7f7f, SC_W8 = 0x77777777, SC_H8 = 0x7d7d7d7d;
__device__ __forceinline__ float sigmoidf_(float x) { return __builtin_amdgcn_rcpf(1.0f + __builtin_amdgcn_exp2f(-1.4426950408889634f * x)); }
__device__ __forceinline__ float gelu_tanh(float x) { const float u2 = 1.5957691216057308f * (x + 0.044715f * x * x * x); return x * __builtin_amdgcn_rcpf(1.0f + __builtin_amdgcn_exp2f(-1.4426950408889634f * u2)); }

__device__ __forceinline__ int launder(int v) { asm volatile("" : "+v"(v)); return v; }
__device__ __forceinline__ int launder_s(int v) { asm volatile("" : "+s"(v)); return v; }

#define XB_TMO      128
#define XB_XCNT(j)  (256  + 64 * (j))
#define XB_XSUB(j)  (1280 + 64 * (j))
#define XB_XGEN(j)  (2304 + 64 * (j))
#define XB_TOP      3328
#define XB_TOPGEN   3392
#define XCD_BAR_WORDS 3456
#define XB_SPIN_CAP (1u << 18)

__device__ __forceinline__ unsigned xb_ld(unsigned* p)              { return __hip_atomic_load(p, __ATOMIC_RELAXED, __HIP_MEMORY_SCOPE_AGENT); }
__device__ __forceinline__ unsigned xb_add(unsigned* p, unsigned v) { return __hip_atomic_fetch_add(p, v, __ATOMIC_RELAXED, __HIP_MEMORY_SCOPE_AGENT); }
__device__ __forceinline__ unsigned xb_xcc_id() { return (unsigned)__builtin_amdgcn_s_getreg((3 << 11) | 20) & 0xFu; }
#define XB_SPIN(cond, bar) do { unsigned _sp = 0; while (cond) { __builtin_amdgcn_s_sleep(1); \
    if ((++_sp & 255u) == 0u) { if (xb_ld(&(bar)[XB_TMO])) break; if (_sp > XB_SPIN_CAP) { atomicAdd(&(bar)[XB_TMO], 1u); break; } } } } while (0)

struct XcdBarrier { unsigned* bar; unsigned x; volatile LAS unsigned* st; };

__device__ __forceinline__ XcdBarrier xcd_barrier_post(unsigned* bar, volatile LAS unsigned* st) {
    XcdBarrier b; b.bar = bar; b.x = xb_xcc_id(); b.st = st;
    if (threadIdx.x == 0) (void)xb_add(&bar[XB_XCNT(b.x)], 1u);
    return b;
}
__device__ __forceinline__ void xcd_barrier_complete(unsigned* bar, unsigned x, unsigned& nloc, unsigned& nx) {
    const unsigned G = gridDim.x * gridDim.y * gridDim.z;
    unsigned sum, cnt, mine, sp = 0u;
    for (;;) {
        sum = 0u; cnt = 0u; mine = 0u;
#pragma unroll
        for (unsigned j = 0; j < 16; ++j) { const unsigned c = xb_ld(&bar[XB_XCNT(j)]); sum += c; cnt += (c > 0u) ? 1u : 0u; mine = (j == x) ? c : mine; }
        if (sum == G) break;
        __builtin_amdgcn_s_sleep(1);
        if ((++sp & 255u) == 0u) { if (xb_ld(&bar[XB_TMO])) break; if (sp > XB_SPIN_CAP) { atomicAdd(&bar[XB_TMO], 1u); break; } }
    }
    nloc = mine > 0u ? mine : 1u; nx = cnt > 0u ? cnt : 1u;
}
__device__ __forceinline__ void xcd_barrier(const XcdBarrier& b) {
    asm volatile("s_waitcnt vmcnt(0)" ::: "memory");
    __syncthreads();
    if (threadIdx.x == 0) {
        unsigned* bar = b.bar;
        __builtin_amdgcn_s_waitcnt(0);
        unsigned nloc = b.st[0], nx = b.st[1];
        if (nloc == 0u) { xcd_barrier_complete(bar, b.x, nloc, nx); b.st[0] = nloc; b.st[1] = nx; }
        const unsigned old = xb_add(&bar[XB_XSUB(b.x)], 1u);
        const unsigned gen = old / nloc;
        if (old + 1u == (gen + 1u) * nloc) {
            __builtin_amdgcn_fence(__ATOMIC_RELEASE, "agent");
            asm volatile("s_waitcnt vmcnt(0)" ::: "memory");
            const unsigned og = xb_add(&bar[XB_TOP], 1u);
            const unsigned tg = og / nx;
            if (og + 1u == (tg + 1u) * nx) xb_add(&bar[XB_TOPGEN], 1u);
            else XB_SPIN(xb_ld(&bar[XB_TOPGEN]) == tg, bar);
            __builtin_amdgcn_fence(__ATOMIC_ACQUIRE, "agent");
            xb_add(&bar[XB_XGEN(b.x)], 1u);
            asm volatile("s_waitcnt vmcnt(0)" ::: "memory");
        } else {
            XB_SPIN(xb_ld(&bar[XB_XGEN(b.x)]) == gen, bar);
            __builtin_amdgcn_fence(__ATOMIC_ACQUIRE, "agent");
            asm volatile("s_waitcnt vmcnt(0)" ::: "memory");
        }
    }
    __syncthreads();
}

namespace pg8 {
constexpr int BM = 256, BK = 64, HALF = 128, HTB = HALF * BK * 2, STAGE_BYTES = 8 * HTB;
__device__ __forceinline__ int lds_byte(int r, int c) { const int st = (r >> 4) * 2 + (c >> 5), rr = r & 15, cc = c & 31, ob = rr * 64 + cc * 2; return st * 1024 + (ob ^ (((ob >> 9) & 1) << 5)); }
__device__ __forceinline__ void stage_rc(int b, int& R, int& C) { const int st = b / 1024, sb = b % 1024, swz = sb ^ (((sb >> 9) & 1) << 5); R = (st >> 1) * 16 + swz / 64; C = (st & 1) * 32 + (swz % 64) / 2; }
__device__ __forceinline__ int perm32(int rho) { const int n = rho >> 4, i = rho & 15; return 8 * (i >> 2) + 4 * n + (i & 3); }
struct Unit { int pm, pn; };
__device__ __forceinline__ unsigned cvt_pk_bf16(float lo, float hi) { unsigned r; asm volatile("v_cvt_pk_bf16_f32 %0, %1, %2" : "=v"(r) : "v"(lo), "v"(hi)); return r; }

struct LinOrder {
    int nunits, nN, G, c;
    __device__ __forceinline__ bool next(int i, Unit& u) const { const long L = (long)i * G + c; if (L >= nunits) return false; u.pn = (int)(L % nN); u.pm = (int)(L / nN); return true; }
    __device__ __forceinline__ void a_ready(const Unit&) const {}
    __device__ __forceinline__ void done(const Unit&) const {}
};
struct AddrPlain {
    static constexpr bool GATHER = false, FP8 = false; static constexpr int SCW = 0, SCW1 = 0, SCX = 0;
    const bf16_t* A; const bf16_t* Bt; int K;
    __device__ __forceinline__ int nt(const Unit&) const { return K / BK; }
    __device__ __forceinline__ const int* idx(const Unit&) const { return nullptr; }
    __device__ __forceinline__ const char* Aof(const Unit& u) const { return (const char*)A + (size_t)u.pm * BM * K * 2; }
    __device__ __forceinline__ const char* Bof(const Unit& u) const { return (const char*)Bt + (size_t)u.pn * BM * K * 2; }
};
struct AddrMoE {
    static constexpr bool GATHER = false, FP8 = true; static constexpr int SCW = SC_W8, SCW1 = SC_W8, SCX = SC_H8;
    const unsigned char* A; const unsigned char* W; size_t wstride; int K;
    __device__ __forceinline__ int nt(const Unit&) const { return K / BK; }
    __device__ __forceinline__ const int* idx(const Unit&) const { return nullptr; }
    __device__ __forceinline__ static int expert(int pm) { return pm < (PX / BM) ? ((pm >> 2) & 15) : (pm - PX / BM); }
    __device__ __forceinline__ const char* Aof(const Unit& u) const { return (const char*)A + (size_t)u.pm * BM * K * 2; }
    __device__ __forceinline__ const char* Bof(const Unit& u) const { return (const char*)(W + (size_t)expert(u.pm) * wstride) + (size_t)u.pn * BM * K * 2; }
};
struct AddrMoEGather {
    static constexpr bool GATHER = true, FP8 = true; static constexpr int SCW = SC_W8, SCW1 = 0x79797979  , SCX = SC_ONE;
    const unsigned char* A; const int* sel; const unsigned char* W; size_t wstride; int K;
    __device__ __forceinline__ int nt(const Unit&) const { return K / BK; }
    __device__ __forceinline__ const int* idx(const Unit& u) const { return sel + (size_t)u.pm * BM; }
    __device__ __forceinline__ const char* Aof(const Unit&) const { return (const char*)A; }
    __device__ __forceinline__ const char* Bof(const Unit& u) const { return (const char*)(W + (size_t)AddrMoE::expert(u.pm) * wstride) + (size_t)u.pn * BM * K * 2; }
};

struct AddrMoEGatherH {
    static constexpr bool GATHER = true, FP8 = true; static constexpr int SCW = SC_W8, SCW1 = SC_W8, SCX = 0x81818181  ;
    const unsigned char* A; const int* sel; const unsigned char* W; size_t wstride; int K;
    __device__ __forceinline__ int nt(const Unit&) const { return K / BK; }
    __device__ __forceinline__ const int* idx(const Unit& u) const { return sel + (size_t)u.pm * BM; }
    __device__ __forceinline__ const char* Aof(const Unit&) const { return (const char*)A; }
    __device__ __forceinline__ const char* Bof(const Unit& u) const { return (const char*)(W + (size_t)AddrMoE::expert(u.pm) * wstride) + (size_t)u.pn * BM * K * 2; }
};

struct MidOrder {
    int nunits, G, c;
    __device__ __forceinline__ bool next(int i, Unit& u) const { const long L = (long)i * G + c; if (L >= nunits) return false; u.pn = (int)((L + i) & 3); u.pm = (int)(L >> 2); return true; }
    __device__ __forceinline__ void a_ready(const Unit&) const {}
    __device__ __forceinline__ void done(const Unit&) const {}
};
struct AddrMid {
    static constexpr bool GATHER = false, FP8 = false; static constexpr int SCW = 0, SCW1 = 0, SCX = 0;
    const bf16_t* Yg; const bf16_t* Z; const bf16_t* Wg; const bf16_t* Wp; int K;
    __device__ __forceinline__ int nt(const Unit& u) const { return u.pn < 2 ? 8 : 4; }
    __device__ __forceinline__ const int* idx(const Unit&) const { return nullptr; }
    __device__ __forceinline__ const char* Aof(const Unit& u) const { return u.pn < 2 ? (const char*)(Yg + (size_t)u.pm * BM * 512) : (const char*)(Z + (size_t)u.pm * BM * 512 + 256 * (u.pn - 2)); }
    __device__ __forceinline__ const char* Bof(const Unit& u) const { return u.pn < 2 ? (const char*)(Wg + (size_t)u.pn * BM * 512) : (const char*)(Wp + (size_t)(u.pn - 2) * BM * 512 + 256 * (u.pn - 2)); }
};

template <class Epi, class Sched, class Addr>
__device__ __forceinline__ void gemm_phase(LAS unsigned char* lds, const Addr g, const Sched& S, const Epi& E) {
    const int tid = launder((int)threadIdx.x), wid = __builtin_amdgcn_readfirstlane(tid >> 6), lane = tid & 63, wr = wid >> 2, wc = wid & 3, fr = lane & 15, fq = lane >> 4;
    const int K = g.K;
    unsigned vA[2][2], voffB[2];
    const size_t kstep = (size_t)(BK * 2);
    const size_t hstep = (size_t)HALF * K * 2;
    LAS int* idxl = (LAS int*)(lds + 131072 + 1024);
#pragma unroll
    for (int i = 0; i < 2; ++i) { int R, C; stage_rc(tid * 16 + i * 8192, R, C); const int Rb = ((R & ~31) + perm32(R & 31));
        vA[0][i] = (unsigned)(R * K + C) * 2u; vA[1][i] = vA[0][i] + (unsigned)hstep; voffB[i] = (unsigned)(Rb * K + C) * 2u; }
    const unsigned ldsw = (unsigned)wid * 1024u;
    const int aoff = lds_byte(wr * 64 + fr, fq * 8), boff = lds_byte(wc * 32 + fr, fq * 8);
#define PG8_SA(b, h) (((b) * 2 + (h)) * HTB)
#define PG8_SB(b, h) ((4 + (b) * 2 + (h)) * HTB)
#define PG8_STAGE(bufoff, gbase, voff) do { _Pragma("unroll") for (int _i = 0; _i < 2; ++_i) \
        __builtin_amdgcn_global_load_lds((const unsigned*)((const char*)(gbase) + (voff)[_i]), (LAS unsigned*)(lds + (bufoff) + ldsw + _i * 8192), 16, 0, 0); } while (0)
#define PG8_LDA(dst, b, h) do { _Pragma("unroll") for (int m = 0; m < 4; ++m) _Pragma("unroll") for (int k = 0; k < 2; ++k) dst[m][k] = *(const LAS bf16x8*)(lds + PG8_SA(b, h) + aoff + m * 2048 + k * 1024); } while (0)
#define PG8_LDB(dst, b, h) do { _Pragma("unroll") for (int n = 0; n < 2; ++n) _Pragma("unroll") for (int k = 0; k < 2; ++k) dst[n][k] = *(const LAS bf16x8*)(lds + PG8_SB(b, h) + boff + n * 2048 + k * 1024); } while (0)
#define PG8_MMA(ai, bj, At, Bt) do { __builtin_amdgcn_s_setprio(1); _Pragma("unroll") for (int m = 0; m < 4; ++m) _Pragma("unroll") for (int n = 0; n < 2; ++n) { \
        if constexpr (Addr::FP8) { const i32x4 b0 = __builtin_bit_cast(i32x4, Bt[n][0]), b1 = __builtin_bit_cast(i32x4, Bt[n][1]), a0 = __builtin_bit_cast(i32x4, At[m][0]), a1 = __builtin_bit_cast(i32x4, At[m][1]); \
            acc[ai][bj][m][n] = __builtin_amdgcn_mfma_scale_f32_16x16x128_f8f6f4(__builtin_shufflevector(b0, b1, 0, 1, 2, 3, 4, 5, 6, 7), __builtin_shufflevector(a0, a1, 0, 1, 2, 3, 4, 5, 6, 7), acc[ai][bj][m][n], 0, 0, 0, (bj) ? Addr::SCW1 : Addr::SCW, 0, Addr::SCX); } \
        else { _Pragma("unroll") for (int k = 0; k < 2; ++k) acc[ai][bj][m][n] = __builtin_amdgcn_mfma_f32_16x16x32_bf16(Bt[n][k], At[m][k], acc[ai][bj][m][n], 0, 0, 0); } } \
        __builtin_amdgcn_s_setprio(0); } while (0)
#define PG8_WAIT_V(n) asm volatile("s_waitcnt vmcnt(" #n ")" ::: "memory")
#define PG8_WAIT_L(n) asm volatile("s_waitcnt lgkmcnt(" #n ")" ::: "memory")
#define PG8_BAR __builtin_amdgcn_s_barrier()
#define PG8_SCHED __builtin_amdgcn_sched_barrier(0)
    Unit cur, nxt; int ui = 0;
    if (!S.next(0, cur)) return;
    f32x4 acc[2][2][4][2];
#pragma unroll
    for (int a = 0; a < 2; ++a)
#pragma unroll
        for (int b = 0; b < 2; ++b)
#pragma unroll
            for (int m = 0; m < 4; ++m)
#pragma unroll
                for (int n = 0; n < 2; ++n) acc[a][b][m][n] = (f32x4){0.f, 0.f, 0.f, 0.f};
    bf16x8 At[4][2], B0[2][2], B1[2][2];
    const char* cA = g.Aof(cur); const char* cB = g.Bof(cur);
    int nt = g.nt(cur);
    S.a_ready(cur);
    if constexpr (Addr::GATHER) { const int* ip = g.idx(cur);
#pragma unroll
        for (int i = 0; i < 2; ++i) { int R, C; stage_rc(tid * 16 + i * 8192, R, C);
#pragma unroll
            for (int h = 0; h < 2; ++h) vA[h][i] = (unsigned)ip[h * HALF + R] * (unsigned)(K * 2) + (unsigned)(C * 2); }
        Unit n1; if (S.next(1, n1) && wid == 0) __builtin_amdgcn_global_load_lds((const unsigned*)(g.idx(n1) + lane * 4), (LAS unsigned*)idxl, 16, 0, 0); }
    PG8_STAGE(PG8_SB(0, 0), cB, voffB); PG8_STAGE(PG8_SA(0, 0), cA, vA[0]); PG8_STAGE(PG8_SB(0, 1), cB + hstep, voffB); PG8_STAGE(PG8_SA(0, 1), cA, vA[1]);
    if (wr == 1) PG8_BAR;
    PG8_WAIT_V(4); PG8_BAR;
    PG8_STAGE(PG8_SB(1, 0), cB + kstep, voffB); PG8_STAGE(PG8_SA(1, 0), cA + kstep, vA[0]); PG8_STAGE(PG8_SB(1, 1), cB + hstep + kstep, voffB);
    PG8_WAIT_V(6); PG8_BAR;
    for (;;) {
        const bool has_next = S.next(ui + 1, nxt);
        const char* nA = has_next ? g.Aof(nxt) : cA; const char* nB = has_next ? g.Bof(nxt) : cB;
        for (int t = 0; t < nt; t += 2) {
            const bool last = (t == nt - 2);
            const char* a1 = cA + (size_t)(t + 1) * kstep;
            const char* a2 = last ? nA : cA + (size_t)(t + 2) * kstep; const char* b2 = last ? nB : cB + (size_t)(t + 2) * kstep;
            const char* a3 = a2 + kstep; const char* b3 = b2 + kstep;
            if (last && has_next) S.a_ready(nxt);
            PG8_LDB(B0, 0, 0); PG8_SCHED; PG8_LDA(At, 0, 0); PG8_STAGE(PG8_SA(1, 1), a1, vA[1]);
            if constexpr (Addr::GATHER) {
                if (last && has_next) {
#pragma unroll
                    for (int i = 0; i < 2; ++i) { int R, C; stage_rc(tid * 16 + i * 8192, R, C);
#pragma unroll
                        for (int h = 0; h < 2; ++h) vA[h][i] = (unsigned)idxl[h * HALF + R] * (unsigned)(K * 2) + (unsigned)(C * 2); } }
            }
            PG8_WAIT_L(8); PG8_BAR; PG8_WAIT_L(0); PG8_MMA(0, 0, At, B0); PG8_BAR; PG8_SCHED;
            PG8_LDB(B1, 0, 1); PG8_STAGE(PG8_SB(0, 0), b2, voffB);
            PG8_BAR; PG8_WAIT_L(0); PG8_MMA(0, 1, At, B1); PG8_BAR;
            PG8_LDA(At, 0, 1); PG8_STAGE(PG8_SA(0, 0), a2, vA[0]);
            PG8_BAR; PG8_WAIT_L(0); PG8_MMA(1, 0, At, B0); PG8_BAR; PG8_SCHED;
            PG8_STAGE(PG8_SB(0, 1), b2 + hstep, voffB);
            PG8_WAIT_V(6); PG8_BAR; PG8_MMA(1, 1, At, B1); PG8_BAR;
            PG8_LDB(B0, 1, 0); PG8_SCHED; PG8_LDA(At, 1, 0); PG8_STAGE(PG8_SA(0, 1), a2, vA[1]);
            PG8_WAIT_L(8); PG8_BAR; PG8_WAIT_L(0); PG8_MMA(0, 0, At, B0); PG8_BAR; PG8_SCHED;
            PG8_LDB(B1, 1, 1); PG8_STAGE(PG8_SB(1, 0), b3, voffB);
            PG8_BAR; PG8_WAIT_L(0); PG8_MMA(0, 1, At, B1); PG8_BAR;
            PG8_LDA(At, 1, 1); PG8_STAGE(PG8_SA(1, 0), a3, vA[0]);
            PG8_BAR; PG8_WAIT_L(0); PG8_MMA(1, 0, At, B0); PG8_BAR; PG8_SCHED;
            PG8_STAGE(PG8_SB(1, 1), b3 + hstep, voffB);
            PG8_WAIT_V(6); PG8_BAR; PG8_MMA(1, 1, At, B1); PG8_BAR;
        }
        E(acc, cur, wr, wc, fr, fq); S.done(cur);
        if (!has_next) break;
        if constexpr (Addr::GATHER) { Unit n2; if (S.next(ui + 2, n2) && wid == 0) __builtin_amdgcn_global_load_lds((const unsigned*)(g.idx(n2) + lane * 4), (LAS unsigned*)idxl, 16, 0, 0); }
#pragma unroll
        for (int a = 0; a < 2; ++a)
#pragma unroll
            for (int b = 0; b < 2; ++b)
#pragma unroll
                for (int m = 0; m < 4; ++m)
#pragma unroll
                    for (int n = 0; n < 2; ++n) acc[a][b][m][n] = (f32x4){0.f, 0.f, 0.f, 0.f};
        cur = nxt; cA = nA; cB = nB; ++ui; nt = g.nt(cur);
    }
    PG8_WAIT_V(0);
    if (wr == 0) PG8_BAR;
    PG8_BAR;
#undef PG8_SA
#undef PG8_SB
#undef PG8_STAGE
#undef PG8_LDA
#undef PG8_LDB
#undef PG8_MMA
#undef PG8_WAIT_V
#undef PG8_WAIT_L
#undef PG8_BAR
#undef PG8_SCHED
}

typedef f32x4 Acc[2][2][4][2];
__device__ __forceinline__ u32x4 pack8(const f32x4& v0, const f32x4& v1) { u32x4 w; w.x = cvt_pk_bf16(v0[0], v0[1]); w.y = cvt_pk_bf16(v0[2], v0[3]); w.z = cvt_pk_bf16(v1[0], v1[1]); w.w = cvt_pk_bf16(v1[2], v1[3]); return w; }

struct EpiPlain {
    bf16_t* O; int ldc;
    __device__ __forceinline__ void operator()(const Acc& acc, const Unit& u, int wr, int wc, int fr, int fq) const {
        const int row0 = u.pm * BM + wr * 64 + fr, col0 = u.pn * BM + wc * 32 + 8 * fq;
#pragma unroll
        for (int ai = 0; ai < 2; ++ai)
#pragma unroll
            for (int m = 0; m < 4; ++m) { bf16_t* rowp = O + (size_t)(row0 + ai * HALF + m * 16) * ldc + col0;
#pragma unroll
                for (int bj = 0; bj < 2; ++bj) *(u32x4*)(rowp + bj * HALF) = pack8(acc[ai][bj][m][0], acc[ai][bj][m][1]); }
    }
};
constexpr float YD_SCALE = 16.f;
struct EpiYd8 {
    unsigned char* O;
    __device__ __forceinline__ void operator()(const Acc& acc, const Unit& u, int wr, int wc, int fr, int fq) const {
        const int row0 = u.pm * BM + wr * 64 + fr, col0 = u.pn * BM + wc * 32 + 8 * fq;
#pragma unroll
        for (int ai = 0; ai < 2; ++ai)
#pragma unroll
            for (int m = 0; m < 4; ++m) { unsigned char* rowp = O + (size_t)(row0 + ai * HALF + m * 16) * 1024 + col0;
#pragma unroll
                for (int bj = 0; bj < 2; ++bj) { const f32x4 a = acc[ai][bj][m][0], b = acc[ai][bj][m][1];
                    u32x2 w; w.x = pk4_fp8(a[0], a[1], a[2], a[3]); w.y = pk4_fp8(b[0], b[1], b[2], b[3]);
                    *(u32x2*)(rowp + bj * HALF) = w; } }
    }
};
struct EpiWin {
    bf16_t* Us5; bf16_t* Vp;
    __device__ __forceinline__ void operator()(const Acc& acc, const Unit& u, int wr, int wc, int fr, int fq) const {
        const int rl = wr * 64 + fr, col0 = u.pn * BM + wc * 32 + 8 * fq;
        if (u.pn < 2) {
            const int b = u.pm < MX / BM ? (u.pm >> 5) : (u.pm - MX / BM), n0 = u.pm < MX / BM ? LC + (u.pm & 31) * BM : 0;
            bf16_t* base = Us5 + ((size_t)b * NG * NSEQ + n0 + rl) * 16;
#pragma unroll
            for (int bj = 0; bj < 2; ++bj) { const int c = col0 + bj * HALF; bf16_t* pb = base + (size_t)(c >> 4) * NSEQ * 16 + (c & 8);
#pragma unroll
                for (int ai = 0; ai < 2; ++ai)
#pragma unroll
                    for (int m = 0; m < 4; ++m) *(u32x4*)(pb + (ai * HALF + m * 16) * 16) = pack8(acc[ai][bj][m][0], acc[ai][bj][m][1]); }
        } else {
            bf16_t* base = Vp + (size_t)(u.pm * BM + rl) * 512 + (col0 - 512);
#pragma unroll
            for (int ai = 0; ai < 2; ++ai)
#pragma unroll
                for (int m = 0; m < 4; ++m)
#pragma unroll
                    for (int bj = 0; bj < 2; ++bj) *(u32x4*)(base + (size_t)(ai * HALF + m * 16) * 512 + bj * HALF) = pack8(acc[ai][bj][m][0], acc[ai][bj][m][1]);
        }
    }
};
struct EpiGlu {
    const bf16_t* Yg; bf16_t* O;
    __device__ __forceinline__ void operator()(const Acc& acc, const Unit& u, int wr, int wc, int fr, int fq) const {
        const int row0 = u.pm * BM + wr * 64 + fr, col0 = u.pn * BM + wc * 32 + 8 * fq;
#pragma unroll
        for (int ai = 0; ai < 2; ++ai)
#pragma unroll
            for (int m = 0; m < 4; ++m) { const int r = row0 + ai * HALF + m * 16;
#pragma unroll
                for (int bj = 0; bj < 2; ++bj) { const int c = col0 + bj * HALF; const u32x4 y = *(const u32x4*)(Yg + (size_t)r * 512 + c);
                    f32x4 v0 = acc[ai][bj][m][0], v1 = acc[ai][bj][m][1];
                    v0[0] = bflo(y.x) * sigmoidf_(v0[0]); v0[1] = bfhi(y.x) * sigmoidf_(v0[1]); v0[2] = bflo(y.y) * sigmoidf_(v0[2]); v0[3] = bfhi(y.y) * sigmoidf_(v0[3]);
                    v1[0] = bflo(y.z) * sigmoidf_(v1[0]); v1[1] = bfhi(y.z) * sigmoidf_(v1[1]); v1[2] = bflo(y.w) * sigmoidf_(v1[2]); v1[3] = bfhi(y.w) * sigmoidf_(v1[3]);
                    *(u32x4*)(O + (size_t)r * 1024 + c) = pack8(v0, v1); } }
    }
};
struct EpiPoolS {
    const float* scale; bf16_t* O;
    __device__ __forceinline__ void operator()(const Acc& acc, const Unit& u, int wr, int wc, int fr, int fq) const {
        const int row0 = u.pm * BM + wr * 64 + fr, col0 = u.pn * BM + wc * 32 + 8 * fq;
        f32x4 s[2][2];
#pragma unroll
        for (int bj = 0; bj < 2; ++bj) { s[bj][0] = *(const f32x4*)(scale + col0 + bj * HALF); s[bj][1] = *(const f32x4*)(scale + col0 + bj * HALF + 4); }
#pragma unroll
        for (int ai = 0; ai < 2; ++ai)
#pragma unroll
            for (int m = 0; m < 4; ++m) { const int r = row0 + ai * HALF + m * 16;
#pragma unroll
                for (int bj = 0; bj < 2; ++bj) { const int c = col0 + bj * HALF;
                    *(u32x4*)(O + (size_t)r * 1024 + 512 + c) = pack8(acc[ai][bj][m][0] * s[bj][0], acc[ai][bj][m][1] * s[bj][1]); } }
    }
};
struct EpiMid {
    const bf16_t* Yg; const float* scale; bf16_t* O;
    __device__ __forceinline__ void operator()(const Acc& acc, const Unit& u, int wr, int wc, int fr, int fq) const {
        if (u.pn < 2) { EpiGlu E{Yg, O}; E(acc, u, wr, wc, fr, fq); }
        else { EpiPoolS E{scale, O}; Unit v = u; v.pn = u.pn - 2; E(acc, v, wr, wc, fr, fq); }
    }
};
struct EpiSwiglu {
    unsigned char* H;
    __device__ __forceinline__ void operator()(const Acc& acc, const Unit& u, int wr, int wc, int fr, int fq) const {
        const int row0 = u.pm * BM + wr * 64 + fr, col0 = u.pn * HALF + wc * 32 + 8 * fq;
#pragma unroll
        for (int ai = 0; ai < 2; ++ai)
#pragma unroll
            for (int m = 0; m < 4; ++m) { const int r = row0 + ai * HALF + m * 16; f32x4 o[2];
#pragma unroll
                for (int n = 0; n < 2; ++n)
#pragma unroll
                    for (int j = 0; j < 4; ++j) { const float a = acc[ai][0][m][n][j], gq = acc[ai][1][m][n][j]; o[n][j] = a * sigmoidf_(a) * gq; }
                u32x2 w; w.x = pk4_fp8(o[0][0], o[0][1], o[0][2], o[0][3]); w.y = pk4_fp8(o[1][0], o[1][1], o[1][2], o[1][3]);
                *(u32x2*)(H + (size_t)r * 1024 + col0) = w; }
    }
};
struct EpiDown {
    const float* gate; bf16_t* O;
    __device__ __forceinline__ void operator()(const Acc& acc, const Unit& u, int wr, int wc, int fr, int fq) const {
        const int row0 = u.pm * BM + wr * 64 + fr, col0 = u.pn * BM + wc * 32 + 8 * fq;
#pragma unroll
        for (int ai = 0; ai < 2; ++ai)
#pragma unroll
            for (int m = 0; m < 4; ++m) { const int r = row0 + ai * HALF + m * 16; const float gt = gate[r];
#pragma unroll
                for (int bj = 0; bj < 2; ++bj) *(u32x4*)(O + (size_t)r * 1024 + col0 + bj * HALF) = pack8(acc[ai][bj][m][0] * gt, acc[ai][bj][m][1] * gt);
                asm volatile("" ::: "memory"); }
    }
};
}

struct Frame {
    LAS unsigned char* lds;
    int tid, lane, wave, vcu, G;
    float* out; unsigned char* ws;
};
struct Args { const float* in[27]; float* out; unsigned char* ws; int ph_lo, ph_hi; };

enum { I_X = 0, I_C, I_CTX, I_CCTX, I_WMOD, I_BMOD, I_GMPRE, I_GMPOST, I_GFPRE, I_GFPOST, I_WIN, I_LRE, I_LIM, I_LDT, I_BRE, I_BIM, I_CRE, I_CIM, I_S5D, I_WGLU, I_POOLW, I_POOLS, I_WOUT, I_WROUTER, I_WGATE, I_WUP, I_WDOWN };

__device__ __forceinline__ void tr_item(const float* W, int ldw, bf16_t* WT, int ldt, int k0, int n0, int drow0, int dk0, LAS float* scr, int lane) {
#pragma unroll 8
    for (int i = 0; i < 32; ++i) { const int kk = 2 * i + (lane >> 5); scr[kk * 33 + (lane & 31)] = W[(size_t)(k0 + kk) * ldw + n0 + (lane & 31)]; }
    asm volatile("s_waitcnt lgkmcnt(0)" ::: "memory");
    const int c = lane & 7;
#pragma unroll
    for (int j = 0; j < 4; ++j) { const int n = (lane >> 3) + 8 * j; const LAS float* s = scr + (8 * c) * 33 + n;
        u32x4 o; o.x = pk2(s[0 * 33], s[1 * 33]); o.y = pk2(s[2 * 33], s[3 * 33]); o.z = pk2(s[4 * 33], s[5 * 33]); o.w = pk2(s[6 * 33], s[7 * 33]);
        *(u32x4*)(WT + (size_t)(drow0 + n) * ldt + dk0 + k0 + 8 * c) = o; }
    asm volatile("s_waitcnt lgkmcnt(0)" ::: "memory");
}

__device__ __forceinline__ void tr_item8(const float* W, int ldw, unsigned char* WT, int ldt, int k0, int n0, int drow0, LAS float* scr, int lane) {
#pragma unroll 8
    for (int i = 0; i < 32; ++i) { const int kk = 2 * i + (lane >> 5); scr[kk * 33 + (lane & 31)] = W[(size_t)(k0 + kk) * ldw + n0 + (lane & 31)]; }
    asm volatile("s_waitcnt lgkmcnt(0)" ::: "memory");
    const int c = lane & 3;
#pragma unroll
    for (int j = 0; j < 2; ++j) { const int n = (lane >> 2) + 16 * j; const LAS float* sp = scr + (16 * c) * 33 + n;
        u32x4 o; o.x = pk4_fp8(sp[0 * 33] * W8_SCALE, sp[1 * 33] * W8_SCALE, sp[2 * 33] * W8_SCALE, sp[3 * 33] * W8_SCALE);
        o.y = pk4_fp8(sp[4 * 33] * W8_SCALE, sp[5 * 33] * W8_SCALE, sp[6 * 33] * W8_SCALE, sp[7 * 33] * W8_SCALE);
        o.z = pk4_fp8(sp[8 * 33] * W8_SCALE, sp[9 * 33] * W8_SCALE, sp[10 * 33] * W8_SCALE, sp[11 * 33] * W8_SCALE);
        o.w = pk4_fp8(sp[12 * 33] * W8_SCALE, sp[13 * 33] * W8_SCALE, sp[14 * 33] * W8_SCALE, sp[15 * 33] * W8_SCALE);
        *(u32x4*)(WT + (size_t)(drow0 + n) * ldt + k0 + 16 * c) = o; }
    asm volatile("s_waitcnt lgkmcnt(0)" ::: "memory");
}

__device__ __forceinline__ void s5_prep(Frame& F, const Args& A, int lg) {
    const int l = lg >> 5, g = lg & 31, tid = F.tid;
    LAS f32x2* apow = (LAS f32x2*)(F.lds + 40960);
    LAS f32x2* Bb = apow + 2 * 17 * 65;
    LAS f32x2* Cc = Bb + 2 * 64 * 16;
    for (int i = tid; i < 2 * 17 * 64; i += 512) { const int d = i / (17 * 64), k = (i / 64) % 17, p = i % 64; const size_t pg = (size_t)(l * 2 + d) * NG + g;
        const float lre = A.in[I_LRE][pg * SP + p], lim = A.in[I_LIM][pg * SP + p], dt = __expf(A.in[I_LDT][pg]);
        const float mag = __expf((float)k * lre * dt); float sn, cs; sincosf((float)k * lim * dt, &sn, &cs);
        apow[(d * 17 + k) * 65 + p] = (f32x2){mag * cs, mag * sn}; }
    for (int i = tid; i < 2 * 64 * 16; i += 512) { const int d = i >> 10, p = (i >> 4) & 63, h = i & 15; const size_t pg = (size_t)(l * 2 + d) * NG + g;
        const float lre = A.in[I_LRE][pg * SP + p], lim = A.in[I_LIM][pg * SP + p], dt = __expf(A.in[I_LDT][pg]);
        const float mag = __expf(lre * dt); float sn, cs; sincosf(lim * dt, &sn, &cs);
        const float nre = mag * cs - 1.0f, nim = mag * sn, den = lre * lre + lim * lim;
        const float cr = (nre * lre + nim * lim) / den, ci = (nim * lre - nre * lim) / den;
        const float br = A.in[I_BRE][(pg * SP + p) * SH + h], bi = A.in[I_BIM][(pg * SP + p) * SH + h];
        Bb[i] = (f32x2){cr * br - ci * bi, cr * bi + ci * br};
        Cc[(d * 16 + h) * 65 + p] = (f32x2){A.in[I_CRE][(pg * SH + h) * SP + p], A.in[I_CIM][(pg * SH + h) * SP + p]}; }
    __syncthreads();
    unsigned char* W = F.ws + WS_S5W + (size_t)lg * S5W_STRIDE;
    for (int i = tid; i < 8192; i += 512) {
        const int r = i >> 12, x = i & 4095, nt = x >> 9, kk = (x >> 6) & 7, ln = x & 63, c = ln & 15, q = ln >> 4;
        const int n = 16 * nt + c, p = n >> 1, ri = n & 1, j = 2 * kk + (q >> 1), h0 = 8 * (q & 1), pw = r ? j : 15 - j;
        const f32x2 ap = apow[(r * 17 + pw) * 65 + p]; float v[8];
#pragma unroll
        for (int jj = 0; jj < 8; ++jj) { const f32x2 bb = Bb[(r * 64 + p) * 16 + h0 + jj]; v[jj] = ri ? (ap.x * bb.y + ap.y * bb.x) : (ap.x * bb.x - ap.y * bb.y); }
        u32x4 o; o.x = pk2(v[0], v[1]); o.y = pk2(v[2], v[3]); o.z = pk2(v[4], v[5]); o.w = pk2(v[6], v[7]);
        *(u32x4*)(W + (r ? S5_OFF_WSR : S5_OFF_WSF) + (size_t)x * 16) = o; }
    for (int i = tid; i < 8192; i += 512) {
        const int r = i >> 12, x = i & 4095, nt = x >> 8, kk = (x >> 6) & 3, ln = x & 63, h = ln & 15, q = ln >> 4;
        const int pw = r ? 16 - nt : nt + 1; float v[8];
#pragma unroll
        for (int jj = 0; jj < 8; ++jj) { const int p = 16 * kk + 4 * q + (jj >> 1); const f32x2 ap = apow[(r * 17 + pw) * 65 + p], cc = Cc[(r * 16 + h) * 65 + p];
            v[jj] = (jj & 1) ? -(cc.x * ap.y + cc.y * ap.x) : (cc.x * ap.x - cc.y * ap.y); }
        u32x4 o; o.x = pk2(v[0], v[1]); o.y = pk2(v[2], v[3]); o.z = pk2(v[4], v[5]); o.w = pk2(v[6], v[7]);
        *(u32x4*)(W + (r ? S5_OFF_WOR : S5_OFF_WOF) + (size_t)x * 16) = o; }
    if (tid < 31 * 16) {
        const int di = tid >> 4, h = tid & 15, dl = di - 15; float acc[16];
#pragma unroll
        for (int k = 0; k < 16; ++k) acc[k] = 0.f;
#pragma unroll
        for (int d = 0; d < 2; ++d) {
            if ((d == 0 && dl >= 0) || (d == 1 && dl <= 0)) { const int tau = d ? -dl : dl;
                for (int p = 0; p < 64; ++p) { const f32x2 cc = Cc[(d * 16 + h) * 65 + p], ap = apow[(d * 17 + tau) * 65 + p];
                    const float zr = cc.x * ap.x - cc.y * ap.y, zi = cc.x * ap.y + cc.y * ap.x;
#pragma unroll
                    for (int k = 0; k < 16; ++k) { const f32x2 bb = Bb[(d * 64 + p) * 16 + k]; acc[k] += zr * bb.x - zi * bb.y; } } } }
        { const float dsk = (dl == 0) ? A.in[I_S5D][l * DS5 + g * 16 + h] : 0.f;
#pragma unroll
          for (int k = 0; k < 16; ++k) acc[k] += (k == h) ? dsk : 0.f; }
        u32x4 o0, o1; o0.x = pk2(acc[0], acc[1]); o0.y = pk2(acc[2], acc[3]); o0.z = pk2(acc[4], acc[5]); o0.w = pk2(acc[6], acc[7]);
        o1.x = pk2(acc[8], acc[9]); o1.y = pk2(acc[10], acc[11]); o1.z = pk2(acc[12], acc[13]); o1.w = pk2(acc[14], acc[15]);
        *(u32x4*)(W + S5_OFF_TT + (size_t)tid * 32) = o0; *(u32x4*)(W + S5_OFF_TT + (size_t)tid * 32 + 16) = o1;
    }
    if (tid < 128) ((f32x2*)(W + S5_OFF_A16))[tid] = apow[((tid >> 6) * 17 + 16) * 65 + (tid & 63)];
    __syncthreads();
}
__device__ __forceinline__ void p0_prologue(Frame& F, const Args& A) {
    unsigned char* ws = F.ws;
    const int gw = F.vcu * 8 + F.wave, NGW = F.G * 8;
    LAS float* sil = (LAS float*)(F.lds);
    for (int i = F.tid; i < 9 * 1024; i += 512) { const float v = (i < 8192) ? A.in[I_C][i] : A.in[I_CCTX][i - 8192]; sil[i] = v * sigmoidf_(v); }
    __syncthreads();
    LAS float* scr = (LAS float*)(F.lds + 40960 + F.wave * 8448);
    float* mod = (float*)(ws + WS_MOD);
    if (F.vcu >= 64 || F.G < 256) {
        LAS float* part = (LAS float*)(F.lds + 40960);
        for (int it = (F.G < 256 ? F.vcu : F.vcu - 64); it < 2 * 96; it += (F.G < 256 ? F.G : F.G - 64)) {
            const int l = it / 96, n0 = (it % 96) * 64, n = n0 + F.lane;
            const float* W = A.in[I_WMOD] + (size_t)l * D * NMOD + n + (size_t)(F.wave * 128) * NMOD;
            float acc[9];
#pragma unroll
            for (int r = 0; r < 9; ++r) acc[r] = 0.f;
#pragma unroll 32
            for (int k = 0; k < 128; ++k) { const float w = W[(size_t)k * NMOD];
#pragma unroll
                for (int r = 0; r < 9; ++r) acc[r] += sil[r * 1024 + F.wave * 128 + k] * w; }
#pragma unroll
            for (int r = 0; r < 9; ++r) part[(F.wave * 9 + r) * 64 + F.lane] = acc[r];
            __syncthreads();
            for (int o = F.tid; o < 9 * 64; o += 512) { float sm = 0.f;
#pragma unroll
                for (int w = 0; w < 8; ++w) sm += part[w * 576 + o];
                const int r = o >> 6, nn = n0 + (o & 63);
                mod[((size_t)l * 9 + r) * NMOD + nn] = sm + A.in[I_BMOD][l * NMOD + nn]; }
            __syncthreads();
        }
    }
    for (int lg = F.vcu; lg < 64; lg += F.G) s5_prep(F, A, lg);
    constexpr int IT_SQ = 16 * 32;
    constexpr int IT_GLU = 8 * 16, IT_POOL = 4 * 2 * 4;
    constexpr int PER_L = 2 * IT_SQ + IT_GLU + IT_POOL;
    constexpr int N_SMALL = 2 * PER_L;
    constexpr int N_GU = 2 * 16 * 2 * IT_SQ, N_D = 2 * 16 * IT_SQ;
    for (int it = gw; it < N_SMALL + N_GU + N_D; it += NGW) {
        int r = it;
        if (r < N_SMALL) {
            const int l = r / PER_L; r -= l * PER_L;
            if (r < IT_SQ) { const int kb = r / 32, nb = r % 32; tr_item(A.in[I_WIN] + (size_t)l * D * D, D, (bf16_t*)(ws + WS_WIN) + (size_t)l * D * D, D, kb * 64, nb * 32, nb * 32, 0, scr, F.lane); continue; }
            r -= IT_SQ;
            if (r < IT_SQ) { const int kb = r / 32, nb = r % 32; tr_item(A.in[I_WOUT] + (size_t)l * D * D, D, (bf16_t*)(ws + WS_WOUT) + (size_t)l * D * D, D, kb * 64, nb * 32, nb * 32, 0, scr, F.lane); continue; }
            r -= IT_SQ;
            if (r < IT_GLU) { const int kb = r / 16, nb = r % 16; tr_item(A.in[I_WGLU] + (size_t)l * DS5 * DS5, DS5, (bf16_t*)(ws + WS_WGLU) + (size_t)l * DS5 * DS5, DS5, kb * 64, nb * 32, nb * 32, 0, scr, F.lane); continue; }
            r -= IT_GLU;
            { const int gi = r / 8, q = r % 8, kb = q / 4, nb = q % 4;
              tr_item(A.in[I_POOLW] + ((size_t)l * 4 + gi) * 128 * 128, 128, (bf16_t*)(ws + WS_WPOOL) + (size_t)l * 512 * 512, 512, kb * 64, nb * 32, gi * 128 + nb * 32, gi * 128, scr, F.lane); continue; }
        }
        r -= N_SMALL;
        if (r < N_GU) {
            const int le = r / (2 * IT_SQ); int q = r % (2 * IT_SQ); const int up = q / IT_SQ; q %= IT_SQ; const int kb = q / 32, nb = q % 32, n0 = nb * 32;
            const float* W = (up ? A.in[I_WUP] : A.in[I_WGATE]) + (size_t)le * D * D;
            tr_item8(W, D, (unsigned char*)(ws + WS_WGU) + (size_t)le * 2048 * D, D, kb * 64, n0, 256 * (n0 / 128) + (n0 % 128) + up * 128, scr, F.lane); continue;
        }
        r -= N_GU;
        { const int le = r / IT_SQ, q = r % IT_SQ, kb = q / 32, nb = q % 32;
          tr_item8(A.in[I_WDOWN] + (size_t)le * D * D, D, (unsigned char*)(ws + WS_WD) + (size_t)le * D * D, D, kb * 64, nb * 32, nb * 32, scr, F.lane); }
    }
    const int gt = F.vcu * 512 + F.tid, NGT = F.G * 512;
    for (int i = gt; i < 2 * 512 * 64; i += NGT) { const int row = (i / 64) % 512, c8 = i % 64; if ((row >> 7) != (c8 >> 4)) *(u32x4*)((bf16_t*)(ws + WS_WPOOL) + (size_t)i * 8) = (u32x4){0u, 0u, 0u, 0u}; }
    for (int i = gt; i < PT; i += NGT) ((int*)(ws + WS_IDENT))[i] = i;
    for (int i = gt; i < 2 * 16 * 1024; i += NGT) { const int l = i / 16384, e = (i / 1024) % 16, k = i % 1024; ((float*)(ws + WS_WRT))[i] = A.in[I_WROUTER][((size_t)l * D + k) * NE + e]; }
}

struct RowF32 { f32x4 v[4]; };
__device__ __forceinline__ void ld_row_f32(RowF32& r, const float* p, int lane) {
#pragma unroll
    for (int j = 0; j < 2; ++j) { r.v[2 * j] = *(const f32x4*)(p + 8 * lane + 512 * j); r.v[2 * j + 1] = *(const f32x4*)(p + 8 * lane + 512 * j + 4); }
}
__device__ __forceinline__ void ld_vec16(float (&o)[16], const float* p, int lane) {
#pragma unroll
    for (int j = 0; j < 2; ++j) { const f32x4 a = *(const f32x4*)(p + 8 * lane + 512 * j), b = *(const f32x4*)(p + 8 * lane + 512 * j + 4);
#pragma unroll
        for (int q = 0; q < 4; ++q) { o[8 * j + q] = a[q]; o[8 * j + 4 + q] = b[q]; } }
}
__device__ __forceinline__ void st_row_bf16(bf16_t* p, const float (&h)[16], int lane) {
#pragma unroll
    for (int j = 0; j < 2; ++j) { u32x4 w; w.x = pk2(h[8 * j], h[8 * j + 1]); w.y = pk2(h[8 * j + 2], h[8 * j + 3]); w.z = pk2(h[8 * j + 4], h[8 * j + 5]); w.w = pk2(h[8 * j + 6], h[8 * j + 7]);
        *(u32x4*)(p + 8 * lane + 512 * j) = w; }
}
struct RowRaw { u32x4 v[4]; };
__device__ __forceinline__ void ld_row_raw(RowRaw& r, const void* p, bool bf, int lane) {
    if (bf) { const bf16_t* q = (const bf16_t*)p; r.v[0] = *(const u32x4*)(q + 8 * lane); r.v[1] = *(const u32x4*)(q + 8 * lane + 512); }
    else { const float* q = (const float*)p; r.v[0] = *(const u32x4*)(q + 8 * lane); r.v[1] = *(const u32x4*)(q + 8 * lane + 4); r.v[2] = *(const u32x4*)(q + 8 * lane + 512); r.v[3] = *(const u32x4*)(q + 8 * lane + 516); }
}
__device__ __forceinline__ void row_to_f32(const RowRaw& r, bool bf, float (&x)[16]) {
    if (bf) {
#pragma unroll
        for (int j = 0; j < 2; ++j) { x[8 * j] = bflo(r.v[j].x); x[8 * j + 1] = bfhi(r.v[j].x); x[8 * j + 2] = bflo(r.v[j].y); x[8 * j + 3] = bfhi(r.v[j].y);
            x[8 * j + 4] = bflo(r.v[j].z); x[8 * j + 5] = bfhi(r.v[j].z); x[8 * j + 6] = bflo(r.v[j].w); x[8 * j + 7] = bfhi(r.v[j].w); }
    } else {
#pragma unroll
        for (int k = 0; k < 4; ++k) { x[4 * k] = __uint_as_float(r.v[k].x); x[4 * k + 1] = __uint_as_float(r.v[k].y); x[4 * k + 2] = __uint_as_float(r.v[k].z); x[4 * k + 3] = __uint_as_float(r.v[k].w); }
    }
}
__device__ __forceinline__ void st_row_f32(float* p, const float (&x)[16], int lane) {
#pragma unroll
    for (int j = 0; j < 2; ++j) { *(f32x4*)(p + 8 * lane + 512 * j) = (f32x4){x[8 * j], x[8 * j + 1], x[8 * j + 2], x[8 * j + 3]};
                                  *(f32x4*)(p + 8 * lane + 512 * j + 4) = (f32x4){x[8 * j + 4], x[8 * j + 5], x[8 * j + 6], x[8 * j + 7]}; }
}
__device__ __forceinline__ void p1_norm(Frame& F, const Args& A, int l, const float* xsrc, const float* csrc) {
    const int gw = F.vcu * 8 + F.wave, NGW = F.G * 8, lane = F.lane;
    const float* gpre = A.in[I_GMPRE] + l * D; const float* mod = (const float*)(F.ws + WS_MOD) + (size_t)l * 9 * NMOD;
    bf16_t* hx = (bf16_t*)(F.ws + WS_HX);
    const int rpw = (MT + NGW - 1) / NGW, r0 = gw * rpw, r1 = min(r0 + rpw, MT);
    if (r0 >= r1) return;
    float PA[16], PS[16]; int cur_bi = -1;
    RowF32 cur, nxt;
    ld_row_f32(cur, r0 < MX ? xsrc + (size_t)r0 * D : csrc + (size_t)(r0 - MX) * D, lane);
    for (int row = r0; row < r1; ++row) {
        if (row + 1 < r1) { const int rn = row + 1; ld_row_f32(nxt, rn < MX ? xsrc + (size_t)rn * D : csrc + (size_t)(rn - MX) * D, lane); }
        const int bi = row < MX ? (row >> 13) : 8;
        if (bi != cur_bi) { cur_bi = bi; const float* mb = mod + (size_t)bi * NMOD; float g_[16], sc[16]; ld_vec16(g_, gpre, lane); ld_vec16(sc, mb + D, lane); ld_vec16(PS, mb, lane);
#pragma unroll
            for (int k = 0; k < 16; ++k) PA[k] = g_[k] * (1.0f + sc[k]); }
        float ss = 0.f;
#pragma unroll
        for (int k = 0; k < 4; ++k) ss += cur.v[k][0] * cur.v[k][0] + cur.v[k][1] * cur.v[k][1] + cur.v[k][2] * cur.v[k][2] + cur.v[k][3] * cur.v[k][3];
        const float rstd = rsqrtf(wave_sum(ss) * (1.0f / D) + RMS_EPS);
        float h[16];
#pragma unroll
        for (int k = 0; k < 4; ++k)
#pragma unroll
            for (int q = 0; q < 4; ++q) h[4 * k + q] = cur.v[k][q] * rstd * PA[4 * k + q] + PS[4 * k + q];
        st_row_bf16(hx + (size_t)row * D, h, lane);
        cur = nxt;
    }
}

constexpr int L_U = 0, L_X = 33792, L_SF = 67072, L_SR = 84480, L_TT = 101888;
__device__ __forceinline__ void s5_mfma(Frame& F, int l, bool wctx) {
    const int tid = F.tid, lane = F.lane, wave = F.wave, c = lane & 15, q = lane >> 4;
    LAS unsigned char* lds = F.lds;
    LAS float* Xs = (LAS float*)(lds + L_X);
    const bf16_t* Us5 = (const bf16_t*)(F.ws + WS_R1 + R1_US5);
    bf16_t* Yg = (bf16_t*)(F.ws + WS_R1 + R1_YG);
    for (int bg = F.vcu; bg < NB * NG; bg += F.G) {
        const int b = bg / NG, g = bg % NG;
        const unsigned char* W = F.ws + WS_S5W + (size_t)(l * NG + g) * S5W_STRIDE;
        const unsigned char* useq = (const unsigned char*)(Us5 + (size_t)bg * NSEQ * 16);
        unsigned char* srs = F.ws + WS_R2 + (size_t)bg * (528 * 256);
        for (int x = tid; x < 31 * 16 * 2; x += 512) { const int row = x >> 1, half = x & 1; *(LAS u32x4*)(lds + L_TT + row * 48 + half * 16) = *(const u32x4*)(W + S5_OFF_TT + row * 32 + half * 16); }
        bf16x8 Bw[8];
#pragma unroll
        for (int kk = 0; kk < 8; ++kk) Bw[kk] = *(const bf16x8*)(W + (S5_OFF_WSR + (wave * 8 + kk) * 1024) + (unsigned)lane * 16u);
        f32x2 a16 = ((const f32x2*)(W + S5_OFF_A16))[64 + lane];
        float sre = 0.f, sim = 0.f;
        u32x4 pu[4];
#pragma unroll
        for (int k = 0; k < 4; ++k) { const int x = tid + 512 * k; if (x < 16 * 32) pu[k] = *(const u32x4*)(useq + 8192 * k + (unsigned)tid * 16u); }
#pragma nounroll
        for (int mbi = 0; mbi < 9; ++mbi) {
            const int mb = (mbi == 0) ? 0 : 9 - mbi;
            const int c0 = (mb == 0) ? 0 : 16 + 64 * (mb - 1), nch = (mb == 0) ? 16 : 64, nmt = nch >> 4;
#pragma unroll
            for (int k = 0; k < 4; ++k) { const int x = tid + 512 * k; if (x < nch * 32) *(LAS u32x4*)(lds + L_U + (x >> 5) * 528 + (x & 31) * 16) = pu[k]; }
            if (mbi < 8) { const int c0n = 16 + 64 * (7 - mbi);
#pragma unroll
                for (int k = 0; k < 4; ++k) pu[k] = *(const u32x4*)(useq + (c0n * 512 + 8192 * k) + (unsigned)tid * 16u); }
            __syncthreads();
#pragma nounroll
            for (int mt = 0; mt < nmt; ++mt) {
                f32x4 acc = (f32x4){0.f, 0.f, 0.f, 0.f};
#pragma unroll
                for (int kk = 0; kk < 8; ++kk) { const bf16x8 Af = *(const LAS bf16x8*)(lds + L_U + (16 * mt + c) * 528 + kk * 64 + q * 16); acc = __builtin_amdgcn_mfma_f32_16x16x32_bf16(Af, Bw[kk], acc, 0, 0, 0);
                    if ((kk & 3) == 3) asm volatile("" ::: "memory"); }
#pragma unroll
                for (int jj = 0; jj < 4; ++jj) Xs[(16 * mt + 4 * q + jj) * 130 + 16 * wave + c] = acc[jj];
            }
            __syncthreads();
            if (wave == 0) {
                for (int cb = nch - 4; cb >= 0; cb -= 4) { f32x2 xv[4];
#pragma unroll
                    for (int k = 0; k < 4; ++k) xv[k] = *(const LAS f32x2*)(Xs + (cb + k) * 130 + 2 * lane);
#pragma unroll
                    for (int k = 3; k >= 0; --k) { *(LAS unsigned*)(lds + L_SR + (cb + k) * 272 + lane * 4) = pk2(sre, sim);
                        const float nr = a16.x * sre - a16.y * sim + xv[k].x, ni = a16.x * sim + a16.y * sre + xv[k].y; sre = nr; sim = ni; } }
            }
            __syncthreads();
            for (int x = tid; x < nch * 16; x += 512) *(u32x4*)(srs + c0 * 256 + (unsigned)x * 16u) = *(const LAS u32x4*)(lds + L_SR + (x >> 4) * 272 + (x & 15) * 16);
            __syncthreads();
        }
        __threadfence(); __syncthreads(); __builtin_amdgcn_fence(__ATOMIC_ACQUIRE, "agent");
        const int tidF = launder(tid), laneF = tidF & 63, cF = laneF & 15, qF = laneF >> 4;
#pragma unroll
        for (int kk = 0; kk < 8; ++kk) Bw[kk] = *(const bf16x8*)(W + (S5_OFF_WSF + (wave * 8 + kk) * 1024) + (unsigned)laneF * 16u);
        a16 = ((const f32x2*)(W + S5_OFF_A16))[laneF];
        sre = 0.f; sim = 0.f;
        u32x4 ps[2];
#pragma unroll
        for (int k = 0; k < 4; ++k) { const int x = tidF + 512 * k; if (x < 16 * 32) pu[k] = *(const u32x4*)(useq + 8192 * k + (unsigned)tidF * 16u); }
#pragma unroll
        for (int k = 0; k < 2; ++k) { const int x = tidF + 512 * k; if (x < 16 * 16) ps[k] = *(const u32x4*)(srs + 8192 * k + (unsigned)tidF * 16u); }
#pragma nounroll
        for (int mb = 0; mb < 9; ++mb) {
            const int c0 = (mb == 0) ? 0 : 16 + 64 * (mb - 1), nch = (mb == 0) ? 16 : 64, nmt = nch >> 4;
#pragma unroll
            for (int k = 0; k < 4; ++k) { const int x = tidF + 512 * k; if (x < nch * 32) *(LAS u32x4*)(lds + L_U + (x >> 5) * 528 + (x & 31) * 16) = pu[k]; }
#pragma unroll
            for (int k = 0; k < 2; ++k) { const int x = tidF + 512 * k; if (x < nch * 16) *(LAS u32x4*)(lds + L_SR + (x >> 4) * 272 + (x & 15) * 16) = ps[k]; }
            if (mb < 8) { const int c0n = 16 + 64 * mb;
#pragma unroll
                for (int k = 0; k < 4; ++k) pu[k] = *(const u32x4*)(useq + (c0n * 512 + 8192 * k) + (unsigned)tidF * 16u);
#pragma unroll
                for (int k = 0; k < 2; ++k) ps[k] = *(const u32x4*)(srs + (c0n * 256 + 8192 * k) + (unsigned)tidF * 16u); }
            __syncthreads();
#pragma nounroll
            for (int mt = 0; mt < nmt; ++mt) {
                f32x4 acc = (f32x4){0.f, 0.f, 0.f, 0.f};
#pragma unroll
                for (int kk = 0; kk < 8; ++kk) { const bf16x8 Af = *(const LAS bf16x8*)(lds + L_U + (16 * mt + cF) * 528 + kk * 64 + qF * 16); acc = __builtin_amdgcn_mfma_f32_16x16x32_bf16(Af, Bw[kk], acc, 0, 0, 0);
                    if ((kk & 3) == 3) asm volatile("" ::: "memory"); }
#pragma unroll
                for (int jj = 0; jj < 4; ++jj) Xs[(16 * mt + 4 * qF + jj) * 130 + 16 * wave + cF] = acc[jj];
            }
            __syncthreads();
            if (wave == 0) {
                for (int cb = 0; cb < nch; cb += 4) { f32x2 xv[4];
#pragma unroll
                    for (int k = 0; k < 4; ++k) xv[k] = *(const LAS f32x2*)(Xs + (cb + k) * 130 + 2 * laneF);
#pragma unroll
                    for (int k = 0; k < 4; ++k) { *(LAS unsigned*)(lds + L_SF + (cb + k) * 272 + laneF * 4) = pk2(sre, sim);
                        const float nr = a16.x * sre - a16.y * sim + xv[k].x, ni = a16.x * sim + a16.y * sre + xv[k].y; sre = nr; sim = ni; } }
            }
            __syncthreads();
            if (mb > 0 || wctx) {
                f32x4 acc[4][2];
#pragma unroll
                for (int mt = 0; mt < 4; ++mt) { acc[mt][0] = (f32x4){0.f, 0.f, 0.f, 0.f}; acc[mt][1] = acc[mt][0]; }
#pragma unroll
                for (int kk = 0; kk < 8; ++kk) {
                    bf16x8 Tf[2];
#pragma unroll
                    for (int e = 0; e < 2; ++e) { const int dl = (2 * wave + e) - 2 * kk - (qF >> 1); Tf[e] = *(const LAS bf16x8*)(lds + L_TT + ((dl + 15) * 16 + cF) * 48 + (qF & 1) * 16); }
#pragma unroll
                    for (int mt = 0; mt < 4; ++mt) if (mt < nmt) { const bf16x8 Af = *(const LAS bf16x8*)(lds + L_U + (16 * mt + cF) * 528 + kk * 64 + qF * 16);
                        acc[mt][0] = __builtin_amdgcn_mfma_f32_16x16x32_bf16(Tf[0], Af, acc[mt][0], 0, 0, 0); acc[mt][1] = __builtin_amdgcn_mfma_f32_16x16x32_bf16(Tf[1], Af, acc[mt][1], 0, 0, 0); }
                    asm volatile("" ::: "memory"); }
#pragma unroll
                for (int dir = 0; dir < 2; ++dir) {
                    bf16x8 Bs[2][4];
#pragma unroll
                    for (int e = 0; e < 2; ++e)
#pragma unroll
                        for (int kk = 0; kk < 4; ++kk) Bs[e][kk] = *(const bf16x8*)(W + ((dir ? S5_OFF_WOR : S5_OFF_WOF) + ((2 * wave + e) * 4 + kk) * 1024) + (unsigned)laneF * 16u);
#pragma unroll
                    for (int kk = 0; kk < 4; ++kk) {
#pragma unroll
                        for (int mt = 0; mt < 4; ++mt) if (mt < nmt) { const bf16x8 Sx = *(const LAS bf16x8*)(lds + (dir ? L_SR : L_SF) + (16 * mt + cF) * 272 + kk * 64 + qF * 16);
#pragma unroll
                            for (int e = 0; e < 2; ++e) acc[mt][e] = __builtin_amdgcn_mfma_f32_16x16x32_bf16(Bs[e][kk], Sx, acc[mt][e], 0, 0, 0); }
                        asm volatile("" ::: "memory"); }
                }
#pragma unroll
                for (int mt = 0; mt < 4; ++mt) if (mt < nmt) {
#pragma unroll
                    for (int e = 0; e < 2; ++e) { const int n = (c0 + 16 * mt + cF) * 16 + 2 * wave + e;
                        const int row = (n < LC) ? (MX + b * LC + n) : (b * T + (n - LC));
                        u32x2 w; w.x = pk2(gelu_tanh(acc[mt][e][0]), gelu_tanh(acc[mt][e][1])); w.y = pk2(gelu_tanh(acc[mt][e][2]), gelu_tanh(acc[mt][e][3]));
                        *(u32x2*)(Yg + (size_t)row * 512 + g * 16 + 4 * qF) = w; } }
            }
            __syncthreads();
        }
    }
}
__device__ __forceinline__ void add8(float (&s)[8], const u32x4& x, float w) {
    s[0] += w * bflo(x.x); s[1] += w * bfhi(x.x); s[2] += w * bflo(x.y); s[3] += w * bfhi(x.y); s[4] += w * bflo(x.z); s[5] += w * bfhi(x.z); s[6] += w * bflo(x.w); s[7] += w * bfhi(x.w);
}
template <bool SUBV>
__device__ __forceinline__ void pool_line(const bf16_t* src, const bf16_t* vsub, bf16_t* dst, size_t stride, int n, int p0, int hw) {
    float s[8];
#pragma unroll
    for (int k = 0; k < 8; ++k) s[k] = 0.f;
    {
        u32x4 x[16];
#pragma unroll
        for (int k = 0; k < 16; ++k) { const int pos = p0 - 8 + k; x[k] = *(const u32x4*)(src + (size_t)min(max(pos, 0), n - 1) * stride); }
#pragma unroll
        for (int k = 0; k < 16; ++k) { const int pos = p0 - 8 + k; const bool in = pos >= max(p0 - hw, 0) && pos < min(p0 + hw, n); add8(s, x[k], in ? 1.0f : 0.0f); }
    }
#pragma nounroll
    for (int pb = p0; pb < p0 + 32; pb += 4) {
        u32x4 xa[4], xs[4], xv[4];
#pragma unroll
        for (int k = 0; k < 4; ++k) { const int p = pb + k; xa[k] = *(const u32x4*)(src + (size_t)min(p + hw, n - 1) * stride); xs[k] = *(const u32x4*)(src + (size_t)max(p - hw, 0) * stride);
            if (SUBV) xv[k] = *(const u32x4*)(vsub + (size_t)p * stride); }
#pragma unroll
        for (int k = 0; k < 4; ++k) { const int p = pb + k;
            const float inv = 1.0f / (float)(min(p + hw, n) - max(p - hw, 0));
            float o[8];
#pragma unroll
            for (int j = 0; j < 8; ++j) o[j] = s[j] * inv;
            if (SUBV) add8(o, xv[k], -1.0f);
            u32x4 w; w.x = pk2(o[0], o[1]); w.y = pk2(o[2], o[3]); w.z = pk2(o[4], o[5]); w.w = pk2(o[6], o[7]);
            *(u32x4*)(dst + (size_t)p * stride) = w;
            add8(s, xa[k], (p + hw < n) ? 1.0f : 0.0f); add8(s, xs[k], (p - hw >= 0) ? -1.0f : 0.0f); }
    }
}
constexpr size_t R2_HV = 64 * MiB;
__device__ __forceinline__ void pool_v(Frame& F) {
    const int gw = F.vcu * 8 + F.wave, NGW = F.G * 8, lane = F.lane, hw = 1 << (lane >> 4);
    const bf16_t* Vp = (const bf16_t*)(F.ws + WS_R1 + R1_VP);
    bf16_t* Hv = (bf16_t*)(F.ws + WS_R2 + R2_HV);
    for (int it = gw; it < NB * 64 * 4; it += NGW) {
        const int rq = it & 3, c = (it >> 2) & 63, b = it >> 8;
        const size_t base = ((size_t)(b * T + c)) * 512 + 8 * lane;
        pool_line<false>(Vp + base, nullptr, Hv + base, (size_t)64 * 512, 128, rq * 32, hw);
    }
}
__device__ __forceinline__ void pool_h(Frame& F, bool with_ctx) {
    const int gw = F.vcu * 8 + F.wave, NGW = F.G * 8, lane = F.lane, hw = 1 << (lane >> 4);
    const bf16_t* Vp = (const bf16_t*)(F.ws + WS_R1 + R1_VP);
    const bf16_t* Hv = (const bf16_t*)(F.ws + WS_R2 + R2_HV);
    bf16_t* Z = (bf16_t*)(F.ws + WS_R1 + R1_Z);
    const int nx = NB * 128 * 2, ntask = nx + (with_ctx ? NB * 8 : 0);
    for (int it = gw; it < ntask; it += NGW) {
        if (it < nx) { const int ch = it & 1, r = (it >> 1) & 127, b = it >> 8; const size_t base = ((size_t)(b * T + r * 64)) * 512 + 8 * lane;
            pool_line<true>(Hv + base, Vp + base, Z + base, 512, 64, ch * 32, hw); }
        else { const int j = it - nx, lq = j & 7, b = j >> 3; const size_t base = ((size_t)(MX + b * LC)) * 512 + 8 * lane;
            pool_line<true>(Vp + base, Vp + base, Z + base, 512, LC, lq * 32, hw); }
    }
}

__device__ __forceinline__ float xor4f(float x) { return dppx<0x1B>(dppx<0x141>(x)); }
__device__ __forceinline__ float xor8f(float x) { return dppx<0x128>(x); }
__device__ __forceinline__ void swap32(float& a, float& b) { const auto r = __builtin_amdgcn_permlane32_swap(__float_as_uint(a), __float_as_uint(b), false, false); a = __uint_as_float(r[0]); b = __uint_as_float(r[1]); }
__device__ __forceinline__ void swap16(float& a, float& b) { const auto r = __builtin_amdgcn_permlane16_swap(__float_as_uint(a), __float_as_uint(b), false, false); a = __uint_as_float(r[0]); b = __uint_as_float(r[1]); }
__device__ __forceinline__ float reduce16(float (&v)[16], int lane) {
#pragma unroll
    for (int i = 0; i < 8; ++i) { float a = v[i], b = v[i + 8]; swap32(a, b); v[i] = a + b; }
#pragma unroll
    for (int i = 0; i < 4; ++i) { float a = v[i], b = v[i + 4]; swap16(a, b); v[i] = a + b; }
#pragma unroll
    for (int i = 0; i < 2; ++i) { const float send = (lane & 8) ? v[i] : v[i + 2], keep = (lane & 8) ? v[i + 2] : v[i]; v[i] = keep + xor8f(send); }
    { const float send = (lane & 4) ? v[0] : v[1], keep = (lane & 4) ? v[1] : v[0]; v[0] = keep + xor4f(send); }
    v[0] += dppx<0x4E>(v[0]); v[0] += dppx<0xB1>(v[0]);
    return v[0];
}
__device__ __forceinline__ float max_idx16(float m) {
    m = fmaxf(m, xor4f(m)); m = fmaxf(m, xor8f(m));
    { float a = m, b = m; swap16(a, b); m = fmaxf(a, b); }
    { float a = m, b = m; swap32(a, b); m = fmaxf(a, b); }
    return m;
}
__device__ __forceinline__ float sum_idx16(float x) {
    x += xor4f(x); x += xor8f(x);
    { float a = x, b = x; swap16(a, b); x = a + b; }
    { float a = x, b = x; swap32(a, b); x = a + b; }
    return x;
}
struct Row6 { u32x4 m[2]; RowRaw x; };
constexpr int P6_WB = 0, P6_HT = 65536, P6_HSTR = 2064, P6_RED = P6_HT + 2 * 16 * P6_HSTR;
static_assert(P6_RED + 8192 <= MISC_OFF, "P6 LDS map");
__device__ __forceinline__ void p6_rows(Frame& F, const Args& A, int l, const float* xf32, const float* csrc, float* cdst, bool with_ctx) {
    bf16_t* XB = (bf16_t*)(F.ws + WS_XB); const bool xbf = (l != 0);
    const int lane = F.lane, wave = F.wave;
    LAS unsigned char* lds = F.lds;
    { const float* wrt = (const float*)(F.ws + WS_WRT) + (size_t)l * 16 * 1024;
      for (int i = F.tid; i < 32 * 64; i += 512) { const int kk = i >> 6, ln = i & 63, e = ln & 15, q = ln >> 4; const float* wp = wrt + e * 1024 + 32 * kk + 8 * q;
          const f32x4 w0 = *(const f32x4*)wp, w1 = *(const f32x4*)(wp + 4); float hi[8], lo[8];
#pragma unroll
          for (int j = 0; j < 4; ++j) { hi[j] = __uint_as_float(f2bf(w0[j]) << 16); lo[j] = w0[j] - hi[j]; hi[4 + j] = __uint_as_float(f2bf(w1[j]) << 16); lo[4 + j] = w1[j] - hi[4 + j]; }
          u32x4 h, lw; h.x = pk2(hi[0], hi[1]); h.y = pk2(hi[2], hi[3]); h.z = pk2(hi[4], hi[5]); h.w = pk2(hi[6], hi[7]);
          lw.x = pk2(lo[0], lo[1]); lw.y = pk2(lo[2], lo[3]); lw.z = pk2(lo[4], lo[5]); lw.w = pk2(lo[6], lo[7]);
          *(LAS u32x4*)(lds + P6_WB + i * 16) = h; *(LAS u32x4*)(lds + P6_WB + 32768 + i * 16) = lw; } }
    __syncthreads();
    const float* gpost = A.in[I_GMPOST] + l * D; const float* gpre = A.in[I_GFPRE] + l * D;
    const float* mod = (const float*)(F.ws + WS_MOD) + (size_t)l * 9 * NMOD;
    const bf16_t* mix = (const bf16_t*)(F.ws + WS_R1);
    unsigned char* hx8 = (unsigned char*)(F.ws + WS_HX);
    float* aff = (float*)(F.ws + WS_AFF); float* affc = (float*)(F.ws + WS_AFFC);
    const int nrows = with_ctx ? MT : MX;
    const int rpb = ((nrows + F.G - 1) / F.G + 1) & ~1;
    const int R0 = F.vcu * rpb, R1 = min(R0 + rpb, nrows);
#define LD_ROW6(dstv, rr) do { const int _r = (rr); _Pragma("unroll") for (int _j = 0; _j < 2; ++_j) (dstv).m[_j] = *(const u32x4*)(mix + (size_t)_r * D + 8 * lane + 512 * _j); \
        if (_r < MX) ld_row_raw((dstv).x, xbf ? (const void*)(XB + (size_t)_r * D) : (const void*)(xf32 + (size_t)_r * D), xbf, lane); else ld_row_raw((dstv).x, csrc + (size_t)(_r - MX) * D, false, lane); } while (0)
#define BI_OF(rr) (((rr) < MX) ? ((rr) >> 13) : 8)
    float PA1[16], PA2[16], PS2[16]; int cur_bi = -1;
    Row6 raw[2];
    if (R0 + 2 * wave < R1) { LD_ROW6(raw[0], R0 + 2 * wave); LD_ROW6(raw[1], R0 + 2 * wave + 1); }
#pragma nounroll
    for (int g0 = R0; g0 < R1; g0 += 16) {
        const int ra = g0 + 2 * wave; const bool act = ra < R1;
        if (act) {
            const int bi = BI_OF(ra); const bool isx = ra < MX;
            if (bi != cur_bi) { cur_bi = bi; const float* mb = mod + (size_t)bi * NMOD; float t0[16], t1[16];
                ld_vec16(t0, gpost, lane); ld_vec16(t1, mb + 2 * D, lane);
#pragma unroll
                for (int k = 0; k < 16; ++k) PA1[k] = t0[k] * t1[k];
                ld_vec16(t0, gpre, lane); ld_vec16(t1, mb + 4 * D, lane); ld_vec16(PS2, mb + 3 * D, lane);
#pragma unroll
                for (int k = 0; k < 16; ++k) PA2[k] = t0[k] * (1.0f + t1[k]); }
#pragma unroll
            for (int r = 0; r < 2; ++r) {
                const int rw = ra + r;
                float mv[16], xv[16];
#pragma unroll
                for (int j = 0; j < 2; ++j) { mv[8 * j] = bflo(raw[r].m[j].x); mv[8 * j + 1] = bfhi(raw[r].m[j].x); mv[8 * j + 2] = bflo(raw[r].m[j].y); mv[8 * j + 3] = bfhi(raw[r].m[j].y);
                    mv[8 * j + 4] = bflo(raw[r].m[j].z); mv[8 * j + 5] = bfhi(raw[r].m[j].z); mv[8 * j + 6] = bflo(raw[r].m[j].w); mv[8 * j + 7] = bfhi(raw[r].m[j].w); }
                float ss = 0.f;
#pragma unroll
                for (int k = 0; k < 16; ++k) ss += mv[k] * mv[k];
                const float rstd = rsqrtf(wave_sum(ss) * (1.0f / D) + RMS_EPS);
                float ss2 = 0.f;
                row_to_f32(raw[r].x, isx && xbf, xv);
#pragma unroll
                for (int k = 0; k < 16; ++k) { const float v = xv[k] + mv[k] * rstd * PA1[k]; xv[k] = v; ss2 += v * v; }
                if (isx) st_row_bf16(XB + (size_t)rw * D, xv, lane); else st_row_f32(cdst + (size_t)(rw - MX) * D, xv, lane);
                const float rstd2 = rsqrtf(wave_sum(ss2) * (1.0f / D) + RMS_EPS);
#pragma unroll
                for (int k = 0; k < 16; ++k) xv[k] = xv[k] * rstd2 * PA2[k] + PS2[k];
#pragma unroll
                for (int j = 0; j < 2; ++j) { u32x2 w; w.x = pk4_fp8(xv[8 * j], xv[8 * j + 1], xv[8 * j + 2], xv[8 * j + 3]); w.y = pk4_fp8(xv[8 * j + 4], xv[8 * j + 5], xv[8 * j + 6], xv[8 * j + 7]);
                    *(u32x2*)(hx8 + (size_t)rw * D + 8 * lane + 512 * j) = w; }
                LAS unsigned char* hrow = lds + P6_HT + (2 * wave + r) * P6_HSTR + lane * 16;
#pragma unroll
                for (int j = 0; j < 2; ++j) { u32x4 h, lw; float lo[8];
                    h.x = pk2(xv[8 * j], xv[8 * j + 1]); h.y = pk2(xv[8 * j + 2], xv[8 * j + 3]); h.z = pk2(xv[8 * j + 4], xv[8 * j + 5]); h.w = pk2(xv[8 * j + 6], xv[8 * j + 7]);
                    lo[0] = xv[8 * j] - bflo(h.x); lo[1] = xv[8 * j + 1] - bfhi(h.x); lo[2] = xv[8 * j + 2] - bflo(h.y); lo[3] = xv[8 * j + 3] - bfhi(h.y);
                    lo[4] = xv[8 * j + 4] - bflo(h.z); lo[5] = xv[8 * j + 5] - bfhi(h.z); lo[6] = xv[8 * j + 6] - bflo(h.w); lo[7] = xv[8 * j + 7] - bfhi(h.w);
                    lw.x = pk2(lo[0], lo[1]); lw.y = pk2(lo[2], lo[3]); lw.z = pk2(lo[4], lo[5]); lw.w = pk2(lo[6], lo[7]);
                    *(LAS u32x4*)(hrow + j * 1024) = h; *(LAS u32x4*)(hrow + 16 * P6_HSTR + j * 1024) = lw; }
            }
            if (ra + 16 < R1) { LD_ROW6(raw[0], ra + 16); LD_ROW6(raw[1], ra + 17); }
        }
        __syncthreads();
        {
            f32x4 acc = (f32x4){0.f, 0.f, 0.f, 0.f};
            const int r16 = lane & 15, q = lane >> 4;
#pragma unroll
            for (int k4 = 0; k4 < 4; ++k4) { const int kk = 4 * wave + k4;
                const bf16x8 ah = *(const LAS bf16x8*)(lds + P6_HT + r16 * P6_HSTR + kk * 64 + q * 16), al = *(const LAS bf16x8*)(lds + P6_HT + 16 * P6_HSTR + r16 * P6_HSTR + kk * 64 + q * 16);
                const bf16x8 bh = *(const LAS bf16x8*)(lds + P6_WB + (kk * 64 + lane) * 16), bl = *(const LAS bf16x8*)(lds + P6_WB + 32768 + (kk * 64 + lane) * 16);
                acc = __builtin_amdgcn_mfma_f32_16x16x32_bf16(ah, bh, acc, 0, 0, 0);
                acc = __builtin_amdgcn_mfma_f32_16x16x32_bf16(al, bh, acc, 0, 0, 0);
                acc = __builtin_amdgcn_mfma_f32_16x16x32_bf16(ah, bl, acc, 0, 0, 0); }
            LAS float* red = (LAS float*)(lds + P6_RED) + wave * 256;
#pragma unroll
            for (int jj = 0; jj < 4; ++jj) red[(4 * q + jj) * 16 + r16] = acc[jj];
        }
        __syncthreads();
        if (act) {
            const int rr = 2 * wave + (lane >> 5), e = lane & 15, rw = g0 + rr;
            const LAS float* red = (const LAS float*)(lds + P6_RED) + rr * 16 + e;
            float lg = 0.f;
#pragma unroll
            for (int w8 = 0; w8 < 8; ++w8) lg += red[w8 * 256];
            float mx = lg; mx = fmaxf(mx, dppx<0xB1>(mx)); mx = fmaxf(mx, dppx<0x4E>(mx)); mx = fmaxf(mx, xor4f(mx)); mx = fmaxf(mx, xor8f(mx));
            const float ex = __expf(lg - mx); float se = ex; se += dppx<0xB1>(se); se += dppx<0x4E>(se); se += xor4f(se); se += xor8f(se);
            if ((lane & 16) == 0) {
                const float av = ex * __builtin_amdgcn_rcpf(se);
                if (rw < MX) aff[((size_t)((rw >> 13) * 16 + e)) * T + (rw & (T - 1))] = av;
                else { const int rc = rw - MX, b = rc >> 8, p = rc & 255; affc[((size_t)(e * 8 + b)) * LC + p] = av; }
            }
        }
    }
#undef LD_ROW6
#undef BI_OF
}

template <int CTRL> __device__ __forceinline__ int dppi(int v) { return __builtin_amdgcn_update_dpp(0, v, CTRL, 0xF, 0xF, false); }
__device__ __forceinline__ int block_sum_i(int v, LAS int* red, int wave, int lane, int& parity) {
    v += dppi<0xB1>(v); v += dppi<0x4E>(v); v += dppi<0x141>(v); v += dppi<0x140>(v);
    v = (__builtin_amdgcn_readlane(v, 0) + __builtin_amdgcn_readlane(v, 16)) + (__builtin_amdgcn_readlane(v, 32) + __builtin_amdgcn_readlane(v, 48));
    LAS int* r = red + 8 * parity; parity ^= 1;
    if (lane == 0) r[wave] = v;
    __syncthreads();
    const i32x4 a = *(const LAS i32x4*)r, b = *(const LAS i32x4*)(r + 4);
    return (a[0] + a[1]) + (a[2] + a[3]) + (b[0] + b[1]) + (b[2] + b[3]);
}
__device__ __forceinline__ void p7_topk(Frame& F, bool with_ctx) {
    LAS int* red = (LAS int*)F.lds;
    LAS int* wtot = (LAS int*)(F.lds + 64);
    int par = 0;
    const float* aff = (const float*)(F.ws + WS_AFF); const float* affc = (const float*)(F.ws + WS_AFFC);
    int* seli = (int*)(F.ws + WS_SELI); float* selg = (float*)(F.ws + WS_SELG); int* inv = (int*)(F.ws + WS_INV);
    const int nprob = with_ctx ? 256 : 128;
    for (int q = F.vcu; q < nprob; q += F.G) {
        const float* src; int n, cap, pbase, rbase, e;
        if (q < 128) { src = aff + (size_t)q * T; n = T; cap = CAPX; pbase = q * CAPX; rbase = (q >> 4) * T; e = q & 15; }
        else { const int qq = q - 128; src = affc + (size_t)qq * LC; n = LC; cap = CAPC; pbase = PX + qq * CAPC; rbase = MX + (qq & 7) * LC; e = qq >> 3; }
        const int t0 = F.tid * 16;
        unsigned key[16]; const bool valid = t0 < n;
#pragma unroll
        for (int i = 0; i < 16; ++i) key[i] = 0u;
        if (valid) {
#pragma unroll
            for (int i4 = 0; i4 < 4; ++i4) { const f32x4 v = *(const f32x4*)(src + t0 + 4 * i4);
#pragma unroll
                for (int j = 0; j < 4; ++j) key[i4 * 4 + j] = __float_as_uint(v[j]); }
        }
        unsigned cur = 0u;
        {
            constexpr unsigned KMIN = 0x2F800000u;
            LAS int* hist = (LAS int*)(F.lds + 1024); LAS int* ctl = (LAS int*)(F.lds + 128); LAS unsigned* cnd = (LAS unsigned*)(F.lds + 16384);
#pragma unroll
            for (int k = 0; k < 4; ++k) hist[F.tid * 4 + k] = 0;
            if (F.tid < 4) ctl[F.tid] = 0;
            __syncthreads();
            int kb[16];
#pragma unroll
            for (int i = 0; i < 16; ++i) { const unsigned d = key[i] - KMIN; kb[i] = key[i] < KMIN ? 0 : (int)min(d >> 17, 2047u); if (valid) __hip_atomic_fetch_add(hist + kb[i], 1, __ATOMIC_RELAXED, __HIP_MEMORY_SCOPE_WORKGROUP); }
            __syncthreads();
            const int b0 = 4 * (511 - F.tid); const i32x4 hv = *(const LAS i32x4*)(hist + b0);
            const int s4 = (hv[0] + hv[1]) + (hv[2] + hv[3]);
            int incl = s4;
#pragma unroll
            for (int o = 1; o < 64; o <<= 1) { const int y = __shfl_up(incl, o); if (F.lane >= o) incl += y; }
            if (F.lane == 63) wtot[F.wave] = incl;
            __syncthreads();
            int above = incl - s4;
#pragma unroll
            for (int w = 0; w < 8; ++w) above += (w < F.wave) ? wtot[w] : 0;
#pragma unroll
            for (int k = 3; k >= 0; --k) { const int h = hv[k]; if (above < cap && cap <= above + h) { ctl[0] = b0 + k; ctl[1] = above; } above += h; }
            __syncthreads();
            const int bstar = ctl[0], needb = cap - ctl[1];
            if (valid) {
#pragma unroll
                for (int i = 0; i < 16; ++i) if (kb[i] == bstar) { const int pos = __hip_atomic_fetch_add(ctl + 2, 1, __ATOMIC_RELAXED, __HIP_MEMORY_SCOPE_WORKGROUP); cnd[pos] = key[i]; }
            }
            __syncthreads();
            const int nc = ctl[2];
            if (F.wave == 0) {
                unsigned t = 0u;
                for (int bit = 31; bit >= 0; --bit) { const unsigned cand = t | (1u << bit); int c = 0;
                    for (int j = F.lane; j < nc; j += 64) c += (cnd[j] >= cand) ? 1 : 0;
                    c += dppi<0xB1>(c); c += dppi<0x4E>(c); c += dppi<0x141>(c); c += dppi<0x140>(c);
                    c = (__builtin_amdgcn_readlane(c, 0) + __builtin_amdgcn_readlane(c, 16)) + (__builtin_amdgcn_readlane(c, 32) + __builtin_amdgcn_readlane(c, 48));
                    if (c >= needb) t = cand; }
                if (F.lane == 0) ctl[3] = (int)t; }
            __syncthreads();
            cur = (unsigned)ctl[3];
        }
        int cg = 0, ce = 0;
#pragma unroll
        for (int i = 0; i < 16; ++i) { cg += (key[i] > cur) ? 1 : 0; ce += (valid && key[i] == cur) ? 1 : 0; }
        const int ngt = block_sum_i(cg, red, F.wave, F.lane, par);
        const int need = cap - ngt;
        int x = cg | (ce << 16);
        int incl = x;
#pragma unroll
        for (int o = 1; o < 64; o <<= 1) { const int y = __shfl_up(incl, o); if (F.lane >= o) incl += y; }
        __syncthreads();
        if (F.lane == 63) wtot[F.wave] = incl;
        __syncthreads();
        int wpre = 0;
#pragma unroll
        for (int w = 0; w < 8; ++w) wpre += (w < F.wave) ? wtot[w] : 0;
        const int excl = wpre + incl - x;
        int pg = excl & 0xffff, pe = excl >> 16;
        if (valid) {
#pragma unroll
            for (int i = 0; i < 16; ++i) {
                const bool gt = key[i] > cur, eq = key[i] == cur;
                const bool sel = gt || (eq && pe < need);
                const int slot = pg + min(pe, need);
                const int trow = rbase + t0 + i;
                if (sel) { seli[pbase + slot] = trow; selg[pbase + slot] = __uint_as_float(key[i]); inv[(size_t)trow * 16 + e] = pbase + slot; }
                else inv[(size_t)trow * 16 + e] = -1;
                pg += gt ? 1 : 0; pe += eq ? 1 : 0;
            }
        }
        __syncthreads();
    }
}

__device__ __forceinline__ void p8a_gather(Frame& F, bool with_ctx) {
    const int gw = F.vcu * 8 + F.wave, NGW = F.G * 8, lane = F.lane;
    const int* seli = (const int*)(F.ws + WS_SELI);
    const bf16_t* hx2 = (const bf16_t*)(F.ws + WS_HX); bf16_t* Xg = (bf16_t*)(F.ws + WS_R2);
    const int np = with_ctx ? PT : PX;
    for (int pr = gw; pr < np; pr += NGW) {
        const int tr = seli[pr];
        const u32x4* s = (const u32x4*)(hx2 + (size_t)tr * D); u32x4* d = (u32x4*)(Xg + (size_t)pr * D);
        const u32x4 a = s[lane], b = s[lane + 64]; d[lane] = a; d[lane + 64] = b;
    }
}

__device__ __forceinline__ void p10_combine(Frame& F, const Args& A, int l, float* xout, float* cio, bool with_ctx) {
    bf16_t* XB = (bf16_t*)(F.ws + WS_XB);
#define LD_ROW10(dstv, rr) do { const int _r = (rr); if (_r < MX) ld_row_raw(dstv, XB + (size_t)_r * D, true, lane); else ld_row_raw(dstv, cio + (size_t)(_r - MX) * D, false, lane); } while (0)
    const int gw = F.vcu * 8 + F.wave, NGW = F.G * 8, lane = F.lane;
    const int* inv = (const int*)(F.ws + WS_INV); const unsigned char* Yd = (const unsigned char*)(F.ws + WS_R2); const float* selg = (const float*)(F.ws + WS_SELG);
    const float* gpost = A.in[I_GFPOST] + l * D; const float* mod = (const float*)(F.ws + WS_MOD) + (size_t)l * 9 * NMOD;
    const float* gpre1 = A.in[I_GMPRE] + D;
    bf16_t* hx = (bf16_t*)(F.ws + WS_HX);
    const int nrows = with_ctx ? MT : MX;
    const int rpw = (nrows + NGW - 1) / NGW, r0 = gw * rpw, r1 = min(r0 + rpw, nrows);
    if (r0 >= r1) return;
    float PA3[16], PA4[16], PS4[16]; int cur_bi = -1;
    RowRaw cur, nxt; int cinv, ninv = -1;
    LD_ROW10(cur, r0);
    cinv = (lane < 16) ? inv[(size_t)r0 * 16 + lane] : -1;
    for (int row = r0; row < r1; ++row) {
        if (row + 1 < r1) { const int rn = row + 1; LD_ROW10(nxt, rn); ninv = (lane < 16) ? inv[(size_t)rn * 16 + lane] : -1; }
        const bool isx = row < MX;
        const int bi = isx ? (row >> 13) : 8;
        if (bi != cur_bi) { cur_bi = bi; const float* mb = mod + (size_t)bi * NMOD; float t0[16], t1[16];
            ld_vec16(t0, gpost, lane); ld_vec16(t1, mb + 5 * D, lane);
#pragma unroll
            for (int k = 0; k < 16; ++k) PA3[k] = t0[k] * t1[k];
            if (l == 0) { const float* mb1 = mb + (size_t)9 * NMOD; ld_vec16(t0, gpre1, lane); ld_vec16(t1, mb1 + D, lane); ld_vec16(PS4, mb1, lane);
#pragma unroll
                for (int k = 0; k < 16; ++k) PA4[k] = t0[k] * (1.0f + t1[k]); } }
        float acc[16];
#pragma unroll
        for (int k = 0; k < 16; ++k) acc[k] = 0.f;
        unsigned long long bm = __ballot(cinv >= 0);
        while (bm) {
            int pr[4]; float wgt[4];
#pragma unroll
            for (int k = 0; k < 4; ++k) { if (bm) { const int e = __builtin_ctzll(bm); bm &= bm - 1; pr[k] = __builtin_amdgcn_readlane(cinv, e); wgt[k] = selg[pr[k]] * (1.0f / pg8::YD_SCALE); } else { pr[k] = 0; wgt[k] = 0.f; } }
            u32x2 y[4][2];
#pragma unroll
            for (int k = 0; k < 4; ++k)
#pragma unroll
                for (int j = 0; j < 2; ++j) y[k][j] = *(const u32x2*)(Yd + (size_t)pr[k] * D + 8 * lane + 512 * j);
#pragma unroll
            for (int k = 0; k < 4; ++k)
#pragma unroll
                for (int j = 0; j < 2; ++j) { const f32x2 v0 = __builtin_amdgcn_cvt_pk_f32_fp8((int)y[k][j].x, false), v1 = __builtin_amdgcn_cvt_pk_f32_fp8((int)y[k][j].x, true),
                                                          v2 = __builtin_amdgcn_cvt_pk_f32_fp8((int)y[k][j].y, false), v3 = __builtin_amdgcn_cvt_pk_f32_fp8((int)y[k][j].y, true);
                    acc[8 * j] += wgt[k] * v0.x; acc[8 * j + 1] += wgt[k] * v0.y; acc[8 * j + 2] += wgt[k] * v1.x; acc[8 * j + 3] += wgt[k] * v1.y;
                    acc[8 * j + 4] += wgt[k] * v2.x; acc[8 * j + 5] += wgt[k] * v2.y; acc[8 * j + 6] += wgt[k] * v3.x; acc[8 * j + 7] += wgt[k] * v3.y; }
        }
        float ss = 0.f;
#pragma unroll
        for (int k = 0; k < 16; ++k) ss += acc[k] * acc[k];
        const float rstd = rsqrtf(wave_sum(ss) * (1.0f / D) + RMS_EPS);
        float s3 = 0.f, x1[16];
        row_to_f32(cur, isx, x1);
#pragma unroll
        for (int k = 0; k < 16; ++k) { const float v = x1[k] + acc[k] * rstd * PA3[k]; acc[k] = v; s3 += v * v; }
        if (!isx) st_row_f32(cio + (size_t)(row - MX) * D, acc, lane);
        else if (l == 0) st_row_bf16(XB + (size_t)row * D, acc, lane);
        else st_row_f32(xout + (size_t)row * D, acc, lane);
        if (l == 0) {
            const float rstd3 = rsqrtf(wave_sum(s3) * (1.0f / D) + RMS_EPS);
#pragma unroll
            for (int k = 0; k < 16; ++k) acc[k] = acc[k] * rstd3 * PA4[k] + PS4[k];
            st_row_bf16(hx + (size_t)row * D, acc, lane);
        }
        cur = nxt; cinv = ninv;
    }
#undef LD_ROW10
}

constexpr int NPL = 11, NPHASE = 1 + 2 * NPL;
#ifndef LB2
#define LB2 2
#endif
__global__ void __launch_bounds__(512, LB2) fwd(Args args) {
    extern __shared__ __attribute__((aligned(16))) unsigned char lds_raw[];
    Frame F;
    F.lds = (LAS unsigned char*)lds_raw;
    F.tid = threadIdx.x; F.lane = F.tid & 63; F.wave = __builtin_amdgcn_readfirstlane(F.tid >> 6);
    F.G = gridDim.x; { const int bx = blockIdx.x; F.vcu = (F.G % 8 == 0) ? (bx % 8) * (F.G / 8) + bx / 8 : bx; }
    F.out = args.out; F.ws = args.ws;
    volatile LAS unsigned* MISC = (volatile LAS unsigned*)(F.lds + MISC_OFF);
    for (int u = F.tid; u < 64; u += 512) ((LAS unsigned*)(F.lds + MISC_OFF))[u] = 0u;
    __syncthreads();
    const int lo = args.ph_lo, hi = args.ph_hi;
    const bool multi = (hi - lo) > 1;
    XcdBarrier bar; bar.bar = (unsigned*)(F.ws + WS_CTL) + 4096; bar.x = 0; bar.st = MISC + 8;
    if (multi) bar = xcd_barrier_post((unsigned*)(F.ws + WS_CTL) + 4096, MISC + 8);
#ifndef PH_MASK
#define PH_MASK 0xFFFFFFFFu
#endif
#define IN(k) (lo <= (k) && (k) < hi)
#define EN(j) ((PH_MASK >> (j)) & 1u)
#ifndef DUP_MASK
#define DUP_MASK 0u
#endif
#define REPS(j) ((((unsigned)DUP_MASK >> (j)) & 1u) ? 2 : 1)
#define FRESH() do { F.tid = launder((int)threadIdx.x); F.lane = F.tid & 63; } while (0)
#define SEAM(k) do { if (multi && IN((k) + 1)) xcd_barrier(bar); } while (0)

    if (EN(0) && IN(0)) { FRESH();
#pragma nounroll
        for (int rep = 0; rep < REPS(0); ++rep) p0_prologue(F, args);
        SEAM(0);
#ifdef XBAR
        if (multi) for (int q = 0; q < XBAR; ++q) xcd_barrier(bar);
#endif
        }

    bf16_t* HX = (bf16_t*)(F.ws + WS_HX);
    float* CTXS = (float*)(F.ws + WS_CTXS);
#pragma nounroll
    for (int l = 0; l < 2; ++l) {
        const int pb = 1 + l * NPL;
        const bool wctx = (l == 0);
        const float* xsrc = args.in[I_X];
        const float* csrc = (l == 0) ? args.in[I_CTX] : CTXS;
        if (EN(1) && IN(pb + 0)) { FRESH();
#pragma nounroll
            for (int rep = 0; rep < REPS(1); ++rep) if (l == 0) p1_norm(F, args, l, xsrc, csrc);
            if (l == 0) SEAM(pb + 0); }
        if (EN(2) && IN(pb + 1)) { FRESH();
            pg8::AddrPlain g{HX, (const bf16_t*)(F.ws + WS_WIN) + (size_t)l * D * D, D};
            pg8::LinOrder S{(MT / 256) * 4, 4, F.G, F.vcu};
            pg8::EpiWin E{(bf16_t*)(F.ws + WS_R1 + R1_US5), (bf16_t*)(F.ws + WS_R1 + R1_VP)};

#pragma nounroll
            for (int rep = 0; rep < REPS(2); ++rep) pg8::gemm_phase(F.lds + STAGE_OFF, g, S, E);
            SEAM(pb + 1);
        }
        if (EN(3) && IN(pb + 2)) { FRESH();
#pragma nounroll
            for (int rep = 0; rep < REPS(3); ++rep) { s5_mfma(F, l, wctx); pool_v(F); }
            SEAM(pb + 2); }
        if (EN(4) && IN(pb + 3)) { FRESH();
#pragma nounroll
            for (int rep = 0; rep < REPS(4); ++rep) pool_h(F, wctx);
            SEAM(pb + 3); }
        if (EN(5) && IN(pb + 4)) { FRESH();
            const int mrows = wctx ? MT : MX;
            { pg8::AddrMid g{(const bf16_t*)(F.ws + WS_R1 + R1_YG), (const bf16_t*)(F.ws + WS_R1 + R1_Z), (const bf16_t*)(F.ws + WS_WGLU) + (size_t)l * DS5 * DS5, (const bf16_t*)(F.ws + WS_WPOOL) + (size_t)l * 512 * 512, 512};
              pg8::MidOrder S{(mrows / 256) * 4, F.G, F.vcu};
              pg8::EpiMid E{(const bf16_t*)(F.ws + WS_R1 + R1_YG), args.in[I_POOLS] + l * 512, HX};
#pragma nounroll
              for (int rep = 0; rep < REPS(5); ++rep) pg8::gemm_phase(F.lds + STAGE_OFF, g, S, E); }
            SEAM(pb + 4);
        }
        if (EN(6) && IN(pb + 5)) { FRESH();
            const int mrows = wctx ? MT : MX;
            pg8::AddrPlain g{HX, (const bf16_t*)(F.ws + WS_WOUT) + (size_t)l * D * D, D};
            pg8::LinOrder S{(mrows / 256) * 4, 4, F.G, F.vcu};
            pg8::EpiPlain E{(bf16_t*)(F.ws + WS_R1), D};

#pragma nounroll
            for (int rep = 0; rep < REPS(6); ++rep) pg8::gemm_phase(F.lds + STAGE_OFF, g, S, E);
            SEAM(pb + 5);
        }
        if (EN(7) && IN(pb + 6)) { FRESH();
#pragma nounroll
            for (int rep = 0; rep < ((l == 0) ? REPS(7) : 1); ++rep) p6_rows(F, args, l, xsrc, csrc, CTXS, wctx);
            SEAM(pb + 6); }
        if (EN(8) && IN(pb + 7)) { FRESH();
#pragma nounroll
            for (int rep = 0; rep < REPS(8); ++rep) p7_topk(F, wctx);
            SEAM(pb + 7); }
        if (EN(9) && IN(pb + 8)) { FRESH();
            const int ptiles = (wctx ? PT : PX) / 256;
            pg8::AddrMoEGather g{(const unsigned char*)(F.ws + WS_HX), (const int*)(F.ws + WS_SELI), (const unsigned char*)(F.ws + WS_WGU) + (size_t)l * 16 * 2048 * D, (size_t)2048 * D, D / 2};
            pg8::LinOrder S{ptiles * 8, 8, F.G, F.vcu};
            pg8::EpiSwiglu E{(unsigned char*)(F.ws + WS_R1)};

#pragma nounroll
            for (int rep = 0; rep < REPS(9); ++rep) pg8::gemm_phase(F.lds + STAGE_OFF, g, S, E);
            SEAM(pb + 8);
        }
        if (EN(10) && IN(pb + 9)) { FRESH();
            const int ptiles = (wctx ? PT : PX) / 256;
            pg8::AddrMoEGatherH g{(const unsigned char*)(F.ws + WS_R1), (const int*)(F.ws + WS_IDENT), (const unsigned char*)(F.ws + WS_WD) + (size_t)l * 16 * D * D, (size_t)D * D, D / 2};
            pg8::LinOrder S{ptiles * 4, 4, F.G, F.vcu};
            pg8::EpiYd8 E{(unsigned char*)(F.ws + WS_R2)};

#pragma nounroll
            for (int rep = 0; rep < REPS(10); ++rep) pg8::gemm_phase(F.lds + STAGE_OFF, g, S, E);
            SEAM(pb + 9);
        }
        if (EN(11) && IN(pb + 10)) { FRESH();
#pragma nounroll
            for (int rep = 0; rep < ((l == 1) ? REPS(11) : 1); ++rep) p10_combine(F, args, l, F.out, CTXS, wctx);
            SEAM(pb + 10); }
    }
#undef IN
#undef SEAM
}

#ifndef MK_ONE_LAUNCH
#define MK_ONE_LAUNCH 1
#endif
extern "C" void kernel_launch(void* const* d_in, const int* in_sizes, int n_in, void* d_out, int out_size, void* d_ws, size_t ws_size, hipStream_t stream) {
    static int grid = 0;
    if (grid == 0) {
        if (n_in != 27 || out_size != MX * D || ws_size < WS_END) { fprintf(stderr, "kernel_launch: unexpected shapes (n_in %d out %d ws %zu)\n", n_in, out_size, ws_size); grid = -1; return; }
        int dev = 0, cus = 0, per_cu = 0;
        if (hipGetDevice(&dev) != hipSuccess || hipDeviceGetAttribute(&cus, hipDeviceAttributeMultiprocessorCount, dev) != hipSuccess) { grid = -1; return; }
        if (hipFuncSetAttribute((const void*)fwd, hipFuncAttributeMaxDynamicSharedMemorySize, LDS_BYTES) != hipSuccess) { fprintf(stderr, "kernel_launch: hipFuncSetAttribute failed\n"); grid = -1; return; }
        if (hipOccupancyMaxActiveBlocksPerMultiprocessor(&per_cu, (const void*)fwd, 512, LDS_BYTES) != hipSuccess || per_cu < 1) fprintf(stderr, "kernel_launch: occupancy query says %d\n", per_cu);
        (void)hipGetLastError();
        grid = cus;
    }
    if (grid < 0) return;
    (void)hipMemsetAsync((char*)d_ws + WS_CTL, 0, CTL_ZERO_BYTES, stream);
    Args a{};
    for (int i = 0; i < 27; ++i) a.in[i] = (const float*)d_in[i];
    a.out = (float*)d_out; a.ws = (unsigned char*)d_ws;
#if MK_ONE_LAUNCH
    a.ph_lo = 0; a.ph_hi = NPHASE;
    hipLaunchKernelGGL(fwd, dim3(grid), dim3(512), LDS_BYTES, stream, a);
#else
    for (int p = 0; p < NPHASE; ++p) { a.ph_lo = p; a.ph_hi = p + 1; hipLaunchKernelGGL(fwd, dim3(grid), dim3(512), LDS_BYTES, stream, a); }
#endif
}
```

```cpp
#include <hip/hip_runtime.h>
#include <cstdio>
#include <cstdint>

#define GAS __attribute__((address_space(1)))
#define LAS __attribute__((address_space(3)))
typedef unsigned short bf16_t;
typedef short bf16x8 __attribute__((ext_vector_type(8)));
typedef float f32x4 __attribute__((ext_vector_type(4)));
typedef float f32x2 __attribute__((ext_vector_type(2)));
typedef unsigned u32x4 __attribute__((ext_vector_type(4)));
typedef unsigned u32x2 __attribute__((ext_vector_type(2)));
typedef int i32x4 __attribute__((ext_vector_type(4)));
typedef int i32x8 __attribute__((ext_vector_type(8)));

constexpr int D = 1024, NB = 8, T = 8192, LC = 256;
constexpr int MX = NB * T, MC = NB * LC, MT = MX + MC;
constexpr int NE = 16, CAPX = 1024, CAPC = 32;
constexpr int PX = NB * NE * CAPX, PC = NE * NB * CAPC, PT = PX + PC;
constexpr int NSEQ = LC + T;
constexpr int DS5 = 512, NG = 32, SH = 16, SP = 64;
constexpr float RMS_EPS = 1e-6f;
constexpr int NMOD = 6 * D;

constexpr size_t MiB = 1u << 20;
constexpr size_t WS_CTL = 0, CTL_ZERO_BYTES = 1 * MiB;
constexpr size_t WS_MOD = 1 * MiB;
constexpr size_t WS_AFF = 2 * MiB;
constexpr size_t WS_AFFC = 6 * MiB;
constexpr size_t WS_SELI = 7 * MiB;
constexpr size_t WS_SELG = 8 * MiB;
constexpr size_t WS_INV = 9 * MiB;
constexpr size_t WS_WRT = 14 * MiB;
constexpr size_t WS_IDENT = 15 * MiB;
constexpr size_t WS_CTXS = 16 * MiB;
constexpr size_t WS_WIN = 24 * MiB;
constexpr size_t WS_WOUT = 28 * MiB;
constexpr size_t WS_WGLU = 32 * MiB;
constexpr size_t WS_WPOOL = 33 * MiB;
constexpr size_t WS_WGU = 34 * MiB;
constexpr size_t WS_WD = 98 * MiB;
constexpr size_t WS_XB = 130 * MiB;
constexpr size_t WS_HX = 262 * MiB;
constexpr size_t WS_R1 = 394 * MiB;
constexpr size_t WS_R2 = 658 * MiB;
constexpr size_t WS_S5W = 922 * MiB;
constexpr size_t S5W_STRIDE = 288 * 1024;
constexpr int S5_OFF_WSF = 0, S5_OFF_WSR = 65536, S5_OFF_WOF = 131072, S5_OFF_WOR = 196608, S5_OFF_TT = 262144, S5_OFF_A16 = 262144 + 16384;
constexpr size_t WS_END = 940 * MiB;
constexpr size_t R1_US5 = 0, R1_VP = 66 * MiB, R1_YG = 132 * MiB, R1_Z = 198 * MiB;

constexpr int LDS_BYTES = 147456;
constexpr int STAGE_OFF = 0, LDSCTL_OFF = 131072, MISC_OFF = LDS_BYTES - 256;

__device__ __forceinline__ unsigned f2bf(float f) { unsigned u = __float_as_uint(f); return (u + 0x7fffu + ((u >> 16) & 1u)) >> 16; }
__device__ __forceinline__ unsigned pk2(float lo, float hi) { unsigned r; asm("v_cvt_pk_bf16_f32 %0, %1, %2" : "=v"(r) : "v"(lo), "v"(hi)); return r; }
__device__ __forceinline__ float bflo(unsigned w) { return __uint_as_float(w << 16); }
__device__ __forceinline__ float bfhi(unsigned w) { return __uint_as_float(w & 0xffff0000u); }
template <int CTRL> __device__ __forceinline__ float dppx(float v) { return __int_as_float(__builtin_amdgcn_update_dpp(0, __float_as_int(v), CTRL, 0xF, 0xF, false)); }
__device__ __forceinline__ float wave_sum(float v) {
    v += dppx<0xB1>(v); v += dppx<0x4E>(v); v += dppx<0x141>(v); v += dppx<0x140>(v);
    const int vi = __float_as_int(v);
    return (__int_as_float(__builtin_amdgcn_readlane(vi, 0)) + __int_as_float(__builtin_amdgcn_readlane(vi, 16))) + (__int_as_float(__builtin_amdgcn_readlane(vi, 32)) + __int_as_float(__builtin_amdgcn_readlane(vi, 48)));
}
__device__ __forceinline__ unsigned pk4_fp8(float a, float b, float c, float d) {
    a = __builtin_amdgcn_fmed3f(a, -448.f, 448.f); b = __builtin_amdgcn_fmed3f(b, -448.f, 448.f); c = __builtin_amdgcn_fmed3f(c, -448.f, 448.f); d = __builtin_amdgcn_fmed3f(d, -448.f, 448.f);
    int w = 0; w = __builtin_amdgcn_cvt_pk_fp8_f32(a, b, w, false); w = __builtin_amdgcn_cvt_pk_fp8_f32(c, d, w, true); return (unsigned)w; }
constexpr float W8_SCALE = 256.f, H8_SCALE = 4.f;
constexpr int SC_ONE = 0x7f7f7f7f, SC_W8 = 0x77777777, SC_H8 = 0x7d7d7d7d;
__device__ __forceinline__ float sigmoidf_(float x) { return __builtin_amdgcn_rcpf(1.0f + __builtin_amdgcn_exp2f(-1.4426950408889634f * x)); }
__device__ __forceinline__ float gelu_tanh(float x) { const float u2 = 1.5957691216057308f * (x + 0.044715f * x * x * x); return x * __builtin_amdgcn_rcpf(1.0f + __builtin_amdgcn_exp2f(-1.4426950408889634f * u2)); }

__device__ __forceinline__ int launder(int v) { asm volatile("" : "+v"(v)); return v; }
__device__ __forceinline__ int launder_s(int v) { asm volatile("" : "+s"(v)); return v; }

#define XB_TMO      128
#define XB_XCNT(j)  (256  + 64 * (j))
#define XB_XSUB(j)  (1280 + 64 * (j))
#define XB_XGEN(j)  (2304 + 64 * (j))
#define XB_TOP      3328
#define XB_TOPGEN   3392
#define XCD_BAR_WORDS 3456
#define XB_SPIN_CAP (1u << 18)

__device__ __forceinline__ unsigned xb_ld(unsigned* p)              { return __hip_atomic_load(p, __ATOMIC_RELAXED, __HIP_MEMORY_SCOPE_AGENT); }
__device__ __forceinline__ unsigned xb_add(unsigned* p, unsigned v) { return __hip_atomic_fetch_add(p, v, __ATOMIC_RELAXED, __HIP_MEMORY_SCOPE_AGENT); }
__device__ __forceinline__ unsigned xb_xcc_id() { return (unsigned)__builtin_amdgcn_s_getreg((3 << 11) | 20) & 0xFu; }
#define XB_SPIN(cond, bar) do { unsigned _sp = 0; while (cond) { __builtin_amdgcn_s_sleep(1); \
    if ((++_sp & 255u) == 0u) { if (xb_ld(&(bar)[XB_TMO])) break; if (_sp > XB_SPIN_CAP) { atomicAdd(&(bar)[XB_TMO], 1u); break; } } } } while (0)

struct XcdBarrier { unsigned* bar; unsigned x; volatile LAS unsigned* st; };

__device__ __forceinline__ XcdBarrier xcd_barrier_post(unsigned* bar, volatile LAS unsigned* st) {
    XcdBarrier b; b.bar = bar; b.x = xb_xcc_id(); b.st = st;
    if (threadIdx.x == 0) (void)xb_add(&bar[XB_XCNT(b.x)], 1u);
    return b;
}
__device__ __forceinline__ void xcd_barrier_complete(unsigned* bar, unsigned x, unsigned& nloc, unsigned& nx) {
    const unsigned G = gridDim.x * gridDim.y * gridDim.z;
    unsigned sum, cnt, mine, sp = 0u;
    for (;;) {
        sum = 0u; cnt = 0u; mine = 0u;
#pragma unroll
        for (unsigned j = 0; j < 16; ++j) { const unsigned c = xb_ld(&bar[XB_XCNT(j)]); sum += c; cnt += (c > 0u) ? 1u : 0u; mine = (j == x) ? c : mine; }
        if (sum == G) break;
        __builtin_amdgcn_s_sleep(1);
        if ((++sp & 255u) == 0u) { if (xb_ld(&bar[XB_TMO])) break; if (sp > XB_SPIN_CAP) { atomicAdd(&bar[XB_TMO], 1u); break; } }
    }
    nloc = mine > 0u ? mine : 1u; nx = cnt > 0u ? cnt : 1u;
}
__device__ __forceinline__ void xcd_barrier(const XcdBarrier& b) {
    asm volatile("s_waitcnt vmcnt(0)" ::: "memory");
    __syncthreads();
    if (threadIdx.x == 0) {
        unsigned* bar = b.bar;
        __builtin_amdgcn_s_waitcnt(0);
        unsigned nloc = b.st[0], nx = b.st[1];
        if (nloc == 0u) { xcd_barrier_complete(bar, b.x, nloc, nx); b.st[0] = nloc; b.st[1] = nx; }
        const unsigned old = xb_add(&bar[XB_XSUB(b.x)], 1u);
        const unsigned gen = old / nloc;
        if (old + 1u == (gen + 1u) * nloc) {
            __builtin_amdgcn_fence(__ATOMIC_RELEASE, "agent");
            asm volatile("s_waitcnt vmcnt(0)" ::: "memory");
            const unsigned og = xb_add(&bar[XB_TOP], 1u);
            const unsigned tg = og / nx;
            if (og + 1u == (tg + 1u) * nx) xb_add(&bar[XB_TOPGEN], 1u);
            else XB_SPIN(xb_ld(&bar[XB_TOPGEN]) == tg, bar);
            __builtin_amdgcn_fence(__ATOMIC_ACQUIRE, "agent");
            xb_add(&bar[XB_XGEN(b.x)], 1u);
            asm volatile("s_waitcnt vmcnt(0)" ::: "memory");
        } else {
            XB_SPIN(xb_ld(&bar[XB_XGEN(b.x)]) == gen, bar);
            __builtin_amdgcn_fence(__ATOMIC_ACQUIRE, "agent");
            asm volatile("s_waitcnt vmcnt(0)" ::: "memory");
        }
    }
    __syncthreads();
}

namespace pg8 {
constexpr int BM = 256, BK = 64, HALF = 128, HTB = HALF * BK * 2, STAGE_BYTES = 8 * HTB;
__device__ __forceinline__ int lds_byte(int r, int c) { const int st = (r >> 4) * 2 + (c >> 5), rr = r & 15, cc = c & 31, ob = rr * 64 + cc * 2; return st * 1024 + (ob ^ (((ob >> 9) & 1) << 5)); }
__device__ __forceinline__ void stage_rc(int b, int& R, int& C) { const int st = b / 1024, sb = b % 1024, swz = sb ^ (((sb >> 9) & 1) << 5); R = (st >> 1) * 16 + swz / 64; C = (st & 1) * 32 + (swz % 64) / 2; }
__device__ __forceinline__ int perm32(int rho) { const int n = rho >> 4, i = rho & 15; return 8 * (i >> 2) + 4 * n + (i & 3); }
struct Unit { int pm, pn; };
__device__ __forceinline__ unsigned cvt_pk_bf16(float lo, float hi) { unsigned r; asm volatile("v_cvt_pk_bf16_f32 %0, %1, %2" : "=v"(r) : "v"(lo), "v"(hi)); return r; }

struct LinOrder {
    int nunits, nN, G, c;
    __device__ __forceinline__ bool next(int i, Unit& u) const { const long L = (long)i * G + c; if (L >= nunits) return false; u.pn = (int)(L % nN); u.pm = (int)(L / nN); return true; }
    __device__ __forceinline__ void a_ready(const Unit&) const {}
    __device__ __forceinline__ void done(const Unit&) const {}
};
struct AddrPlain {
    static constexpr bool GATHER = false, FP8 = false; static constexpr int SCW = 0, SCW1 = 0, SCX = 0;
    const bf16_t* A; const bf16_t* Bt; int K;
    __device__ __forceinline__ int nt(const Unit&) const { return K / BK; }
    __device__ __forceinline__ const int* idx(const Unit&) const { return nullptr; }
    __device__ __forceinline__ const char* Aof(const Unit& u) const { return (const char*)A + (size_t)u.pm * BM * K * 2; }
    __device__ __forceinline__ const char* Bof(const Unit& u) const { return (const char*)Bt + (size_t)u.pn * BM * K * 2; }
};
struct AddrMoE {
    static constexpr bool GATHER = false, FP8 = true; static constexpr int SCW = SC_W8, SCW1 = SC_W8, SCX = SC_H8;
    const unsigned char* A; const unsigned char* W; size_t wstride; int K;
    __device__ __forceinline__ int nt(const Unit&) const { return K / BK; }
    __device__ __forceinline__ const int* idx(const Unit&) const { return nullptr; }
    __device__ __forceinline__ static int expert(int pm) { return pm < (PX / BM) ? ((pm >> 2) & 15) : (pm - PX / BM); }
    __device__ __forceinline__ const char* Aof(const Unit& u) const { return (const char*)A + (size_t)u.pm * BM * K * 2; }
    __device__ __forceinline__ const char* Bof(const Unit& u) const { return (const char*)(W + (size_t)expert(u.pm) * wstride) + (size_t)u.pn * BM * K * 2; }
};
struct AddrMoEGather {
    static constexpr bool GATHER = true, FP8 = true; static constexpr int SCW = SC_W8, SCW1 = 0x79797979  , SCX = SC_ONE;
    const unsigned char* A; const int* sel; const unsigned char* W; size_t wstride; int K;
    __device__ __forceinline__ int nt(const Unit&) const { return K / BK; }
    __device__ __forceinline__ const int* idx(const Unit& u) const { return sel + (size_t)u.pm * BM; }
    __device__ __forceinline__ const char* Aof(const Unit&) const { return (const char*)A; }
    __device__ __forceinline__ const char* Bof(const Unit& u) const { return (const char*)(W + (size_t)AddrMoE::expert(u.pm) * wstride) + (size_t)u.pn * BM * K * 2; }
};

struct AddrMoEGatherH {
    static constexpr bool GATHER = true, FP8 = true; static constexpr int SCW = SC_W8, SCW1 = SC_W8, SCX = 0x81818181  ;
    const unsigned char* A; const int* sel; const unsigned char* W; size_t wstride; int K;
    __device__ __forceinline__ int nt(const Unit&) const { return K / BK; }
    __device__ __forceinline__ const int* idx(const Unit& u) const { return sel + (size_t)u.pm * BM; }
    __device__ __forceinline__ const char* Aof(const Unit&) const { return (const char*)A; }
    __device__ __forceinline__ const char* Bof(const Unit& u) const { return (const char*)(W + (size_t)AddrMoE::expert(u.pm) * wstride) + (size_t)u.pn * BM * K * 2; }
};

struct MidOrder {
    int nunits, G, c;
    __device__ __forceinline__ bool next(int i, Unit& u) const { const long L = (long)i * G + c; if (L >= nunits) return false; u.pn = (int)((L + i) & 3); u.pm = (int)(L >> 2); return true; }
    __device__ __forceinline__ void a_ready(const Unit&) const {}
    __device__ __forceinline__ void done(const Unit&) const {}
};
struct AddrMid {
    static constexpr bool GATHER = false, FP8 = false; static constexpr int SCW = 0, SCW1 = 0, SCX = 0;
    const bf16_t* Yg; const bf16_t* Z; const bf16_t* Wg; const bf16_t* Wp; int K;
    __device__ __forceinline__ int nt(const Unit& u) const { return u.pn < 2 ? 8 : 4; }
    __device__ __forceinline__ const int* idx(const Unit&) const { return nullptr; }
    __device__ __forceinline__ const char* Aof(const Unit& u) const { return u.pn < 2 ? (const char*)(Yg + (size_t)u.pm * BM * 512) : (const char*)(Z + (size_t)u.pm * BM * 512 + 256 * (u.pn - 2)); }
    __device__ __forceinline__ const char* Bof(const Unit& u) const { return u.pn < 2 ? (const char*)(Wg + (size_t)u.pn * BM * 512) : (const char*)(Wp + (size_t)(u.pn - 2) * BM * 512 + 256 * (u.pn - 2)); }
};

template <class Epi, class Sched, class Addr>
__device__ __forceinline__ void gemm_phase(LAS unsigned char* lds, const Addr g, const Sched& S, const Epi& E) {
    const int tid = launder((int)threadIdx.x), wid = __builtin_amdgcn_readfirstlane(tid >> 6), lane = tid & 63, wr = wid >> 2, wc = wid & 3, fr = lane & 15, fq = lane >> 4;
    const int K = g.K;
    unsigned vA[2][2], voffB[2];
    const size_t kstep = (size_t)(BK * 2);
    const size_t hstep = (size_t)HALF * K * 2;
    LAS int* idxl = (LAS int*)(lds + 131072 + 1024);
#pragma unroll
    for (int i = 0; i < 2; ++i) { int R, C; stage_rc(tid * 16 + i * 8192, R, C); const int Rb = ((R & ~31) + perm32(R & 31));
        vA[0][i] = (unsigned)(R * K + C) * 2u; vA[1][i] = vA[0][i] + (unsigned)hstep; voffB[i] = (unsigned)(Rb * K + C) * 2u; }
    const unsigned ldsw = (unsigned)wid * 1024u;
    const int aoff = lds_byte(wr * 64 + fr, fq * 8), boff = lds_byte(wc * 32 + fr, fq * 8);
#define PG8_SA(b, h) (((b) * 2 + (h)) * HTB)
#define PG8_SB(b, h) ((4 + (b) * 2 + (h)) * HTB)
#define PG8_STAGE(bufoff, gbase, voff) do { _Pragma("unroll") for (int _i = 0; _i < 2; ++_i) \
        __builtin_amdgcn_global_load_lds((const unsigned*)((const char*)(gbase) + (voff)[_i]), (LAS unsigned*)(lds + (bufoff) + ldsw + _i * 8192), 16, 0, 0); } while (0)
#define PG8_LDA(dst, b, h) do { _Pragma("unroll") for (int m = 0; m < 4; ++m) _Pragma("unroll") for (int k = 0; k < 2; ++k) dst[m][k] = *(const LAS bf16x8*)(lds + PG8_SA(b, h) + aoff + m * 2048 + k * 1024); } while (0)
#define PG8_LDB(dst, b, h) do { _Pragma("unroll") for (int n = 0; n < 2; ++n) _Pragma("unroll") for (int k = 0; k < 2; ++k) dst[n][k] = *(const LAS bf16x8*)(lds + PG8_SB(b, h) + boff + n * 2048 + k * 1024); } while (0)
#define PG8_MMA(ai, bj, At, Bt) do { __builtin_amdgcn_s_setprio(1); _Pragma("unroll") for (int m = 0; m < 4; ++m) _Pragma("unroll") for (int n = 0; n < 2; ++n) { \
        if constexpr (Addr::FP8) { const i32x4 b0 = __builtin_bit_cast(i32x4, Bt[n][0]), b1 = __builtin_bit_cast(i32x4, Bt[n][1]), a0 = __builtin_bit_cast(i32x4, At[m][0]), a1 = __builtin_bit_cast(i32x4, At[m][1]); \
            acc[ai][bj][m][n] = __builtin_amdgcn_mfma_scale_f32_16x16x128_f8f6f4(__builtin_shufflevector(b0, b1, 0, 1, 2, 3, 4, 5, 6, 7), __builtin_shufflevector(a0, a1, 0, 1, 2, 3, 4, 5, 6, 7), acc[ai][bj][m][n], 0, 0, 0, (bj) ? Addr::SCW1 : Addr::SCW, 0, Addr::SCX); } \
        else { _Pragma("unroll") for (int k = 0; k < 2; ++k) acc[ai][bj][m][n] = __builtin_amdgcn_mfma_f32_16x16x32_bf16(Bt[n][k], At[m][k], acc[ai][bj][m][n], 0, 0, 0); } } \
        __builtin_amdgcn_s_setprio(0); } while (0)
#define PG8_WAIT_V(n) asm volatile("s_waitcnt vmcnt(" #n ")" ::: "memory")
#define PG8_WAIT_L(n) asm volatile("s_waitcnt lgkmcnt(" #n ")" ::: "memory")
#define PG8_BAR __builtin_amdgcn_s_barrier()
#define PG8_SCHED __builtin_amdgcn_sched_barrier(0)
    Unit cur, nxt; int ui = 0;
    if (!S.next(0, cur)) return;
    f32x4 acc[2][2][4][2];
#pragma unroll
    for (int a = 0; a < 2; ++a)
#pragma unroll
        for (int b = 0; b < 2; ++b)
#pragma unroll
            for (int m = 0; m < 4; ++m)
#pragma unroll
                for (int n = 0; n < 2; ++n) acc[a][b][m][n] = (f32x4){0.f, 0.f, 0.f, 0.f};
    bf16x8 At[4][2], B0[2][2], B1[2][2];
    const char* cA = g.Aof(cur); const char* cB = g.Bof(cur);
    int nt = g.nt(cur);
    S.a_ready(cur);
    if constexpr (Addr::GATHER) { const int* ip = g.idx(cur);
#pragma unroll
        for (int i = 0; i < 2; ++i) { int R, C; stage_rc(tid * 16 + i * 8192, R, C);
#pragma unroll
            for (int h = 0; h < 2; ++h) vA[h][i] = (unsigned)ip[h * HALF + R] * (unsigned)(K * 2) + (unsigned)(C * 2); }
        Unit n1; if (S.next(1, n1) && wid == 0) __builtin_amdgcn_global_load_lds((const unsigned*)(g.idx(n1) + lane * 4), (LAS unsigned*)idxl, 16, 0, 0); }
    PG8_STAGE(PG8_SB(0, 0), cB, voffB); PG8_STAGE(PG8_SA(0, 0), cA, vA[0]); PG8_STAGE(PG8_SB(0, 1), cB + hstep, voffB); PG8_STAGE(PG8_SA(0, 1), cA, vA[1]);
    if (wr == 1) PG8_BAR;
    PG8_WAIT_V(4); PG8_BAR;
    PG8_STAGE(PG8_SB(1, 0), cB + kstep, voffB); PG8_STAGE(PG8_SA(1, 0), cA + kstep, vA[0]); PG8_STAGE(PG8_SB(1, 1), cB + hstep + kstep, voffB);
    PG8_WAIT_V(6); PG8_BAR;
    for (;;) {
        const bool has_next = S.next(ui + 1, nxt);
        const char* nA = has_next ? g.Aof(nxt) : cA; const char* nB = has_next ? g.Bof(nxt) : cB;
        for (int t = 0; t < nt; t += 2) {
            const bool last = (t == nt - 2);
            const char* a1 = cA + (size_t)(t + 1) * kstep;
            const char* a2 = last ? nA : cA + (size_t)(t + 2) * kstep; const char* b2 = last ? nB : cB + (size_t)(t + 2) * kstep;
            const char* a3 = a2 + kstep; const char* b3 = b2 + kstep;
            if (last && has_next) S.a_ready(nxt);
            PG8_LDB(B0, 0, 0); PG8_SCHED; PG8_LDA(At, 0, 0); PG8_STAGE(PG8_SA(1, 1), a1, vA[1]);
            if constexpr (Addr::GATHER) {
                if (last && has_next) {
#pragma unroll
                    for (int i = 0; i < 2; ++i) { int R, C; stage_rc(tid * 16 + i * 8192, R, C);
#pragma unroll
                        for (int h = 0; h < 2; ++h) vA[h][i] = (unsigned)idxl[h * HALF + R] * (unsigned)(K * 2) + (unsigned)(C * 2); } }
            }
            PG8_WAIT_L(8); PG8_BAR; PG8_WAIT_L(0); PG8_MMA(0, 0, At, B0); PG8_BAR; PG8_SCHED;
            PG8_LDB(B1, 0, 1); PG8_STAGE(PG8_SB(0, 0), b2, voffB);
            PG8_BAR; PG8_WAIT_L(0); PG8_MMA(0, 1, At, B1); PG8_BAR;
            PG8_LDA(At, 0, 1); PG8_STAGE(PG8_SA(0, 0), a2, vA[0]);
            PG8_BAR; PG8_WAIT_L(0); PG8_MMA(1, 0, At, B0); PG8_BAR; PG8_SCHED;
            PG8_STAGE(PG8_SB(0, 1), b2 + hstep, voffB);
            PG8_WAIT_V(6); PG8_BAR; PG8_MMA(1, 1, At, B1); PG8_BAR;
            PG8_LDB(B0, 1, 0); PG8_SCHED; PG8_LDA(At, 1, 0); PG8_STAGE(PG8_SA(0, 1), a2, vA[1]);
            PG8_WAIT_L(8); PG8_BAR; PG8_WAIT_L(0); PG8_MMA(0, 0, At, B0); PG8_BAR; PG8_SCHED;
            PG8_LDB(B1, 1, 1); PG8_STAGE(PG8_SB(1, 0), b3, voffB);
            PG8_BAR; PG8_WAIT_L(0); PG8_MMA(0, 1, At, B1); PG8_BAR;
            PG8_LDA(At, 1, 1); PG8_STAGE(PG8_SA(1, 0), a3, vA[0]);
            PG8_BAR; PG8_WAIT_L(0); PG8_MMA(1, 0, At, B0); PG8_BAR; PG8_SCHED;
            PG8_STAGE(PG8_SB(1, 1), b3 + hstep, voffB);
            PG8_WAIT_V(6); PG8_BAR; PG8_MMA(1, 1, At, B1); PG8_BAR;
        }
        E(acc, cur, wr, wc, fr, fq); S.done(cur);
        if (!has_next) break;
        if constexpr (Addr::GATHER) { Unit n2; if (S.next(ui + 2, n2) && wid == 0) __builtin_amdgcn_global_load_lds((const unsigned*)(g.idx(n2) + lane * 4), (LAS unsigned*)idxl, 16, 0, 0); }
#pragma unroll
        for (int a = 0; a < 2; ++a)
#pragma unroll
            for (int b = 0; b < 2; ++b)
#pragma unroll
                for (int m = 0; m < 4; ++m)
#pragma unroll
                    for (int n = 0; n < 2; ++n) acc[a][b][m][n] = (f32x4){0.f, 0.f, 0.f, 0.f};
        cur = nxt; cA = nA; cB = nB; ++ui; nt = g.nt(cur);
    }
    PG8_WAIT_V(0);
    if (wr == 0) PG8_BAR;
    PG8_BAR;
#undef PG8_SA
#undef PG8_SB
#undef PG8_STAGE
#undef PG8_LDA
#undef PG8_LDB
#undef PG8_MMA
#undef PG8_WAIT_V
#undef PG8_WAIT_L
#undef PG8_BAR
#undef PG8_SCHED
}

typedef f32x4 Acc[2][2][4][2];
__device__ __forceinline__ u32x4 pack8(const f32x4& v0, const f32x4& v1) { u32x4 w; w.x = cvt_pk_bf16(v0[0], v0[1]); w.y = cvt_pk_bf16(v0[2], v0[3]); w.z = cvt_pk_bf16(v1[0], v1[1]); w.w = cvt_pk_bf16(v1[2], v1[3]); return w; }

struct EpiPlain {
    bf16_t* O; int ldc;
    __device__ __forceinline__ void operator()(const Acc& acc, const Unit& u, int wr, int wc, int fr, int fq) const {
        const int row0 = u.pm * BM + wr * 64 + fr, col0 = u.pn * BM + wc * 32 + 8 * fq;
#pragma unroll
        for (int ai = 0; ai < 2; ++ai)
#pragma unroll
            for (int m = 0; m < 4; ++m) { bf16_t* rowp = O + (size_t)(row0 + ai * HALF + m * 16) * ldc + col0;
#pragma unroll
                for (int bj = 0; bj < 2; ++bj) *(u32x4*)(rowp + bj * HALF) = pack8(acc[ai][bj][m][0], acc[ai][bj][m][1]); }
    }
};
constexpr float YD_SCALE = 16.f;
struct EpiYd8 {
    unsigned char* O;
    __device__ __forceinline__ void operator()(const Acc& acc, const Unit& u, int wr, int wc, int fr, int fq) const {
        const int row0 = u.pm * BM + wr * 64 + fr, col0 = u.pn * BM + wc * 32 + 8 * fq;
#pragma unroll
        for (int ai = 0; ai < 2; ++ai)
#pragma unroll
            for (int m = 0; m < 4; ++m) { unsigned char* rowp = O + (size_t)(row0 + ai * HALF + m * 16) * 1024 + col0;
#pragma unroll
                for (int bj = 0; bj < 2; ++bj) { const f32x4 a = acc[ai][bj][m][0], b = acc[ai][bj][m][1];
                    u32x2 w; w.x = pk4_fp8(a[0], a[1], a[2], a[3]); w.y = pk4_fp8(b[0], b[1], b[2], b[3]);
                    *(u32x2*)(rowp + bj * HALF) = w; } }
    }
};
struct EpiWin {
    bf16_t* Us5; bf16_t* Vp;
    __device__ __forceinline__ void operator()(const Acc& acc, const Unit& u, int wr, int wc, int fr, int fq) const {
        const int rl = wr * 64 + fr, col0 = u.pn * BM + wc * 32 + 8 * fq;
        if (u.pn < 2) {
            const int b = u.pm < MX / BM ? (u.pm >> 5) : (u.pm - MX / BM), n0 = u.pm < MX / BM ? LC + (u.pm & 31) * BM : 0;
            bf16_t* base = Us5 + ((size_t)b * NG * NSEQ + n0 + rl) * 16;
#pragma unroll
            for (int bj = 0; bj < 2; ++bj) { const int c = col0 + bj * HALF; bf16_t* pb = base + (size_t)(c >> 4) * NSEQ * 16 + (c & 8);
#pragma unroll
                for (int ai = 0; ai < 2; ++ai)
#pragma unroll
                    for (int m = 0; m < 4; ++m) *(u32x4*)(pb + (ai * HALF + m * 16) * 16) = pack8(acc[ai][bj][m][0], acc[ai][bj][m][1]); }
        } else {
            bf16_t* base = Vp + (size_t)(u.pm * BM + rl) * 512 + (col0 - 512);
#pragma unroll
            for (int ai = 0; ai < 2; ++ai)
#pragma unroll
                for (int m = 0; m < 4; ++m)
#pragma unroll
                    for (int bj = 0; bj < 2; ++bj) *(u32x4*)(base + (size_t)(ai * HALF + m * 16) * 512 + bj * HALF) = pack8(acc[ai][bj][m][0], acc[ai][bj][m][1]);
        }
    }
};
struct EpiGlu {
    const bf16_t* Yg; bf16_t* O;
    __device__ __forceinline__ void operator()(const Acc& acc, const Unit& u, int wr, int wc, int fr, int fq) const {
        const int row0 = u.pm * BM + wr * 64 + fr, col0 = u.pn * BM + wc * 32 + 8 * fq;
#pragma unroll
        for (int ai = 0; ai < 2; ++ai)
#pragma unroll
            for (int m = 0; m < 4; ++m) { const int r = row0 + ai * HALF + m * 16;
#pragma unroll
                for (int bj = 0; bj < 2; ++bj) { const int c = col0 + bj * HALF; const u32x4 y = *(const u32x4*)(Yg + (size_t)r * 512 + c);
                    f32x4 v0 = acc[ai][bj][m][0], v1 = acc[ai][bj][m][1];
                    v0[0] = bflo(y.x) * sigmoidf_(v0[0]); v0[1] = bfhi(y.x) * sigmoidf_(v0[1]); v0[2] = bflo(y.y) * sigmoidf_(v0[2]); v0[3] = bfhi(y.y) * sigmoidf_(v0[3]);
                    v1[0] = bflo(y.z) * sigmoidf_(v1[0]); v1[1] = bfhi(y.z) * sigmoidf_(v1[1]); v1[2] = bflo(y.w) * sigmoidf_(v1[2]); v1[3] = bfhi(y.w) * sigmoidf_(v1[3]);
                    *(u32x4*)(O + (size_t)r * 1024 + c) = pack8(v0, v1); } }
    }
};
struct EpiPoolS {
    const float* scale; bf16_t* O;
    __device__ __forceinline__ void operator()(const Acc& acc, const Unit& u, int wr, int wc, int fr, int fq) const {
        const int row0 = u.pm * BM + wr * 64 + fr, col0 = u.pn * BM + wc * 32 + 8 * fq;
        f32x4 s[2][2];
#pragma unroll
        for (int bj = 0; bj < 2; ++bj) { s[bj][0] = *(const f32x4*)(scale + col0 + bj * HALF); s[bj][1] = *(const f32x4*)(scale + col0 + bj * HALF + 4); }
#pragma unroll
        for (int ai = 0; ai < 2; ++ai)
#pragma unroll
            for (int m = 0; m < 4; ++m) { const int r = row0 + ai * HALF + m * 16;
#pragma unroll
                for (int bj = 0; bj < 2; ++bj) { const int c = col0 + bj * HALF;
                    *(u32x4*)(O + (size_t)r * 1024 + 512 + c) = pack8(acc[ai][bj][m][0] * s[bj][0], acc[ai][bj][m][1] * s[bj][1]); } }
    }
};
struct EpiMid {
    const bf16_t* Yg; const float* scale; bf16_t* O;
    __device__ __forceinline__ void operator()(const Acc& acc, const Unit& u, int wr, int wc, int fr, int fq) const {
        if (u.pn < 2) { EpiGlu E{Yg, O}; E(acc, u, wr, wc, fr, fq); }
        else { EpiPoolS E{scale, O}; Unit v = u; v.pn = u.pn - 2; E(acc, v, wr, wc, fr, fq); }
    }
};
struct EpiSwiglu {
    unsigned char* H;
    __device__ __forceinline__ void operator()(const Acc& acc, const Unit& u, int wr, int wc, int fr, int fq) const {
        const int row0 = u.pm * BM + wr * 64 + fr, col0 = u.pn * HALF + wc * 32 + 8 * fq;
#pragma unroll
        for (int ai = 0; ai < 2; ++ai)
#pragma unroll
            for (int m = 0; m < 4; ++m) { const int r = row0 + ai * HALF + m * 16; f32x4 o[2];
#pragma unroll
                for (int n = 0; n < 2; ++n)
#pragma unroll
                    for (int j = 0; j < 4; ++j) { const float a = acc[ai][0][m][n][j], gq = acc[ai][1][m][n][j]; o[n][j] = a * sigmoidf_(a) * gq; }
                u32x2 w; w.x = pk4_fp8(o[0][0], o[0][1], o[0][2], o[0][3]); w.y = pk4_fp8(o[1][0], o[1][1], o[1][2], o[1][3]);
                *(u32x2*)(H + (size_t)r * 1024 + col0) = w; }
    }
};
struct EpiDown {
    const float* gate; bf16_t* O;
    __device__ __forceinline__ void operator()(const Acc& acc, const Unit& u, int wr, int wc, int fr, int fq) const {
        const int row0 = u.pm * BM + wr * 64 + fr, col0 = u.pn * BM + wc * 32 + 8 * fq;
#pragma unroll
        for (int ai = 0; ai < 2; ++ai)
#pragma unroll
            for (int m = 0; m < 4; ++m) { const int r = row0 + ai * HALF + m * 16; const float gt = gate[r];
#pragma unroll
                for (int bj = 0; bj < 2; ++bj) *(u32x4*)(O + (size_t)r * 1024 + col0 + bj * HALF) = pack8(acc[ai][bj][m][0] * gt, acc[ai][bj][m][1] * gt);
                asm volatile("" ::: "memory"); }
    }
};
}

struct Frame {
    LAS unsigned char* lds;
    int tid, lane, wave, vcu, G;
    float* out; unsigned char* ws;
};
struct Args { const float* in[27]; float* out; unsigned char* ws; int ph_lo, ph_hi; };

enum { I_X = 0, I_C, I_CTX, I_CCTX, I_WMOD, I_BMOD, I_GMPRE, I_GMPOST, I_GFPRE, I_GFPOST, I_WIN, I_LRE, I_LIM, I_LDT, I_BRE, I_BIM, I_CRE, I_CIM, I_S5D, I_WGLU, I_POOLW, I_POOLS, I_WOUT, I_WROUTER, I_WGATE, I_WUP, I_WDOWN };

__device__ __forceinline__ void tr_item(const float* W, int ldw, bf16_t* WT, int ldt, int k0, int n0, int drow0, int dk0, LAS float* scr, int lane) {
#pragma unroll 8
    for (int i = 0; i < 32; ++i) { const int kk = 2 * i + (lane >> 5); scr[kk * 33 + (lane & 31)] = __builtin_nontemporal_load(W + (size_t)(k0 + kk) * ldw + n0 + (lane & 31)); }
    asm volatile("s_waitcnt lgkmcnt(0)" ::: "memory");
    const int c = lane & 7;
#pragma unroll
    for (int j = 0; j < 4; ++j) { const int n = (lane >> 3) + 8 * j; const LAS float* s = scr + (8 * c) * 33 + n;
        u32x4 o; o.x = pk2(s[0 * 33], s[1 * 33]); o.y = pk2(s[2 * 33], s[3 * 33]); o.z = pk2(s[4 * 33], s[5 * 33]); o.w = pk2(s[6 * 33], s[7 * 33]);
        *(u32x4*)(WT + (size_t)(drow0 + n) * ldt + dk0 + k0 + 8 * c) = o; }
    asm volatile("s_waitcnt lgkmcnt(0)" ::: "memory");
}

__device__ __forceinline__ void tr_item8(const float* W, int ldw, unsigned char* WT, int ldt, int k0, int n0, int drow0, LAS float* scr, int lane) {
#pragma unroll 8
    for (int i = 0; i < 32; ++i) { const int kk = 2 * i + (lane >> 5); scr[kk * 33 + (lane & 31)] = __builtin_nontemporal_load(W + (size_t)(k0 + kk) * ldw + n0 + (lane & 31)); }
    asm volatile("s_waitcnt lgkmcnt(0)" ::: "memory");
    const int c = lane & 3;
#pragma unroll
    for (int j = 0; j < 2; ++j) { const int n = (lane >> 2) + 16 * j; const LAS float* sp = scr + (16 * c) * 33 + n;
        u32x4 o; o.x = pk4_fp8(sp[0 * 33] * W8_SCALE, sp[1 * 33] * W8_SCALE, sp[2 * 33] * W8_SCALE, sp[3 * 33] * W8_SCALE);
        o.y = pk4_fp8(sp[4 * 33] * W8_SCALE, sp[5 * 33] * W8_SCALE, sp[6 * 33] * W8_SCALE, sp[7 * 33] * W8_SCALE);
        o.z = pk4_fp8(sp[8 * 33] * W8_SCALE, sp[9 * 33] * W8_SCALE, sp[10 * 33] * W8_SCALE, sp[11 * 33] * W8_SCALE);
        o.w = pk4_fp8(sp[12 * 33] * W8_SCALE, sp[13 * 33] * W8_SCALE, sp[14 * 33] * W8_SCALE, sp[15 * 33] * W8_SCALE);
        *(u32x4*)(WT + (size_t)(drow0 + n) * ldt + k0 + 16 * c) = o; }
    asm volatile("s_waitcnt lgkmcnt(0)" ::: "memory");
}

__device__ __forceinline__ void s5_prep(Frame& F, const Args& A, int lg) {
    const int l = lg >> 5, g = lg & 31, tid = F.tid;
    LAS f32x2* apow = (LAS f32x2*)(F.lds + 40960);
    LAS f32x2* Bb = apow + 2 * 17 * 65;
    LAS f32x2* Cc = Bb + 2 * 64 * 16;
    for (int i = tid; i < 2 * 17 * 64; i += 512) { const int d = i / (17 * 64), k = (i / 64) % 17, p = i % 64; const size_t pg = (size_t)(l * 2 + d) * NG + g;
        const float lre = A.in[I_LRE][pg * SP + p], lim = A.in[I_LIM][pg * SP + p], dt = __expf(A.in[I_LDT][pg]);
        const float mag = __expf((float)k * lre * dt); float sn, cs; sincosf((float)k * lim * dt, &sn, &cs);
        apow[(d * 17 + k) * 65 + p] = (f32x2){mag * cs, mag * sn}; }
    for (int i = tid; i < 2 * 64 * 16; i += 512) { const int d = i >> 10, p = (i >> 4) & 63, h = i & 15; const size_t pg = (size_t)(l * 2 + d) * NG + g;
        const float lre = A.in[I_LRE][pg * SP + p], lim = A.in[I_LIM][pg * SP + p], dt = __expf(A.in[I_LDT][pg]);
        const float mag = __expf(lre * dt); float sn, cs; sincosf(lim * dt, &sn, &cs);
        const float nre = mag * cs - 1.0f, nim = mag * sn, den = lre * lre + lim * lim;
        const float cr = (nre * lre + nim * lim) / den, ci = (nim * lre - nre * lim) / den;
        const float br = A.in[I_BRE][(pg * SP + p) * SH + h], bi = A.in[I_BIM][(pg * SP + p) * SH + h];
        Bb[i] = (f32x2){cr * br - ci * bi, cr * bi + ci * br};
        Cc[(d * 16 + h) * 65 + p] = (f32x2){A.in[I_CRE][(pg * SH + h) * SP + p], A.in[I_CIM][(pg * SH + h) * SP + p]}; }
    __syncthreads();
    unsigned char* W = F.ws + WS_S5W + (size_t)lg * S5W_STRIDE;
    for (int i = tid; i < 8192; i += 512) {
        const int r = i >> 12, x = i & 4095, nt = x >> 9, kk = (x >> 6) & 7, ln = x & 63, c = ln & 15, q = ln >> 4;
        const int n = 16 * nt + c, p = n >> 1, ri = n & 1, j = 2 * kk + (q >> 1), h0 = 8 * (q & 1), pw = r ? j : 15 - j;
        const f32x2 ap = apow[(r * 17 + pw) * 65 + p]; float v[8];
#pragma unroll
        for (int jj = 0; jj < 8; ++jj) { const f32x2 bb = Bb[(r * 64 + p) * 16 + h0 + jj]; v[jj] = ri ? (ap.x * bb.y + ap.y * bb.x) : (ap.x * bb.x - ap.y * bb.y); }
        u32x4 o; o.x = pk2(v[0], v[1]); o.y = pk2(v[2], v[3]); o.z = pk2(v[4], v[5]); o.w = pk2(v[6], v[7]);
        *(u32x4*)(W + (r ? S5_OFF_WSR : S5_OFF_WSF) + (size_t)x * 16) = o; }
    for (int i = tid; i < 8192; i += 512) {
        const int r = i >> 12, x = i & 4095, nt = x >> 8, kk = (x >> 6) & 3, ln = x & 63, h = ln & 15, q = ln >> 4;
        const int pw = r ? 16 - nt : nt + 1; float v[8];
#pragma unroll
        for (int jj = 0; jj < 8; ++jj) { const int p = 16 * kk + 4 * q + (jj >> 1); const f32x2 ap = apow[(r * 17 + pw) * 65 + p], cc = Cc[(r * 16 + h) * 65 + p];
            v[jj] = (jj & 1) ? -(cc.x * ap.y + cc.y * ap.x) : (cc.x * ap.x - cc.y * ap.y); }
        u32x4 o; o.x = pk2(v[0], v[1]); o.y = pk2(v[2], v[3]); o.z = pk2(v[4], v[5]); o.w = pk2(v[6], v[7]);
        *(u32x4*)(W + (r ? S5_OFF_WOR : S5_OFF_WOF) + (size_t)x * 16) = o; }
    if (tid < 31 * 16) {
        const int di = tid >> 4, h = tid & 15, dl = di - 15; float acc[16];
#pragma unroll
        for (int k = 0; k < 16; ++k) acc[k] = 0.f;
#pragma unroll
        for (int d = 0; d < 2; ++d) {
            if ((d == 0 && dl >= 0) || (d == 1 && dl <= 0)) { const int tau = d ? -dl : dl;
                for (int p = 0; p < 64; ++p) { const f32x2 cc = Cc[(d * 16 + h) * 65 + p], ap = apow[(d * 17 + tau) * 65 + p];
                    const float zr = cc.x * ap.x - cc.y * ap.y, zi = cc.x * ap.y + cc.y * ap.x;
#pragma unroll
                    for (int k = 0; k < 16; ++k) { const f32x2 bb = Bb[(d * 64 + p) * 16 + k]; acc[k] += zr * bb.x - zi * bb.y; } } } }
        { const float dsk = (dl == 0) ? A.in[I_S5D][l * DS5 + g * 16 + h] : 0.f;
#pragma unroll
          for (int k = 0; k < 16; ++k) acc[k] += (k == h) ? dsk : 0.f; }
        u32x4 o0, o1; o0.x = pk2(acc[0], acc[1]); o0.y = pk2(acc[2], acc[3]); o0.z = pk2(acc[4], acc[5]); o0.w = pk2(acc[6], acc[7]);
        o1.x = pk2(acc[8], acc[9]); o1.y = pk2(acc[10], acc[11]); o1.z = pk2(acc[12], acc[13]); o1.w = pk2(acc[14], acc[15]);
        *(u32x4*)(W + S5_OFF_TT + (size_t)tid * 32) = o0; *(u32x4*)(W + S5_OFF_TT + (size_t)tid * 32 + 16) = o1;
    }
    if (tid < 128) ((f32x2*)(W + S5_OFF_A16))[tid] = apow[((tid >> 6) * 17 + 16) * 65 + (tid & 63)];
    __syncthreads();
}
__device__ __forceinline__ void p0_prologue(Frame& F, const Args& A) {
    unsigned char* ws = F.ws;
    const int gw = F.vcu * 8 + F.wave, NGW = F.G * 8;
    LAS float* sil = (LAS float*)(F.lds);
    for (int i = F.tid; i < 9 * 1024; i += 512) { const float v = (i < 8192) ? A.in[I_C][i] : A.in[I_CCTX][i - 8192]; sil[i] = v * sigmoidf_(v); }
    __syncthreads();
    LAS float* scr = (LAS float*)(F.lds + 40960 + F.wave * 8448);
    float* mod = (float*)(ws + WS_MOD);
    if (F.vcu >= 64 || F.G < 256) {
        LAS float* part = (LAS float*)(F.lds + 40960);
        for (int it = (F.G < 256 ? F.vcu : F.vcu - 64); it < 2 * 96; it += (F.G < 256 ? F.G : F.G - 64)) {
            const int l = it / 96, n0 = (it % 96) * 64, n = n0 + F.lane;
            const float* W = A.in[I_WMOD] + (size_t)l * D * NMOD + n + (size_t)(F.wave * 128) * NMOD;
            float acc[9];
#pragma unroll
            for (int r = 0; r < 9; ++r) acc[r] = 0.f;
#pragma unroll 32
            for (int k = 0; k < 128; ++k) { const float w = W[(size_t)k * NMOD];
#pragma unroll
                for (int r = 0; r < 9; ++r) acc[r] += sil[r * 1024 + F.wave * 128 + k] * w; }
#pragma unroll
            for (int r = 0; r < 9; ++r) part[(F.wave * 9 + r) * 64 + F.lane] = acc[r];
            __syncthreads();
            for (int o = F.tid; o < 9 * 64; o += 512) { float sm = 0.f;
#pragma unroll
                for (int w = 0; w < 8; ++w) sm += part[w * 576 + o];
                const int r = o >> 6, nn = n0 + (o & 63);
                mod[((size_t)l * 9 + r) * NMOD + nn] = sm + A.in[I_BMOD][l * NMOD + nn]; }
            __syncthreads();
        }
    }
    for (int lg = F.vcu; lg < 64; lg += F.G) s5_prep(F, A, lg);
    constexpr int IT_SQ = 16 * 32;
    constexpr int IT_GLU = 8 * 16, IT_POOL = 4 * 2 * 4;
    constexpr int PER_L = 2 * IT_SQ + IT_GLU + IT_POOL;
    constexpr int N_SMALL = 2 * PER_L;
    constexpr int N_GU = 2 * 16 * 2 * IT_SQ, N_D = 2 * 16 * IT_SQ;
    for (int it = gw; it < N_SMALL + N_GU + N_D; it += NGW) {
        int r = it;
        if (r < N_SMALL) {
            const int l = r / PER_L; r -= l * PER_L;
            if (r < IT_SQ) { const int kb = r / 32, nb = r % 32; tr_item(A.in[I_WIN] + (size_t)l * D * D, D, (bf16_t*)(ws + WS_WIN) + (size_t)l * D * D, D, kb * 64, nb * 32, nb * 32, 0, scr, F.lane); continue; }
            r -= IT_SQ;
            if (r < IT_SQ) { const int kb = r / 32, nb = r % 32; tr_item(A.in[I_WOUT] + (size_t)l * D * D, D, (bf16_t*)(ws + WS_WOUT) + (size_t)l * D * D, D, kb * 64, nb * 32, nb * 32, 0, scr, F.lane); continue; }
            r -= IT_SQ;
            if (r < IT_GLU) { const int kb = r / 16, nb = r % 16; tr_item(A.in[I_WGLU] + (size_t)l * DS5 * DS5, DS5, (bf16_t*)(ws + WS_WGLU) + (size_t)l * DS5 * DS5, DS5, kb * 64, nb * 32, nb * 32, 0, scr, F.lane); continue; }
            r -= IT_GLU;
            { const int gi = r / 8, q = r % 8, kb = q / 4, nb = q % 4;
              tr_item(A.in[I_POOLW] + ((size_t)l * 4 + gi) * 128 * 128, 128, (bf16_t*)(ws + WS_WPOOL) + (size_t)l * 512 * 512, 512, kb * 64, nb * 32, gi * 128 + nb * 32, gi * 128, scr, F.lane); continue; }
        }
        r -= N_SMALL;
        if (r < N_GU) {
            const int le = r / (2 * IT_SQ); int q = r % (2 * IT_SQ); const int up = q / IT_SQ; q %= IT_SQ; const int kb = q / 32, nb = q % 32, n0 = nb * 32;
            const float* W = (up ? A.in[I_WUP] : A.in[I_WGATE]) + (size_t)le * D * D;
            tr_item8(W, D, (unsigned char*)(ws + WS_WGU) + (size_t)le * 2048 * D, D, kb * 64, n0, 256 * (n0 / 128) + (n0 % 128) + up * 128, scr, F.lane); continue;
        }
        r -= N_GU;
        { const int le = r / IT_SQ, q = r % IT_SQ, kb = q / 32, nb = q % 32;
          tr_item8(A.in[I_WDOWN] + (size_t)le * D * D, D, (unsigned char*)(ws + WS_WD) + (size_t)le * D * D, D, kb * 64, nb * 32, nb * 32, scr, F.lane); }
    }
    const int gt = F.vcu * 512 + F.tid, NGT = F.G * 512;
    for (int i = gt; i < 2 * 512 * 64; i += NGT) { const int row = (i / 64) % 512, c8 = i % 64; if ((row >> 7) != (c8 >> 4)) *(u32x4*)((bf16_t*)(ws + WS_WPOOL) + (size_t)i * 8) = (u32x4){0u, 0u, 0u, 0u}; }
    for (int i = gt; i < PT; i += NGT) ((int*)(ws + WS_IDENT))[i] = i;
    for (int i = gt; i < 2 * 16 * 1024; i += NGT) { const int l = i / 16384, e = (i / 1024) % 16, k = i % 1024; ((float*)(ws + WS_WRT))[i] = A.in[I_WROUTER][((size_t)l * D + k) * NE + e]; }
}

struct RowF32 { f32x4 v[4]; };
__device__ __forceinline__ void ld_row_f32(RowF32& r, const float* p, int lane) {
#pragma unroll
    for (int j = 0; j < 2; ++j) { r.v[2 * j] = __builtin_nontemporal_load((const f32x4*)(p + 8 * lane + 512 * j)); r.v[2 * j + 1] = __builtin_nontemporal_load((const f32x4*)(p + 8 * lane + 512 * j + 4)); }
}
__device__ __forceinline__ void ld_vec16(float (&o)[16], const float* p, int lane) {
#pragma unroll
    for (int j = 0; j < 2; ++j) { const f32x4 a = *(const f32x4*)(p + 8 * lane + 512 * j), b = *(const f32x4*)(p + 8 * lane + 512 * j + 4);
#pragma unroll
        for (int q = 0; q < 4; ++q) { o[8 * j + q] = a[q]; o[8 * j + 4 + q] = b[q]; } }
}
__device__ __forceinline__ void st_row_bf16(bf16_t* p, const float (&h)[16], int lane) {
#pragma unroll
    for (int j = 0; j < 2; ++j) { u32x4 w; w.x = pk2(h[8 * j], h[8 * j + 1]); w.y = pk2(h[8 * j + 2], h[8 * j + 3]); w.z = pk2(h[8 * j + 4], h[8 * j + 5]); w.w = pk2(h[8 * j + 6], h[8 * j + 7]);
        *(u32x4*)(p + 8 * lane + 512 * j) = w; }
}
struct RowRaw { u32x4 v[4]; };
__device__ __forceinline__ void ld_row_raw(RowRaw& r, const void* p, bool bf, int lane) {
    if (bf) { const bf16_t* q = (const bf16_t*)p; r.v[0] = *(const u32x4*)(q + 8 * lane); r.v[1] = *(const u32x4*)(q + 8 * lane + 512); }
    else { const float* q = (const float*)p; r.v[0] = *(const u32x4*)(q + 8 * lane); r.v[1] = *(const u32x4*)(q + 8 * lane + 4); r.v[2] = *(const u32x4*)(q + 8 * lane + 512); r.v[3] = *(const u32x4*)(q + 8 * lane + 516); }
}
__device__ __forceinline__ void row_to_f32(const RowRaw& r, bool bf, float (&x)[16]) {
    if (bf) {
#pragma unroll
        for (int j = 0; j < 2; ++j) { x[8 * j] = bflo(r.v[j].x); x[8 * j + 1] = bfhi(r.v[j].x); x[8 * j + 2] = bflo(r.v[j].y); x[8 * j + 3] = bfhi(r.v[j].y);
            x[8 * j + 4] = bflo(r.v[j].z); x[8 * j + 5] = bfhi(r.v[j].z); x[8 * j + 6] = bflo(r.v[j].w); x[8 * j + 7] = bfhi(r.v[j].w); }
    } else {
#pragma unroll
        for (int k = 0; k < 4; ++k) { x[4 * k] = __uint_as_float(r.v[k].x); x[4 * k + 1] = __uint_as_float(r.v[k].y); x[4 * k + 2] = __uint_as_float(r.v[k].z); x[4 * k + 3] = __uint_as_float(r.v[k].w); }
    }
}
__device__ __forceinline__ void st_row_f32(float* p, const float (&x)[16], int lane) {
#pragma unroll
    for (int j = 0; j < 2; ++j) { *(f32x4*)(p + 8 * lane + 512 * j) = (f32x4){x[8 * j], x[8 * j + 1], x[8 * j + 2], x[8 * j + 3]};
                                  *(f32x4*)(p + 8 * lane + 512 * j + 4) = (f32x4){x[8 * j + 4], x[8 * j + 5], x[8 * j + 6], x[8 * j + 7]}; }
}
__device__ __forceinline__ void p1_norm(Frame& F, const Args& A, int l, const float* xsrc, const float* csrc) {
    const int gw = F.vcu * 8 + F.wave, NGW = F.G * 8, lane = F.lane;
    const float* gpre = A.in[I_GMPRE] + l * D; const float* mod = (const float*)(F.ws + WS_MOD) + (size_t)l * 9 * NMOD;
    bf16_t* hx = (bf16_t*)(F.ws + WS_HX);
    const int rpw = (MT + NGW - 1) / NGW, r0 = gw * rpw, r1 = min(r0 + rpw, MT);
    if (r0 >= r1) return;
    float PA[16], PS[16]; int cur_bi = -1;
    RowF32 cur, nxt;
    ld_row_f32(cur, r0 < MX ? xsrc + (size_t)r0 * D : csrc + (size_t)(r0 - MX) * D, lane);
    for (int row = r0; row < r1; ++row) {
        if (row + 1 < r1) { const int rn = row + 1; ld_row_f32(nxt, rn < MX ? xsrc + (size_t)rn * D : csrc + (size_t)(rn - MX) * D, lane); }
        const int bi = row < MX ? (row >> 13) : 8;
        if (bi != cur_bi) { cur_bi = bi; const float* mb = mod + (size_t)bi * NMOD; float g_[16], sc[16]; ld_vec16(g_, gpre, lane); ld_vec16(sc, mb + D, lane); ld_vec16(PS, mb, lane);
#pragma unroll
            for (int k = 0; k < 16; ++k) PA[k] = g_[k] * (1.0f + sc[k]); }
        float ss = 0.f;
#pragma unroll
        for (int k = 0; k < 4; ++k) ss += cur.v[k][0] * cur.v[k][0] + cur.v[k][1] * cur.v[k][1] + cur.v[k][2] * cur.v[k][2] + cur.v[k][3] * cur.v[k][3];
        const float rstd = rsqrtf(wave_sum(ss) * (1.0f / D) + RMS_EPS);
        float h[16];
#pragma unroll
        for (int k = 0; k < 4; ++k)
#pragma unroll
            for (int q = 0; q < 4; ++q) h[4 * k + q] = cur.v[k][q] * rstd * PA[4 * k + q] + PS[4 * k + q];
        st_row_bf16(hx + (size_t)row * D, h, lane);
        cur = nxt;
    }
}

constexpr int L_U = 0, L_X = 33792, L_SF = 67072, L_SR = 84480, L_TT = 101888;
__device__ __forceinline__ void s5_mfma(Frame& F, int l, bool wctx) {
    const int tid = F.tid, lane = F.lane, wave = F.wave, c = lane & 15, q = lane >> 4;
    LAS unsigned char* lds = F.lds;
    LAS float* Xs = (LAS float*)(lds + L_X);
    const bf16_t* Us5 = (const bf16_t*)(F.ws + WS_R1 + R1_US5);
    bf16_t* Yg = (bf16_t*)(F.ws + WS_R1 + R1_YG);
    for (int bg = F.vcu; bg < NB * NG; bg += F.G) {
        const int b = bg / NG, g = bg % NG;
        const unsigned char* W = F.ws + WS_S5W + (size_t)(l * NG + g) * S5W_STRIDE;
        const unsigned char* useq = (const unsigned char*)(Us5 + (size_t)bg * NSEQ * 16);
        unsigned char* srs = F.ws + WS_R2 + (size_t)bg * (528 * 256);
        for (int x = tid; x < 31 * 16 * 2; x += 512) { const int row = x >> 1, half = x & 1; *(LAS u32x4*)(lds + L_TT + row * 48 + half * 16) = *(const u32x4*)(W + S5_OFF_TT + row * 32 + half * 16); }
        bf16x8 Bw[8];
#pragma unroll
        for (int kk = 0; kk < 8; ++kk) Bw[kk] = *(const bf16x8*)(W + (S5_OFF_WSR + (wave * 8 + kk) * 1024) + (unsigned)lane * 16u);
        f32x2 a16 = ((const f32x2*)(W + S5_OFF_A16))[64 + lane];
        float sre = 0.f, sim = 0.f;
        u32x4 pu[4];
#pragma unroll
        for (int k = 0; k < 4; ++k) { const int x = tid + 512 * k; if (x < 16 * 32) pu[k] = *(const u32x4*)(useq + 8192 * k + (unsigned)tid * 16u); }
#pragma nounroll
        for (int mbi = 0; mbi < 9; ++mbi) {
            const int mb = (mbi == 0) ? 0 : 9 - mbi;
            const int c0 = (mb == 0) ? 0 : 16 + 64 * (mb - 1), nch = (mb == 0) ? 16 : 64, nmt = nch >> 4;
#pragma unroll
            for (int k = 0; k < 4; ++k) { const int x = tid + 512 * k; if (x < nch * 32) *(LAS u32x4*)(lds + L_U + (x >> 5) * 528 + (x & 31) * 16) = pu[k]; }
            if (mbi < 8) { const int c0n = 16 + 64 * (7 - mbi);
#pragma unroll
                for (int k = 0; k < 4; ++k) pu[k] = *(const u32x4*)(useq + (c0n * 512 + 8192 * k) + (unsigned)tid * 16u); }
            __syncthreads();
#pragma nounroll
            for (int mt = 0; mt < nmt; ++mt) {
                f32x4 acc = (f32x4){0.f, 0.f, 0.f, 0.f};
#pragma unroll
                for (int kk = 0; kk < 8; ++kk) { const bf16x8 Af = *(const LAS bf16x8*)(lds + L_U + (16 * mt + c) * 528 + kk * 64 + q * 16); acc = __builtin_amdgcn_mfma_f32_16x16x32_bf16(Af, Bw[kk], acc, 0, 0, 0);
                    if ((kk & 3) == 3) asm volatile("" ::: "memory"); }
#pragma unroll
                for (int jj = 0; jj < 4; ++jj) Xs[(16 * mt + 4 * q + jj) * 130 + 16 * wave + c] = acc[jj];
            }
            __syncthreads();
            if (wave == 0) {
                for (int cb = nch - 4; cb >= 0; cb -= 4) { f32x2 xv[4];
#pragma unroll
                    for (int k = 0; k < 4; ++k) xv[k] = *(const LAS f32x2*)(Xs + (cb + k) * 130 + 2 * lane);
#pragma unroll
                    for (int k = 3; k >= 0; --k) { *(LAS unsigned*)(lds + L_SR + (cb + k) * 272 + lane * 4) = pk2(sre, sim);
                        const float nr = a16.x * sre - a16.y * sim + xv[k].x, ni = a16.x * sim + a16.y * sre + xv[k].y; sre = nr; sim = ni; } }
            }
            __syncthreads();
            for (int x = tid; x < nch * 16; x += 512) *(u32x4*)(srs + c0 * 256 + (unsigned)x * 16u) = *(const LAS u32x4*)(lds + L_SR + (x >> 4) * 272 + (x & 15) * 16);
            __syncthreads();
        }
        __threadfence(); __syncthreads(); __builtin_amdgcn_fence(__ATOMIC_ACQUIRE, "agent");
        const int tidF = launder(tid), laneF = tidF & 63, cF = laneF & 15, qF = laneF >> 4;
#pragma unroll
        for (int kk = 0; kk < 8; ++kk) Bw[kk] = *(const bf16x8*)(W + (S5_OFF_WSF + (wave * 8 + kk) * 1024) + (unsigned)laneF * 16u);
        a16 = ((const f32x2*)(W + S5_OFF_A16))[laneF];
        sre = 0.f; sim = 0.f;
        u32x4 ps[2];
#pragma unroll
        for (int k = 0; k < 4; ++k) { const int x = tidF + 512 * k; if (x < 16 * 32) pu[k] = *(const u32x4*)(useq + 8192 * k + (unsigned)tidF * 16u); }
#pragma unroll
        for (int k = 0; k < 2; ++k) { const int x = tidF + 512 * k; if (x < 16 * 16) ps[k] = *(const u32x4*)(srs + 8192 * k + (unsigned)tidF * 16u); }
#pragma nounroll
        for (int mb = 0; mb < 9; ++mb) {
            const int c0 = (mb == 0) ? 0 : 16 + 64 * (mb - 1), nch = (mb == 0) ? 16 : 64, nmt = nch >> 4;
#pragma unroll
            for (int k = 0; k < 4; ++k) { const int x = tidF + 512 * k; if (x < nch * 32) *(LAS u32x4*)(lds + L_U + (x >> 5) * 528 + (x & 31) * 16) = pu[k]; }
#pragma unroll
            for (int k = 0; k < 2; ++k) { const int x = tidF + 512 * k; if (x < nch * 16) *(LAS u32x4*)(lds + L_SR + (x >> 4) * 272 + (x & 15) * 16) = ps[k]; }
            if (mb < 8) { const int c0n = 16 + 64 * mb;
#pragma unroll
                for (int k = 0; k < 4; ++k) pu[k] = *(const u32x4*)(useq + (c0n * 512 + 8192 * k) + (unsigned)tidF * 16u);
#pragma unroll
                for (int k = 0; k < 2; ++k) ps[k] = *(const u32x4*)(srs + (c0n * 256 + 8192 * k) + (unsigned)tidF * 16u); }
            __syncthreads();
#pragma nounroll
            for (int mt = 0; mt < nmt; ++mt) {
                f32x4 acc = (f32x4){0.f, 0.f, 0.f, 0.f};
#pragma unroll
                for (int kk = 0; kk < 8; ++kk) { const bf16x8 Af = *(const LAS bf16x8*)(lds + L_U + (16 * mt + cF) * 528 + kk * 64 + qF * 16); acc = __builtin_amdgcn_mfma_f32_16x16x32_bf16(Af, Bw[kk], acc, 0, 0, 0);
                    if ((kk & 3) == 3) asm volatile("" ::: "memory"); }
#pragma unroll
                for (int jj = 0; jj < 4; ++jj) Xs[(16 * mt + 4 * qF + jj) * 130 + 16 * wave + cF] = acc[jj];
            }
            __syncthreads();
            if (wave == 0) {
                for (int cb = 0; cb < nch; cb += 4) { f32x2 xv[4];
#pragma unroll
                    for (int k = 0; k < 4; ++k) xv[k] = *(const LAS f32x2*)(Xs + (cb + k) * 130 + 2 * laneF);
#pragma unroll
                    for (int k = 0; k < 4; ++k) { *(LAS unsigned*)(lds + L_SF + (cb + k) * 272 + laneF * 4) = pk2(sre, sim);
                        const float nr = a16.x * sre - a16.y * sim + xv[k].x, ni = a16.x * sim + a16.y * sre + xv[k].y; sre = nr; sim = ni; } }
            }
            __syncthreads();
            if (mb > 0 || wctx) {
                f32x4 acc[4][2];
#pragma unroll
                for (int mt = 0; mt < 4; ++mt) { acc[mt][0] = (f32x4){0.f, 0.f, 0.f, 0.f}; acc[mt][1] = acc[mt][0]; }
#pragma unroll
                for (int kk = 0; kk < 8; ++kk) {
                    bf16x8 Tf[2];
#pragma unroll
                    for (int e = 0; e < 2; ++e) { const int dl = (2 * wave + e) - 2 * kk - (qF >> 1); Tf[e] = *(const LAS bf16x8*)(lds + L_TT + ((dl + 15) * 16 + cF) * 48 + (qF & 1) * 16); }
#pragma unroll
                    for (int mt = 0; mt < 4; ++mt) if (mt < nmt) { const bf16x8 Af = *(const LAS bf16x8*)(lds + L_U + (16 * mt + cF) * 528 + kk * 64 + qF * 16);
                        acc[mt][0] = __builtin_amdgcn_mfma_f32_16x16x32_bf16(Tf[0], Af, acc[mt][0], 0, 0, 0); acc[mt][1] = __builtin_amdgcn_mfma_f32_16x16x32_bf16(Tf[1], Af, acc[mt][1], 0, 0, 0); }
                    asm volatile("" ::: "memory"); }
#pragma unroll
                for (int dir = 0; dir < 2; ++dir) {
                    bf16x8 Bs[2][4];
#pragma unroll
                    for (int e = 0; e < 2; ++e)
#pragma unroll
                        for (int kk = 0; kk < 4; ++kk) Bs[e][kk] = *(const bf16x8*)(W + ((dir ? S5_OFF_WOR : S5_OFF_WOF) + ((2 * wave + e) * 4 + kk) * 1024) + (unsigned)laneF * 16u);
#pragma unroll
                    for (int kk = 0; kk < 4; ++kk) {
#pragma unroll
                        for (int mt = 0; mt < 4; ++mt) if (mt < nmt) { const bf16x8 Sx = *(const LAS bf16x8*)(lds + (dir ? L_SR : L_SF) + (16 * mt + cF) * 272 + kk * 64 + qF * 16);
#pragma unroll
                            for (int e = 0; e < 2; ++e) acc[mt][e] = __builtin_amdgcn_mfma_f32_16x16x32_bf16(Bs[e][kk], Sx, acc[mt][e], 0, 0, 0); }
                        asm volatile("" ::: "memory"); }
                }
#pragma unroll
                for (int mt = 0; mt < 4; ++mt) if (mt < nmt) {
#pragma unroll
                    for (int e = 0; e < 2; ++e) { const int n = (c0 + 16 * mt + cF) * 16 + 2 * wave + e;
                        const int row = (n < LC) ? (MX + b * LC + n) : (b * T + (n - LC));
                        u32x2 w; w.x = pk2(gelu_tanh(acc[mt][e][0]), gelu_tanh(acc[mt][e][1])); w.y = pk2(gelu_tanh(acc[mt][e][2]), gelu_tanh(acc[mt][e][3]));
                        *(u32x2*)(Yg + (size_t)row * 512 + g * 16 + 4 * qF) = w; } }
            }
            __syncthreads();
        }
    }
}
__device__ __forceinline__ void add8(float (&s)[8], const u32x4& x, float w) {
    s[0] += w * bflo(x.x); s[1] += w * bfhi(x.x); s[2] += w * bflo(x.y); s[3] += w * bfhi(x.y); s[4] += w * bflo(x.z); s[5] += w * bfhi(x.z); s[6] += w * bflo(x.w); s[7] += w * bfhi(x.w);
}
template <bool SUBV>
__device__ __forceinline__ void pool_line(const bf16_t* src, const bf16_t* vsub, bf16_t* dst, size_t stride, int n, int p0, int hw) {
    float s[8];
#pragma unroll
    for (int k = 0; k < 8; ++k) s[k] = 0.f;
    {
        u32x4 x[16];
#pragma unroll
        for (int k = 0; k < 16; ++k) { const int pos = p0 - 8 + k; x[k] = *(const u32x4*)(src + (size_t)min(max(pos, 0), n - 1) * stride); }
#pragma unroll
        for (int k = 0; k < 16; ++k) { const int pos = p0 - 8 + k; const bool in = pos >= max(p0 - hw, 0) && pos < min(p0 + hw, n); add8(s, x[k], in ? 1.0f : 0.0f); }
    }
#pragma nounroll
    for (int pb = p0; pb < p0 + 32; pb += 4) {
        u32x4 xa[4], xs[4], xv[4];
#pragma unroll
        for (int k = 0; k < 4; ++k) { const int p = pb + k; xa[k] = *(const u32x4*)(src + (size_t)min(p + hw, n - 1) * stride); xs[k] = *(const u32x4*)(src + (size_t)max(p - hw, 0) * stride);
            if (SUBV) xv[k] = *(const u32x4*)(vsub + (size_t)p * stride); }
#pragma unroll
        for (int k = 0; k < 4; ++k) { const int p = pb + k;
            const float inv = 1.0f / (float)(min(p + hw, n) - max(p - hw, 0));
            float o[8];
#pragma unroll
            for (int j = 0; j < 8; ++j) o[j] = s[j] * inv;
            if (SUBV) add8(o, xv[k], -1.0f);
            u32x4 w; w.x = pk2(o[0], o[1]); w.y = pk2(o[2], o[3]); w.z = pk2(o[4], o[5]); w.w = pk2(o[6], o[7]);
            *(u32x4*)(dst + (size_t)p * stride) = w;
            add8(s, xa[k], (p + hw < n) ? 1.0f : 0.0f); add8(s, xs[k], (p - hw >= 0) ? -1.0f : 0.0f); }
    }
}
constexpr size_t R2_HV = 64 * MiB;
__device__ __forceinline__ void pool_v(Frame& F) {
    const int gw = F.vcu * 8 + F.wave, NGW = F.G * 8, lane = F.lane, hw = 1 << (lane >> 4);
    const bf16_t* Vp = (const bf16_t*)(F.ws + WS_R1 + R1_VP);
    bf16_t* Hv = (bf16_t*)(F.ws + WS_R2 + R2_HV);
    for (int it = gw; it < NB * 64 * 4; it += NGW) {
        const int rq = it & 3, c = (it >> 2) & 63, b = it >> 8;
        const size_t base = ((size_t)(b * T + c)) * 512 + 8 * lane;
        pool_line<false>(Vp + base, nullptr, Hv + base, (size_t)64 * 512, 128, rq * 32, hw);
    }
}
__device__ __forceinline__ void pool_h(Frame& F, bool with_ctx) {
    const int gw = F.vcu * 8 + F.wave, NGW = F.G * 8, lane = F.lane, hw = 1 << (lane >> 4);
    const bf16_t* Vp = (const bf16_t*)(F.ws + WS_R1 + R1_VP);
    const bf16_t* Hv = (const bf16_t*)(F.ws + WS_R2 + R2_HV);
    bf16_t* Z = (bf16_t*)(F.ws + WS_R1 + R1_Z);
    const int nx = NB * 128 * 2, ntask = nx + (with_ctx ? NB * 8 : 0);
    for (int it = gw; it < ntask; it += NGW) {
        if (it < nx) { const int ch = it & 1, r = (it >> 1) & 127, b = it >> 8; const size_t base = ((size_t)(b * T + r * 64)) * 512 + 8 * lane;
            pool_line<true>(Hv + base, Vp + base, Z + base, 512, 64, ch * 32, hw); }
        else { const int j = it - nx, lq = j & 7, b = j >> 3; const size_t base = ((size_t)(MX + b * LC)) * 512 + 8 * lane;
            pool_line<true>(Vp + base, Vp + base, Z + base, 512, LC, lq * 32, hw); }
    }
}

__device__ __forceinline__ float xor4f(float x) { return dppx<0x1B>(dppx<0x141>(x)); }
__device__ __forceinline__ float xor8f(float x) { return dppx<0x128>(x); }
__device__ __forceinline__ void swap32(float& a, float& b) { const auto r = __builtin_amdgcn_permlane32_swap(__float_as_uint(a), __float_as_uint(b), false, false); a = __uint_as_float(r[0]); b = __uint_as_float(r[1]); }
__device__ __forceinline__ void swap16(float& a, float& b) { const auto r = __builtin_amdgcn_permlane16_swap(__float_as_uint(a), __float_as_uint(b), false, false); a = __uint_as_float(r[0]); b = __uint_as_float(r[1]); }
__device__ __forceinline__ float reduce16(float (&v)[16], int lane) {
#pragma unroll
    for (int i = 0; i < 8; ++i) { float a = v[i], b = v[i + 8]; swap32(a, b); v[i] = a + b; }
#pragma unroll
    for (int i = 0; i < 4; ++i) { float a = v[i], b = v[i + 4]; swap16(a, b); v[i] = a + b; }
#pragma unroll
    for (int i = 0; i < 2; ++i) { const float send = (lane & 8) ? v[i] : v[i + 2], keep = (lane & 8) ? v[i + 2] : v[i]; v[i] = keep + xor8f(send); }
    { const float send = (lane & 4) ? v[0] : v[1], keep = (lane & 4) ? v[1] : v[0]; v[0] = keep + xor4f(send); }
    v[0] += dppx<0x4E>(v[0]); v[0] += dppx<0xB1>(v[0]);
    return v[0];
}
__device__ __forceinline__ float max_idx16(float m) {
    m = fmaxf(m, xor4f(m)); m = fmaxf(m, xor8f(m));
    { float a = m, b = m; swap16(a, b); m = fmaxf(a, b); }
    { float a = m, b = m; swap32(a, b); m = fmaxf(a, b); }
    return m;
}
__device__ __forceinline__ float sum_idx16(float x) {
    x += xor4f(x); x += xor8f(x);
    { float a = x, b = x; swap16(a, b); x = a + b; }
    { float a = x, b = x; swap32(a, b); x = a + b; }
    return x;
}
struct Row6 { u32x4 m[2]; RowRaw x; };
constexpr int P6_WB = 0, P6_HT = 65536, P6_HSTR = 2064, P6_RED = P6_HT + 2 * 16 * P6_HSTR;
static_assert(P6_RED + 8192 <= MISC_OFF, "P6 LDS map");
__device__ __forceinline__ void p6_rows(Frame& F, const Args& A, int l, const float* xf32, const float* csrc, float* cdst, bool with_ctx) {
    bf16_t* XB = (bf16_t*)(F.ws + WS_XB); const bool xbf = (l != 0);
    const int lane = F.lane, wave = F.wave;
    LAS unsigned char* lds = F.lds;
    { const float* wrt = (const float*)(F.ws + WS_WRT) + (size_t)l * 16 * 1024;
      for (int i = F.tid; i < 32 * 64; i += 512) { const int kk = i >> 6, ln = i & 63, e = ln & 15, q = ln >> 4; const float* wp = wrt + e * 1024 + 32 * kk + 8 * q;
          const f32x4 w0 = *(const f32x4*)wp, w1 = *(const f32x4*)(wp + 4); float hi[8], lo[8];
#pragma unroll
          for (int j = 0; j < 4; ++j) { hi[j] = __uint_as_float(f2bf(w0[j]) << 16); lo[j] = w0[j] - hi[j]; hi[4 + j] = __uint_as_float(f2bf(w1[j]) << 16); lo[4 + j] = w1[j] - hi[4 + j]; }
          u32x4 h, lw; h.x = pk2(hi[0], hi[1]); h.y = pk2(hi[2], hi[3]); h.z = pk2(hi[4], hi[5]); h.w = pk2(hi[6], hi[7]);
          lw.x = pk2(lo[0], lo[1]); lw.y = pk2(lo[2], lo[3]); lw.z = pk2(lo[4], lo[5]); lw.w = pk2(lo[6], lo[7]);
          *(LAS u32x4*)(lds + P6_WB + i * 16) = h; *(LAS u32x4*)(lds + P6_WB + 32768 + i * 16) = lw; } }
    __syncthreads();
    const float* gpost = A.in[I_GMPOST] + l * D; const float* gpre = A.in[I_GFPRE] + l * D;
    const float* mod = (const float*)(F.ws + WS_MOD) + (size_t)l * 9 * NMOD;
    const bf16_t* mix = (const bf16_t*)(F.ws + WS_R1);
    unsigned char* hx8 = (unsigned char*)(F.ws + WS_HX);
    float* aff = (float*)(F.ws + WS_AFF); float* affc = (float*)(F.ws + WS_AFFC);
    const int nrows = with_ctx ? MT : MX;
    const int rpb = ((nrows + F.G - 1) / F.G + 1) & ~1;
    const int R0 = F.vcu * rpb, R1 = min(R0 + rpb, nrows);
#define LD_ROW6(dstv, rr) do { const int _r = (rr); _Pragma("unroll") for (int _j = 0; _j < 2; ++_j) (dstv).m[_j] = *(const u32x4*)(mix + (size_t)_r * D + 8 * lane + 512 * _j); \
        if (_r < MX) ld_row_raw((dstv).x, xbf ? (const void*)(XB + (size_t)_r * D) : (const void*)(xf32 + (size_t)_r * D), xbf, lane); else ld_row_raw((dstv).x, csrc + (size_t)(_r - MX) * D, false, lane); } while (0)
#define BI_OF(rr) (((rr) < MX) ? ((rr) >> 13) : 8)
    float PA1[16], PA2[16], PS2[16]; int cur_bi = -1;
    Row6 raw[2];
    if (R0 + 2 * wave < R1) { LD_ROW6(raw[0], R0 + 2 * wave); LD_ROW6(raw[1], R0 + 2 * wave + 1); }
#pragma nounroll
    for (int g0 = R0; g0 < R1; g0 += 16) {
        const int ra = g0 + 2 * wave; const bool act = ra < R1;
        if (act) {
            const int bi = BI_OF(ra); const bool isx = ra < MX;
            if (bi != cur_bi) { cur_bi = bi; const float* mb = mod + (size_t)bi * NMOD; float t0[16], t1[16];
                ld_vec16(t0, gpost, lane); ld_vec16(t1, mb + 2 * D, lane);
#pragma unroll
                for (int k = 0; k < 16; ++k) PA1[k] = t0[k] * t1[k];
                ld_vec16(t0, gpre, lane); ld_vec16(t1, mb + 4 * D, lane); ld_vec16(PS2, mb + 3 * D, lane);
#pragma unroll
                for (int k = 0; k < 16; ++k) PA2[k] = t0[k] * (1.0f + t1[k]); }
#pragma unroll
            for (int r = 0; r < 2; ++r) {
                const int rw = ra + r;
                float mv[16], xv[16];
#pragma unroll
                for (int j = 0; j < 2; ++j) { mv[8 * j] = bflo(raw[r].m[j].x); mv[8 * j + 1] = bfhi(raw[r].m[j].x); mv[8 * j + 2] = bflo(raw[r].m[j].y); mv[8 * j + 3] = bfhi(raw[r].m[j].y);
                    mv[8 * j + 4] = bflo(raw[r].m[j].z); mv[8 * j + 5] = bfhi(raw[r].m[j].z); mv[8 * j + 6] = bflo(raw[r].m[j].w); mv[8 * j + 7] = bfhi(raw[r].m[j].w); }
                float ss = 0.f;
#pragma unroll
                for (int k = 0; k < 16; ++k) ss += mv[k] * mv[k];
                const float rstd = rsqrtf(wave_sum(ss) * (1.0f / D) + RMS_EPS);
                float ss2 = 0.f;
                row_to_f32(raw[r].x, isx && xbf, xv);
#pragma unroll
                for (int k = 0; k < 16; ++k) { const float v = xv[k] + mv[k] * rstd * PA1[k]; xv[k] = v; ss2 += v * v; }
                if (isx) st_row_bf16(XB + (size_t)rw * D, xv, lane); else st_row_f32(cdst + (size_t)(rw - MX) * D, xv, lane);
                const float rstd2 = rsqrtf(wave_sum(ss2) * (1.0f / D) + RMS_EPS);
#pragma unroll
                for (int k = 0; k < 16; ++k) xv[k] = xv[k] * rstd2 * PA2[k] + PS2[k];
#pragma unroll
                for (int j = 0; j < 2; ++j) { u32x2 w; w.x = pk4_fp8(xv[8 * j], xv[8 * j + 1], xv[8 * j + 2], xv[8 * j + 3]); w.y = pk4_fp8(xv[8 * j + 4], xv[8 * j + 5], xv[8 * j + 6], xv[8 * j + 7]);
                    *(u32x2*)(hx8 + (size_t)rw * D + 8 * lane + 512 * j) = w; }
                LAS unsigned char* hrow = lds + P6_HT + (2 * wave + r) * P6_HSTR + lane * 16;
#pragma unroll
                for (int j = 0; j < 2; ++j) { u32x4 h, lw; float lo[8];
                    h.x = pk2(xv[8 * j], xv[8 * j + 1]); h.y = pk2(xv[8 * j + 2], xv[8 * j + 3]); h.z = pk2(xv[8 * j + 4], xv[8 * j + 5]); h.w = pk2(xv[8 * j + 6], xv[8 * j + 7]);
                    lo[0] = xv[8 * j] - bflo(h.x); lo[1] = xv[8 * j + 1] - bfhi(h.x); lo[2] = xv[8 * j + 2] - bflo(h.y); lo[3] = xv[8 * j + 3] - bfhi(h.y);
                    lo[4] = xv[8 * j + 4] - bflo(h.z); lo[5] = xv[8 * j + 5] - bfhi(h.z); lo[6] = xv[8 * j + 6] - bflo(h.w); lo[7] = xv[8 * j + 7] - bfhi(h.w);
                    lw.x = pk2(lo[0], lo[1]); lw.y = pk2(lo[2], lo[3]); lw.z = pk2(lo[4], lo[5]); lw.w = pk2(lo[6], lo[7]);
                    *(LAS u32x4*)(hrow + j * 1024) = h; *(LAS u32x4*)(hrow + 16 * P6_HSTR + j * 1024) = lw; }
            }
            if (ra + 16 < R1) { LD_ROW6(raw[0], ra + 16); LD_ROW6(raw[1], ra + 17); }
        }
        __syncthreads();
        {
            f32x4 acc = (f32x4){0.f, 0.f, 0.f, 0.f};
            const int r16 = lane & 15, q = lane >> 4;
#pragma unroll
            for (int k4 = 0; k4 < 4; ++k4) { const int kk = 4 * wave + k4;
                const bf16x8 ah = *(const LAS bf16x8*)(lds + P6_HT + r16 * P6_HSTR + kk * 64 + q * 16), al = *(const LAS bf16x8*)(lds + P6_HT + 16 * P6_HSTR + r16 * P6_HSTR + kk * 64 + q * 16);
                const bf16x8 bh = *(const LAS bf16x8*)(lds + P6_WB + (kk * 64 + lane) * 16), bl = *(const LAS bf16x8*)(lds + P6_WB + 32768 + (kk * 64 + lane) * 16);
                acc = __builtin_amdgcn_mfma_f32_16x16x32_bf16(ah, bh, acc, 0, 0, 0);
                acc = __builtin_amdgcn_mfma_f32_16x16x32_bf16(al, bh, acc, 0, 0, 0);
                acc = __builtin_amdgcn_mfma_f32_16x16x32_bf16(ah, bl, acc, 0, 0, 0); }
            LAS float* red = (LAS float*)(lds + P6_RED) + wave * 256;
#pragma unroll
            for (int jj = 0; jj < 4; ++jj) red[(4 * q + jj) * 16 + r16] = acc[jj];
        }
        __syncthreads();
        if (act) {
            const int rr = 2 * wave + (lane >> 5), e = lane & 15, rw = g0 + rr;
            const LAS float* red = (const LAS float*)(lds + P6_RED) + rr * 16 + e;
            float lg = 0.f;
#pragma unroll
            for (int w8 = 0; w8 < 8; ++w8) lg += red[w8 * 256];
            float mx = lg; mx = fmaxf(mx, dppx<0xB1>(mx)); mx = fmaxf(mx, dppx<0x4E>(mx)); mx = fmaxf(mx, xor4f(mx)); mx = fmaxf(mx, xor8f(mx));
            const float ex = __expf(lg - mx); float se = ex; se += dppx<0xB1>(se); se += dppx<0x4E>(se); se += xor4f(se); se += xor8f(se);
            if ((lane & 16) == 0) {
                const float av = ex * __builtin_amdgcn_rcpf(se);
                if (rw < MX) aff[((size_t)((rw >> 13) * 16 + e)) * T + (rw & (T - 1))] = av;
                else { const int rc = rw - MX, b = rc >> 8, p = rc & 255; affc[((size_t)(e * 8 + b)) * LC + p] = av; }
            }
        }
    }
#undef LD_ROW6
#undef BI_OF
}

template <int CTRL> __device__ __forceinline__ int dppi(int v) { return __builtin_amdgcn_update_dpp(0, v, CTRL, 0xF, 0xF, false); }
__device__ __forceinline__ int block_sum_i(int v, LAS int* red, int wave, int lane, int& parity) {
    v += dppi<0xB1>(v); v += dppi<0x4E>(v); v += dppi<0x141>(v); v += dppi<0x140>(v);
    v = (__builtin_amdgcn_readlane(v, 0) + __builtin_amdgcn_readlane(v, 16)) + (__builtin_amdgcn_readlane(v, 32) + __builtin_amdgcn_readlane(v, 48));
    LAS int* r = red + 8 * parity; parity ^= 1;
    if (lane == 0) r[wave] = v;
    __syncthreads();
    const i32x4 a = *(const LAS i32x4*)r, b = *(const LAS i32x4*)(r + 4);
    return (a[0] + a[1]) + (a[2] + a[3]) + (b[0] + b[1]) + (b[2] + b[3]);
}
__device__ __forceinline__ void p7_topk(Frame& F, bool with_ctx) {
    LAS int* red = (LAS int*)F.lds;
    LAS int* wtot = (LAS int*)(F.lds + 64);
    int par = 0;
    const float* aff = (const float*)(F.ws + WS_AFF); const float* affc = (const float*)(F.ws + WS_AFFC);
    int* seli = (int*)(F.ws + WS_SELI); float* selg = (float*)(F.ws + WS_SELG); int* inv = (int*)(F.ws + WS_INV);
    const int nprob = with_ctx ? 256 : 128;
    for (int q = F.vcu; q < nprob; q += F.G) {
        const float* src; int n, cap, pbase, rbase, e;
        if (q < 128) { src = aff + (size_t)q * T; n = T; cap = CAPX; pbase = q * CAPX; rbase = (q >> 4) * T; e = q & 15; }
        else { const int qq = q - 128; src = affc + (size_t)qq * LC; n = LC; cap = CAPC; pbase = PX + qq * CAPC; rbase = MX + (qq & 7) * LC; e = qq >> 3; }
        const int t0 = F.tid * 16;
        unsigned key[16]; const bool valid = t0 < n;
#pragma unroll
        for (int i = 0; i < 16; ++i) key[i] = 0u;
        if (valid) {
#pragma unroll
            for (int i4 = 0; i4 < 4; ++i4) { const f32x4 v = *(const f32x4*)(src + t0 + 4 * i4);
#pragma unroll
                for (int j = 0; j < 4; ++j) key[i4 * 4 + j] = __float_as_uint(v[j]); }
        }
        unsigned cur = 0u;
        {
            constexpr unsigned KMIN = 0x2F800000u;
            LAS int* hist = (LAS int*)(F.lds + 1024); LAS int* ctl = (LAS int*)(F.lds + 128); LAS unsigned* cnd = (LAS unsigned*)(F.lds + 16384);
#pragma unroll
            for (int k = 0; k < 4; ++k) hist[F.tid * 4 + k] = 0;
            if (F.tid < 4) ctl[F.tid] = 0;
            __syncthreads();
            int kb[16];
#pragma unroll
            for (int i = 0; i < 16; ++i) { const unsigned d = key[i] - KMIN; kb[i] = key[i] < KMIN ? 0 : (int)min(d >> 17, 2047u); if (valid) __hip_atomic_fetch_add(hist + kb[i], 1, __ATOMIC_RELAXED, __HIP_MEMORY_SCOPE_WORKGROUP); }
            __syncthreads();
            const int b0 = 4 * (511 - F.tid); const i32x4 hv = *(const LAS i32x4*)(hist + b0);
            const int s4 = (hv[0] + hv[1]) + (hv[2] + hv[3]);
            int incl = s4;
#pragma unroll
            for (int o = 1; o < 64; o <<= 1) { const int y = __shfl_up(incl, o); if (F.lane >= o) incl += y; }
            if (F.lane == 63) wtot[F.wave] = incl;
            __syncthreads();
            int above = incl - s4;
#pragma unroll
            for (int w = 0; w < 8; ++w) above += (w < F.wave) ? wtot[w] : 0;
#pragma unroll
            for (int k = 3; k >= 0; --k) { const int h = hv[k]; if (above < cap && cap <= above + h) { ctl[0] = b0 + k; ctl[1] = above; } above += h; }
            __syncthreads();
            const int bstar = ctl[0], needb = cap - ctl[1];
            if (valid) {
#pragma unroll
                for (int i = 0; i < 16; ++i) if (kb[i] == bstar) { const int pos = __hip_atomic_fetch_add(ctl + 2, 1, __ATOMIC_RELAXED, __HIP_MEMORY_SCOPE_WORKGROUP); cnd[pos] = key[i]; }
            }
            __syncthreads();
            const int nc = ctl[2];
            if (F.wave == 0) {
                unsigned t = 0u;
                for (int bit = 31; bit >= 0; --bit) { const unsigned cand = t | (1u << bit); int c = 0;
                    for (int j = F.lane; j < nc; j += 64) c += (cnd[j] >= cand) ? 1 : 0;
                    c += dppi<0xB1>(c); c += dppi<0x4E>(c); c += dppi<0x141>(c); c += dppi<0x140>(c);
                    c = (__builtin_amdgcn_readlane(c, 0) + __builtin_amdgcn_readlane(c, 16)) + (__builtin_amdgcn_readlane(c, 32) + __builtin_amdgcn_readlane(c, 48));
                    if (c >= needb) t = cand; }
                if (F.lane == 0) ctl[3] = (int)t; }
            __syncthreads();
            cur = (unsigned)ctl[3];
        }
        int cg = 0, ce = 0;
#pragma unroll
        for (int i = 0; i < 16; ++i) { cg += (key[i] > cur) ? 1 : 0; ce += (valid && key[i] == cur) ? 1 : 0; }
        const int ngt = block_sum_i(cg, red, F.wave, F.lane, par);
        const int need = cap - ngt;
        int x = cg | (ce << 16);
        int incl = x;
#pragma unroll
        for (int o = 1; o < 64; o <<= 1) { const int y = __shfl_up(incl, o); if (F.lane >= o) incl += y; }
        __syncthreads();
        if (F.lane == 63) wtot[F.wave] = incl;
        __syncthreads();
        int wpre = 0;
#pragma unroll
        for (int w = 0; w < 8; ++w) wpre += (w < F.wave) ? wtot[w] : 0;
        const int excl = wpre + incl - x;
        int pg = excl & 0xffff, pe = excl >> 16;
        if (valid) {
#pragma unroll
            for (int i = 0; i < 16; ++i) {
                const bool gt = key[i] > cur, eq = key[i] == cur;
                const bool sel = gt || (eq && pe < need);
                const int slot = pg + min(pe, need);
                const int trow = rbase + t0 + i;
                if (sel) { seli[pbase + slot] = trow; selg[pbase + slot] = __uint_as_float(key[i]); inv[(size_t)trow * 16 + e] = pbase + slot; }
                else inv[(size_t)trow * 16 + e] = -1;
                pg += gt ? 1 : 0; pe += eq ? 1 : 0;
            }
        }
        __syncthreads();
    }
}

__device__ __forceinline__ void p8a_gather(Frame& F, bool with_ctx) {
    const int gw = F.vcu * 8 + F.wave, NGW = F.G * 8, lane = F.lane;
    const int* seli = (const int*)(F.ws + WS_SELI);
    const bf16_t* hx2 = (const bf16_t*)(F.ws + WS_HX); bf16_t* Xg = (bf16_t*)(F.ws + WS_R2);
    const int np = with_ctx ? PT : PX;
    for (int pr = gw; pr < np; pr += NGW) {
        const int tr = seli[pr];
        const u32x4* s = (const u32x4*)(hx2 + (size_t)tr * D); u32x4* d = (u32x4*)(Xg + (size_t)pr * D);
        const u32x4 a = s[lane], b = s[lane + 64]; d[lane] = a; d[lane + 64] = b;
    }
}

__device__ __forceinline__ void p10_combine(Frame& F, const Args& A, int l, float* xout, float* cio, bool with_ctx) {
    bf16_t* XB = (bf16_t*)(F.ws + WS_XB);
#define LD_ROW10(dstv, rr) do { const int _r = (rr); if (_r < MX) ld_row_raw(dstv, XB + (size_t)_r * D, true, lane); else ld_row_raw(dstv, cio + (size_t)(_r - MX) * D, false, lane); } while (0)
    const int gw = F.vcu * 8 + F.wave, NGW = F.G * 8, lane = F.lane;
    const int* inv = (const int*)(F.ws + WS_INV); const unsigned char* Yd = (const unsigned char*)(F.ws + WS_R2); const float* selg = (const float*)(F.ws + WS_SELG);
    const float* gpost = A.in[I_GFPOST] + l * D; const float* mod = (const float*)(F.ws + WS_MOD) + (size_t)l * 9 * NMOD;
    const float* gpre1 = A.in[I_GMPRE] + D;
    bf16_t* hx = (bf16_t*)(F.ws + WS_HX);
    const int nrows = with_ctx ? MT : MX;
    const int rpw = (nrows + NGW - 1) / NGW, r0 = gw * rpw, r1 = min(r0 + rpw, nrows);
    if (r0 >= r1) return;
    float PA3[16], PA4[16], PS4[16]; int cur_bi = -1;
    RowRaw cur, nxt; int cinv, ninv = -1;
    LD_ROW10(cur, r0);
    cinv = (lane < 16) ? inv[(size_t)r0 * 16 + lane] : -1;
    for (int row = r0; row < r1; ++row) {
        if (row + 1 < r1) { const int rn = row + 1; LD_ROW10(nxt, rn); ninv = (lane < 16) ? inv[(size_t)rn * 16 + lane] : -1; }
        const bool isx = row < MX;
        const int bi = isx ? (row >> 13) : 8;
        if (bi != cur_bi) { cur_bi = bi; const float* mb = mod + (size_t)bi * NMOD; float t0[16], t1[16];
            ld_vec16(t0, gpost, lane); ld_vec16(t1, mb + 5 * D, lane);
#pragma unroll
            for (int k = 0; k < 16; ++k) PA3[k] = t0[k] * t1[k];
            if (l == 0) { const float* mb1 = mb + (size_t)9 * NMOD; ld_vec16(t0, gpre1, lane); ld_vec16(t1, mb1 + D, lane); ld_vec16(PS4, mb1, lane);
#pragma unroll
                for (int k = 0; k < 16; ++k) PA4[k] = t0[k] * (1.0f + t1[k]); } }
        float acc[16];
#pragma unroll
        for (int k = 0; k < 16; ++k) acc[k] = 0.f;
        unsigned long long bm = __ballot(cinv >= 0);
        while (bm) {
            int pr[4]; float wgt[4];
#pragma unroll
            for (int k = 0; k < 4; ++k) { if (bm) { const int e = __builtin_ctzll(bm); bm &= bm - 1; pr[k] = __builtin_amdgcn_readlane(cinv, e); wgt[k] = selg[pr[k]] * (1.0f / pg8::YD_SCALE); } else { pr[k] = 0; wgt[k] = 0.f; } }
            u32x2 y[4][2];
#pragma unroll
            for (int k = 0; k < 4; ++k)
#pragma unroll
                for (int j = 0; j < 2; ++j) y[k][j] = *(const u32x2*)(Yd + (size_t)pr[k] * D + 8 * lane + 512 * j);
#pragma unroll
            for (int k = 0; k < 4; ++k)
#pragma unroll
                for (int j = 0; j < 2; ++j) { const f32x2 v0 = __builtin_amdgcn_cvt_pk_f32_fp8((int)y[k][j].x, false), v1 = __builtin_amdgcn_cvt_pk_f32_fp8((int)y[k][j].x, true),
                                                          v2 = __builtin_amdgcn_cvt_pk_f32_fp8((int)y[k][j].y, false), v3 = __builtin_amdgcn_cvt_pk_f32_fp8((int)y[k][j].y, true);
                    acc[8 * j] += wgt[k] * v0.x; acc[8 * j + 1] += wgt[k] * v0.y; acc[8 * j + 2] += wgt[k] * v1.x; acc[8 * j + 3] += wgt[k] * v1.y;
                    acc[8 * j + 4] += wgt[k] * v2.x; acc[8 * j + 5] += wgt[k] * v2.y; acc[8 * j + 6] += wgt[k] * v3.x; acc[8 * j + 7] += wgt[k] * v3.y; }
        }
        float ss = 0.f;
#pragma unroll
        for (int k = 0; k < 16; ++k) ss += acc[k] * acc[k];
        const float rstd = rsqrtf(wave_sum(ss) * (1.0f / D) + RMS_EPS);
        float s3 = 0.f, x1[16];
        row_to_f32(cur, isx, x1);
#pragma unroll
        for (int k = 0; k < 16; ++k) { const float v = x1[k] + acc[k] * rstd * PA3[k]; acc[k] = v; s3 += v * v; }
        if (!isx) st_row_f32(cio + (size_t)(row - MX) * D, acc, lane);
        else if (l == 0) st_row_bf16(XB + (size_t)row * D, acc, lane);
        else st_row_f32(xout + (size_t)row * D, acc, lane);
        if (l == 0) {
            const float rstd3 = rsqrtf(wave_sum(s3) * (1.0f / D) + RMS_EPS);
#pragma unroll
            for (int k = 0; k < 16; ++k) acc[k] = acc[k] * rstd3 * PA4[k] + PS4[k];
            st_row_bf16(hx + (size_t)row * D, acc, lane);
        }
        cur = nxt; cinv = ninv;
    }
#undef LD_ROW10
}

constexpr int NPL = 11, NPHASE = 1 + 2 * NPL;
#ifndef LB2
#define LB2 2
#endif
__global__ void __launch_bounds__(512, LB2) fwd(Args args) {
    extern __shared__ __attribute__((aligned(16))) unsigned char lds_raw[];
    Frame F;
    F.lds = (LAS unsigned char*)lds_raw;
    F.tid = threadIdx.x; F.lane = F.tid & 63; F.wave = __builtin_amdgcn_readfirstlane(F.tid >> 6);
    F.G = gridDim.x; { const int bx = blockIdx.x; F.vcu = (F.G % 8 == 0) ? (bx % 8) * (F.G / 8) + bx / 8 : bx; }
    F.out = args.out; F.ws = args.ws;
    volatile LAS unsigned* MISC = (volatile LAS unsigned*)(F.lds + MISC_OFF);
    for (int u = F.tid; u < 64; u += 512) ((LAS unsigned*)(F.lds + MISC_OFF))[u] = 0u;
    __syncthreads();
    const int lo = args.ph_lo, hi = args.ph_hi;
    const bool multi = (hi - lo) > 1;
    XcdBarrier bar; bar.bar = (unsigned*)(F.ws + WS_CTL) + 4096; bar.x = 0; bar.st = MISC + 8;
    if (multi) bar = xcd_barrier_post((unsigned*)(F.ws + WS_CTL) + 4096, MISC + 8);
#ifndef PH_MASK
#define PH_MASK 0xFFFFFFFFu
#endif
#define IN(k) (lo <= (k) && (k) < hi)
#define EN(j) ((PH_MASK >> (j)) & 1u)
#ifndef DUP_MASK
#define DUP_MASK 0u
#endif
#define REPS(j) ((((unsigned)DUP_MASK >> (j)) & 1u) ? 2 : 1)
#define FRESH() do { F.tid = launder((int)threadIdx.x); F.lane = F.tid & 63; } while (0)
#define SEAM(k) do { if (multi && IN((k) + 1)) xcd_barrier(bar); } while (0)

    if (EN(0) && IN(0)) { FRESH();
#pragma nounroll
        for (int rep = 0; rep < REPS(0); ++rep) p0_prologue(F, args);
        SEAM(0);
#ifdef XBAR
        if (multi) for (int q = 0; q < XBAR; ++q) xcd_barrier(bar);
#endif
        }

    bf16_t* HX = (bf16_t*)(F.ws + WS_HX);
    float* CTXS = (float*)(F.ws + WS_CTXS);
#pragma nounroll
    for (int l = 0; l < 2; ++l) {
        const int pb = 1 + l * NPL;
        const bool wctx = (l == 0);
        const float* xsrc = args.in[I_X];
        const float* csrc = (l == 0) ? args.in[I_CTX] : CTXS;
        if (EN(1) && IN(pb + 0)) { FRESH();
#pragma nounroll
            for (int rep = 0; rep < REPS(1); ++rep) if (l == 0) p1_norm(F, args, l, xsrc, csrc);
            if (l == 0) SEAM(pb + 0); }
        if (EN(2) && IN(pb + 1)) { FRESH();
            pg8::AddrPlain g{HX, (const bf16_t*)(F.ws + WS_WIN) + (size_t)l * D * D, D};
            pg8::LinOrder S{(MT / 256) * 4, 4, F.G, F.vcu};
            pg8::EpiWin E{(bf16_t*)(F.ws + WS_R1 + R1_US5), (bf16_t*)(F.ws + WS_R1 + R1_VP)};

#pragma nounroll
            for (int rep = 0; rep < REPS(2); ++rep) pg8::gemm_phase(F.lds + STAGE_OFF, g, S, E);
            SEAM(pb + 1);
        }
        if (EN(3) && IN(pb + 2)) { FRESH();
#pragma nounroll
            for (int rep = 0; rep < REPS(3); ++rep) { s5_mfma(F, l, wctx); pool_v(F); }
            SEAM(pb + 2); }
        if (EN(4) && IN(pb + 3)) { FRESH();
#pragma nounroll
            for (int rep = 0; rep < REPS(4); ++rep) pool_h(F, wctx);
            SEAM(pb + 3); }
        if (EN(5) && IN(pb + 4)) { FRESH();
            const int mrows = wctx ? MT : MX;
            { pg8::AddrMid g{(const bf16_t*)(F.ws + WS_R1 + R1_YG), (const bf16_t*)(F.ws + WS_R1 + R1_Z), (const bf16_t*)(F.ws + WS_WGLU) + (size_t)l * DS5 * DS5, (const bf16_t*)(F.ws + WS_WPOOL) + (size_t)l * 512 * 512, 512};
              pg8::MidOrder S{(mrows / 256) * 4, F.G, F.vcu};
              pg8::EpiMid E{(const bf16_t*)(F.ws + WS_R1 + R1_YG), args.in[I_POOLS] + l * 512, HX};
#pragma nounroll
              for (int rep = 0; rep < REPS(5); ++rep) pg8::gemm_phase(F.lds + STAGE_OFF, g, S, E); }
            SEAM(pb + 4);
        }
        if (EN(6) && IN(pb + 5)) { FRESH();
            const int mrows = wctx ? MT : MX;
            pg8::AddrPlain g{HX, (const bf16_t*)(F.ws + WS_WOUT) + (size_t)l * D * D, D};
            pg8::LinOrder S{(mrows / 256) * 4, 4, F.G, F.vcu};
            pg8::EpiPlain E{(bf16_t*)(F.ws + WS_R1), D};

#pragma nounroll
            for (int rep = 0; rep < REPS(6); ++rep) pg8::gemm_phase(F.lds + STAGE_OFF, g, S, E);
            SEAM(pb + 5);
        }
        if (EN(7) && IN(pb + 6)) { FRESH();
#pragma nounroll
            for (int rep = 0; rep < ((l == 0) ? REPS(7) : 1); ++rep) p6_rows(F, args, l, xsrc, csrc, CTXS, wctx);
            SEAM(pb + 6); }
        if (EN(8) && IN(pb + 7)) { FRESH();
#pragma nounroll
            for (int rep = 0; rep < REPS(8); ++rep) p7_topk(F, wctx);
            SEAM(pb + 7); }
        if (EN(9) && IN(pb + 8)) { FRESH();
            const int ptiles = (wctx ? PT : PX) / 256;
            pg8::AddrMoEGather g{(const unsigned char*)(F.ws + WS_HX), (const int*)(F.ws + WS_SELI), (const unsigned char*)(F.ws + WS_WGU) + (size_t)l * 16 * 2048 * D, (size_t)2048 * D, D / 2};
            pg8::LinOrder S{ptiles * 8, 8, F.G, F.vcu};
            pg8::EpiSwiglu E{(unsigned char*)(F.ws + WS_R1)};

#pragma nounroll
            for (int rep = 0; rep < REPS(9); ++rep) pg8::gemm_phase(F.lds + STAGE_OFF, g, S, E);
            SEAM(pb + 8);
        }
        if (EN(10) && IN(pb + 9)) { FRESH();
            const int ptiles = (wctx ? PT : PX) / 256;
            pg8::AddrMoEGatherH g{(const unsigned char*)(F.ws + WS_R1), (const int*)(F.ws + WS_IDENT), (const unsigned char*)(F.ws + WS_WD) + (size_t)l * 16 * D * D, (size_t)D * D, D / 2};
            pg8::LinOrder S{ptiles * 4, 4, F.G, F.vcu};
            pg8::EpiYd8 E{(unsigned char*)(F.ws + WS_R2)};

#pragma nounroll
            for (int rep = 0; rep < REPS(10); ++rep) pg8::gemm_phase(F.lds + STAGE_OFF, g, S, E);
            SEAM(pb + 9);
        }
        if (EN(11) && IN(pb + 10)) { FRESH();
#pragma nounroll
            for (int rep = 0; rep < ((l == 1) ? REPS(11) : 1); ++rep) p10_combine(F, args, l, F.out, CTXS, wctx);
            SEAM(pb + 10); }
    }
#undef IN
#undef SEAM
}

#ifndef MK_ONE_LAUNCH
#define MK_ONE_LAUNCH 1
#endif
extern "C" void kernel_launch(void* const* d_in, const int* in_sizes, int n_in, void* d_out, int out_size, void* d_ws, size_t ws_size, hipStream_t stream) {
    static int grid = 0;
    if (grid == 0) {
        if (n_in != 27 || out_size != MX * D || ws_size < WS_END) { fprintf(stderr, "kernel_launch: unexpected shapes (n_in %d out %d ws %zu)\n", n_in, out_size, ws_size); grid = -1; return; }
        int dev = 0, cus = 0, per_cu = 0;
        if (hipGetDevice(&dev) != hipSuccess || hipDeviceGetAttribute(&cus, hipDeviceAttributeMultiprocessorCount, dev) != hipSuccess) { grid = -1; return; }
        if (hipFuncSetAttribute((const void*)fwd, hipFuncAttributeMaxDynamicSharedMemorySize, LDS_BYTES) != hipSuccess) { fprintf(stderr, "kernel_launch: hipFuncSetAttribute failed\n"); grid = -1; return; }
        if (hipOccupancyMaxActiveBlocksPerMultiprocessor(&per_cu, (const void*)fwd, 512, LDS_BYTES) != hipSuccess || per_cu < 1) fprintf(stderr, "kernel_launch: occupancy query says %d\n", per_cu);
        (void)hipGetLastError();
        grid = cus;
    }
    if (grid < 0) return;
    (void)hipMemsetAsync((char*)d_ws + WS_CTL, 0, CTL_ZERO_BYTES, stream);
    Args a{};
    for (int i = 0; i < 27; ++i) a.in[i] = (const float*)d_in[i];
    a.out = (float*)d_out; a.ws = (unsigned char*)d_ws;
#if MK_ONE_LAUNCH
    a.ph_lo = 0; a.ph_hi = NPHASE;
    hipLaunchKernelGGL(fwd, dim3(grid), dim3(512), LDS_BYTES, stream, a);
#else
    for (int p = 0; p < NPHASE; ++p) { a.ph_lo = p; a.ph_hi = p + 1; hipLaunchKernelGGL(fwd, dim3(grid), dim3(512), LDS_BYTES, stream, a); }
#endif
}
```
